# Optimizing an MI355X kernel written in HIP

```python
import math
import jax, jax.numpy as jnp
from jax import lax
import numpy as np

D_MODEL = 1024
BATCH = 4
SEQ = 8192
DEPTH = 1

D_PLE = 256
GRID_W = 64
D_SSM = 512
SSM_GROUP = 16
N_SSM_GROUPS = D_SSM // SSM_GROUP
SSM_STATE = 64
DT_MIN = 1e-3
DT_MAX = 1e-1
D_NA = 512
NA_HEADS = 8
NA_HEAD_DIM = D_NA // NA_HEADS
NA_ROWS_MAX = 8
NA_COLS = 16
D_MIX = D_SSM + D_NA
D_IN_PROJ = 2 * D_SSM + 4 * D_NA
EPS = 1e-6

kernel_name = "hybrid_s5_natten_sandwich_ple_encoder"


def rms_norm(x, gain):
    xf = x.astype(jnp.float32)
    y = xf * lax.rsqrt(jnp.mean(xf * xf, axis=-1, keepdims=True) + EPS)
    return (y * gain.astype(jnp.float32)).astype(x.dtype)


def _complex_linear_combine(left, right):
    a1r, a1i, b1r, b1i = left
    a2r, a2i, b2r, b2i = right
    return (a2r * a1r - a2i * a1i,
            a2r * a1i + a2i * a1r,
            a2r * b1r - a2i * b1i + b2r,
            a2r * b1i + a2i * b1r + b2i)


def s5_bidirectional(u, a_re, a_im, log_dt, b_re, b_im, c_re, c_im, d):
    f32 = jnp.float32
    bsz, seqlen, _ = u.shape
    uf = u.astype(f32).reshape(bsz, seqlen, N_SSM_GROUPS, SSM_GROUP)
    y = uf * d.astype(f32)
    for direction in range(2):
        ar = a_re[direction].astype(f32)
        ai = a_im[direction].astype(f32)
        dt = jnp.exp(log_dt[direction].astype(f32))[:, None]
        mag = jnp.exp(dt * ar)
        abar_re = mag * jnp.cos(dt * ai)
        abar_im = mag * jnp.sin(dt * ai)
        num_re = abar_re - 1.0
        num_im = abar_im
        denom = ar * ar + ai * ai
        coef_re = (num_re * ar + num_im * ai) / denom
        coef_im = (num_im * ar - num_re * ai) / denom
        br = b_re[direction].astype(f32)
        bi = b_im[direction].astype(f32)
        bbar_re = coef_re[..., None] * br - coef_im[..., None] * bi
        bbar_im = coef_re[..., None] * bi + coef_im[..., None] * br
        bu_re = jnp.einsum('blgh,gph->blgp', uf, bbar_re)
        bu_im = jnp.einsum('blgh,gph->blgp', uf, bbar_im)
        shp = (1, seqlen, N_SSM_GROUPS, SSM_STATE)
        a_seq_re = jnp.broadcast_to(abar_re, shp)
        a_seq_im = jnp.broadcast_to(abar_im, shp)
        _, _, h_re, h_im = lax.associative_scan(
            _complex_linear_combine, (a_seq_re, a_seq_im, bu_re, bu_im),
            reverse=(direction == 1), axis=1)
        cr = c_re[direction].astype(f32)
        ci = c_im[direction].astype(f32)
        y = y + jnp.einsum('blgp,ghp->blgh', h_re, cr) - jnp.einsum('blgp,ghp->blgh', h_im, ci)
    return y.reshape(bsz, seqlen, D_SSM)


def neighborhood_attention_2d(q, k, v, rpb):
    f32 = jnp.float32
    bsz, seqlen, _ = q.shape
    rows = seqlen // GRID_W
    kh = min(NA_ROWS_MAX, rows)
    shp = (bsz, rows, GRID_W, NA_HEADS, NA_HEAD_DIM)
    q = q.reshape(shp)
    k = k.reshape(shp)
    v = v.reshape(shp)
    r = jnp.arange(rows)
    row_start = jnp.clip(r - kh // 2, 0, rows - kh)
    row_idx = row_start[:, None] + jnp.arange(kh)[None, :]
    k_blk = k[:, row_idx]
    v_blk = v[:, row_idx]
    c = jnp.arange(GRID_W)
    col_start = jnp.clip(c - NA_COLS // 2, 0, GRID_W - NA_COLS)
    col_in = (c[None, :] >= col_start[:, None]) & (c[None, :] < col_start[:, None] + NA_COLS)
    dr = row_idx - r[:, None] + (NA_ROWS_MAX - 1)
    dc = jnp.clip(c[None, :] - c[:, None] + (NA_COLS - 1), 0, 2 * NA_COLS - 2)
    bias = rpb.astype(f32)[:, dr[:, None, :, None], dc[None, :, None, :]]
    scale = NA_HEAD_DIM ** -0.5
    scores = jnp.einsum('brqhd,brikhd->bhrqik', q, k_blk,
                        preferred_element_type=f32) * scale + bias
    scores = jnp.where(col_in[:, None, :], scores, jnp.finfo(f32).min)
    probs = jax.nn.softmax(scores, axis=(-2, -1))
    out = jnp.einsum('bhrqik,brikhd->brqhd', probs.astype(v.dtype), v_blk)
    return out.reshape(bsz, seqlen, D_NA)


def setup_inputs(seed: int = 0) -> dict:
    key = jax.random.key(seed)
    ks = jax.random.split(key, 24)
    f32 = jnp.float32
    G, P, H = N_SSM_GROUPS, SSM_STATE, SSM_GROUP
    nrm = lambda kk, shape, s: jax.random.normal(kk, shape, f32) * s
    n_idx = jnp.arange(P, dtype=f32)
    return {
        "x": nrm(ks[0], (BATCH, SEQ, D_MODEL), 1.0),
        "p": nrm(ks[1], (DEPTH, BATCH, SEQ, D_PLE), 1.0),
        "norm_pre": 1.0 + nrm(ks[2], (DEPTH, D_MODEL), 0.02),
        "norm_post": 1.0 + nrm(ks[3], (DEPTH, D_MODEL), 0.02),
        "w_in": nrm(ks[4], (DEPTH, D_MODEL, D_IN_PROJ), D_MODEL ** -0.5),
        "ssm_a_re": -0.5 + nrm(ks[5], (DEPTH, 2, G, P), 0.01),
        "ssm_a_im": math.pi * n_idx + nrm(ks[6], (DEPTH, 2, G, P), 0.01),
        "ssm_log_dt": jax.random.uniform(ks[7], (DEPTH, 2, G), f32,
                                         minval=math.log(DT_MIN), maxval=math.log(DT_MAX)),
        "ssm_b_re": nrm(ks[8], (DEPTH, 2, G, P, H), H ** -0.5),
        "ssm_b_im": nrm(ks[9], (DEPTH, 2, G, P, H), H ** -0.5),
        "ssm_c_re": nrm(ks[10], (DEPTH, 2, G, H, P), P ** -0.5),
        "ssm_c_im": nrm(ks[11], (DEPTH, 2, G, H, P), P ** -0.5),
        "ssm_d": nrm(ks[12], (DEPTH, G, H), 1.0),
        "w_glu": nrm(ks[13], (DEPTH, D_SSM, D_SSM), D_SSM ** -0.5),
        "b_glu": nrm(ks[14], (DEPTH, D_SSM), 0.01),
        "na_rpb": nrm(ks[15], (DEPTH, NA_HEADS, 2 * NA_ROWS_MAX - 1, 2 * NA_COLS - 1), 0.02),
        "w_out": nrm(ks[16], (DEPTH, D_MIX, D_MODEL), D_MIX ** -0.5),
        "w_ple": nrm(ks[17], (DEPTH, D_PLE, D_MODEL), D_PLE ** -0.5),
        "ple_norm": 1.0 + nrm(ks[18], (DEPTH, D_MODEL), 0.02),
        "w_ple_gate": nrm(ks[19], (DEPTH, D_MODEL, D_MODEL), D_MODEL ** -0.5),
    }


def reference(x, p, norm_pre, norm_post, w_in, ssm_a_re, ssm_a_im, ssm_log_dt,
              ssm_b_re, ssm_b_im, ssm_c_re, ssm_c_im, ssm_d, w_glu, b_glu,
              na_rpb, w_out, w_ple, ple_norm, w_ple_gate):
    h = x
    splits = [D_SSM, 2 * D_SSM, 2 * D_SSM + D_NA, 2 * D_SSM + 2 * D_NA, 2 * D_SSM + 3 * D_NA]
    for i in range(DEPTH):
        hn = rms_norm(h, norm_pre[i])
        proj = hn @ w_in[i]
        u_s, z_s, q, k, v, z_n = jnp.split(proj, splits, axis=-1)
        y_s = s5_bidirectional(u_s, ssm_a_re[i], ssm_a_im[i], ssm_log_dt[i],
                               ssm_b_re[i], ssm_b_im[i], ssm_c_re[i], ssm_c_im[i], ssm_d[i])
        y_s = jax.nn.gelu(y_s.astype(hn.dtype))
        y_s = y_s * jax.nn.sigmoid(y_s @ w_glu[i] + b_glu[i])
        y_s = y_s * jax.nn.silu(z_s)
        y_n = neighborhood_attention_2d(q, k, v, na_rpb[i]) * jax.nn.silu(z_n)
        mix = jnp.concatenate([y_s, y_n], axis=-1) @ w_out[i]
        h = h + rms_norm(mix, norm_post[i])
        e = rms_norm(p[i] @ w_ple[i], ple_norm[i])
        h = h + jax.nn.sigmoid(h @ w_ple_gate[i]) * e
    return h
```

```cpp
#include <hip/hip_runtime.h>
#include <hip/hip_cooperative_groups.h>
#include <stdint.h>
#include <stdio.h>
namespace cg = cooperative_groups;

#ifndef MK_MULTI
#define MK_MULTI 1
#endif

typedef unsigned short bf16_t;
typedef short bf16x8 __attribute__((ext_vector_type(8)));
typedef float f32x4 __attribute__((ext_vector_type(4)));
typedef unsigned u32x4 __attribute__((ext_vector_type(4)));
typedef unsigned u32x2 __attribute__((ext_vector_type(2)));

constexpr int T = 32768, DM = 1024, SEQ = 8192, DPLE = 256, DIN = 3072;
constexpr int LC = 64;
constexpr int NCH = T / LC;
constexpr int CPB = SEQ / LC;
constexpr int KU = LC * 16;
constexpr int NS = 256;
constexpr int KA = KU + NS;
constexpr float EPS = 1e-6f;

constexpr size_t MB = 1ull << 20;
constexpr size_t OFF_XN = 0;
constexpr size_t OFF_MIXIN = OFF_XN;
constexpr size_t OFF_PB = OFF_XN + 64 * MB;
constexpr size_t OFF_WIN = OFF_PB + 16 * MB;
constexpr size_t OFF_WGLU = OFF_WIN + 6 * MB;
constexpr size_t OFF_WOUT = OFF_WGLU + 1 * MB;
constexpr size_t OFF_WPLE = OFF_WOUT + 2 * MB;
constexpr size_t OFF_WPG = OFF_WPLE + 1 * MB;
constexpr size_t OFF_UA = OFF_WPG + 2 * MB;
constexpr size_t OFF_ZS = OFF_UA + 40 * MB;
constexpr size_t OFF_Q = OFF_ZS + 32 * MB;
constexpr size_t OFF_K = OFF_Q + 32 * MB;
constexpr size_t OFF_VT = OFF_K + 32 * MB;
constexpr size_t OFF_ZN = OFF_VT + 32 * MB;
constexpr size_t OFF_MIX = OFF_Q;
constexpr size_t OFF_HB = OFF_VT;
constexpr size_t OFF_LAM = OFF_ZN + 32 * MB;
constexpr size_t OFF_BBAR = OFF_LAM + 3 * MB;
constexpr size_t OFF_KTAB = OFF_BBAR + 1 * MB;
constexpr size_t OFF_TQ = OFF_KTAB + 4 * MB;
constexpr size_t OFF_ERAW = OFF_TQ;
constexpr size_t OFF_PM = OFF_TQ + 80 * MB;
constexpr size_t OFF_S = OFF_PM + 16 * MB;
constexpr size_t OFF_YS = OFF_S + 16 * MB;
constexpr size_t OFF_SS = OFF_YS + 32 * MB;
constexpr size_t OFF_ESS = OFF_SS + 2 * MB;
constexpr size_t OFF_RSTD = OFF_ESS + 2 * MB;
constexpr size_t WS_END = OFF_RSTD + 1 * MB;

struct Params {
    const float *x, *p, *norm_pre, *norm_post, *w_in, *a_re, *a_im, *log_dt, *b_re, *b_im, *c_re, *c_im, *ssm_d, *w_glu, *b_glu, *rpb, *w_out, *w_ple, *ple_norm, *w_pg;
    float* out;
    unsigned char* ws;
};

__device__ __forceinline__ unsigned pk2(float lo, float hi) { unsigned r; asm("v_cvt_pk_bf16_f32 %0, %1, %2" : "=v"(r) : "v"(lo), "v"(hi)); return r; }
__device__ __forceinline__ float bflo(unsigned w) { return __uint_as_float(w << 16); }
__device__ __forceinline__ float bfhi(unsigned w) { return __uint_as_float(w & 0xffff0000u); }
__device__ __forceinline__ void store_bf4(bf16_t* p, f32x4 v) { u32x2 w; w.x = pk2(v[0], v[1]); w.y = pk2(v[2], v[3]); *(u32x2*)p = w; }
__device__ __forceinline__ f32x4 load_bf4(const bf16_t* p) { u32x2 w = *(const u32x2*)p; f32x4 v; v[0] = bflo(w.x); v[1] = bfhi(w.x); v[2] = bflo(w.y); v[3] = bfhi(w.y); return v; }
__device__ __forceinline__ float sigmoidf_(float v) { return 1.f / (1.f + __expf(-v)); }
__device__ __forceinline__ float gelu_tanh(float v) { const float u = 0.7978845608028654f * (v + 0.044715f * v * v * v); const float th = 1.f - 2.f / (__expf(2.f * u) + 1.f); return 0.5f * v * (1.f + th); }

constexpr int LDS_ROW = 72;
constexpr int LDS_TILE = 128 * LDS_ROW;
constexpr int LDS_BYTES = 4 * LDS_TILE * 2;

template <class Epi>
__device__ __forceinline__ void gemm_tile(const bf16_t* __restrict__ A, int lda, const bf16_t* __restrict__ Bt, int ldb, int K, bf16_t* lds, const Epi& epi) {
    const int tid = threadIdx.x, lane = tid & 63, wid = tid >> 6, wm = wid >> 1, wn = wid & 1, fr = lane & 15, fq = lane >> 4;
    const int sr = tid >> 3, sc = (tid & 7) * 8;
    const bf16_t* ga = A + (size_t)sr * lda + sc;
    const bf16_t* gb = Bt + (size_t)sr * ldb + sc;
    f32x4 acc[4][4];
#pragma unroll
    for (int mi = 0; mi < 4; ++mi)
#pragma unroll
        for (int ni = 0; ni < 4; ++ni) acc[mi][ni] = (f32x4){0.f, 0.f, 0.f, 0.f};
    u32x4 ra[4], rb[4];
    const int nk = K >> 6;
#pragma unroll
    for (int i = 0; i < 4; ++i) { ra[i] = *(const u32x4*)(ga + (size_t)(32 * i) * lda); rb[i] = *(const u32x4*)(gb + (size_t)(32 * i) * ldb); }
#pragma unroll
    for (int i = 0; i < 4; ++i) { *(u32x4*)(lds + (sr + 32 * i) * LDS_ROW + sc) = ra[i]; *(u32x4*)(lds + 2 * LDS_TILE + (sr + 32 * i) * LDS_ROW + sc) = rb[i]; }
    __syncthreads();
    for (int kt = 0; kt < nk; ++kt) {
        const int buf = kt & 1;
        if (kt + 1 < nk) {
#pragma unroll
            for (int i = 0; i < 4; ++i) { ra[i] = *(const u32x4*)(ga + (size_t)(32 * i) * lda + (kt + 1) * 64); rb[i] = *(const u32x4*)(gb + (size_t)(32 * i) * ldb + (kt + 1) * 64); }
        }
        const bf16_t* as = lds + buf * LDS_TILE + (wm * 64 + fr) * LDS_ROW + fq * 8;
        const bf16_t* bs = lds + (2 + buf) * LDS_TILE + (wn * 64 + fr) * LDS_ROW + fq * 8;
#pragma unroll
        for (int ks = 0; ks < 2; ++ks) {
            bf16x8 af[4], bfr[4];
#pragma unroll
            for (int i = 0; i < 4; ++i) { af[i] = *(const bf16x8*)(as + i * 16 * LDS_ROW + ks * 32); bfr[i] = *(const bf16x8*)(bs + i * 16 * LDS_ROW + ks * 32); }
#pragma unroll
            for (int mi = 0; mi < 4; ++mi)
#pragma unroll
                for (int ni = 0; ni < 4; ++ni) acc[mi][ni] = __builtin_amdgcn_mfma_f32_16x16x32_bf16(bfr[ni], af[mi], acc[mi][ni], 0, 0, 0);
        }
        if (kt + 1 < nk) {
            const int nb = buf ^ 1;
#pragma unroll
            for (int i = 0; i < 4; ++i) { *(u32x4*)(lds + nb * LDS_TILE + (sr + 32 * i) * LDS_ROW + sc) = ra[i]; *(u32x4*)(lds + (2 + nb) * LDS_TILE + (sr + 32 * i) * LDS_ROW + sc) = rb[i]; }
        }
        __syncthreads();
    }
    epi(acc, wm * 64 + fr, wn * 64 + fq * 4);
}

struct EpiInProj {
    unsigned char* ws; int m0, n0;
    __device__ __forceinline__ void operator()(f32x4 (&acc)[4][4], int r0, int c0) const {
        const int sec = n0 >> 9;
#pragma unroll
        for (int mi = 0; mi < 4; ++mi) {
            const int t = m0 + r0 + mi * 16;
#pragma unroll
            for (int ni = 0; ni < 4; ++ni) {
                const int nn = (n0 + c0 + ni * 16) & 511; f32x4 v = acc[mi][ni];
                if (sec == 0) { const int g = nn >> 4, hh = nn & 15, ch = t / LC, j = t % LC; store_bf4((bf16_t*)(ws + OFF_UA) + ((size_t)(g * NCH + ch)) * KA + j * 16 + hh, v); }
                else if (sec == 1) store_bf4((bf16_t*)(ws + OFF_ZS) + (size_t)t * 512 + nn, v);
                else if (sec == 2) store_bf4((bf16_t*)(ws + OFF_Q) + (size_t)t * 512 + nn, v * 0.125f);
                else if (sec == 3) store_bf4((bf16_t*)(ws + OFF_K) + (size_t)t * 512 + nn, v);
                else if (sec == 4) { const int b = t >> 13, l = t & 8191; bf16_t* vt = (bf16_t*)(ws + OFF_VT) + ((size_t)(b * 512 + nn)) * SEQ + l; const unsigned w0 = pk2(v[0], v[1]), w1 = pk2(v[2], v[3]);
                    vt[0] = (bf16_t)(w0 & 0xffff); vt[SEQ] = (bf16_t)(w0 >> 16); vt[2 * SEQ] = (bf16_t)(w1 & 0xffff); vt[3 * SEQ] = (bf16_t)(w1 >> 16); }
                else store_bf4((bf16_t*)(ws + OFF_ZN) + (size_t)t * 512 + nn, v);
            }
        }
    }
};
struct EpiS {
    float* S; int m0, n0;
    __device__ __forceinline__ void operator()(f32x4 (&acc)[4][4], int r0, int c0) const {
#pragma unroll
        for (int mi = 0; mi < 4; ++mi)
#pragma unroll
            for (int ni = 0; ni < 4; ++ni) *(f32x4*)(S + (size_t)(m0 + r0 + mi * 16) * NS + n0 + c0 + ni * 16) = acc[mi][ni];
    }
};
struct EpiY {
    bf16_t* ys; int g, m0, n0;
    __device__ __forceinline__ void operator()(f32x4 (&acc)[4][4], int r0, int c0) const {
#pragma unroll
        for (int mi = 0; mi < 4; ++mi) {
            const int ch = m0 + r0 + mi * 16;
#pragma unroll
            for (int ni = 0; ni < 4; ++ni) {
                const int n = n0 + c0 + ni * 16, i = n >> 4, h = n & 15; f32x4 v = acc[mi][ni];
#pragma unroll
                for (int e = 0; e < 4; ++e) v[e] = gelu_tanh(v[e]);
                store_bf4(ys + ((size_t)ch * LC + i) * 512 + g * 16 + h, v);
            }
        }
    }
};
struct EpiGlu {
    const bf16_t* ys; const bf16_t* zs; const float* bglu; bf16_t* mixin; int m0, n0;
    __device__ __forceinline__ void operator()(f32x4 (&acc)[4][4], int r0, int c0) const {
#pragma unroll
        for (int mi = 0; mi < 4; ++mi) {
            const int t = m0 + r0 + mi * 16;
#pragma unroll
            for (int ni = 0; ni < 4; ++ni) {
                const int n = n0 + c0 + ni * 16; const f32x4 bv = *(const f32x4*)(bglu + n);
                const f32x4 y = load_bf4(ys + (size_t)t * 512 + n), z = load_bf4(zs + (size_t)t * 512 + n); f32x4 o;
#pragma unroll
                for (int e = 0; e < 4; ++e) o[e] = y[e] * sigmoidf_(acc[mi][ni][e] + bv[e]) * z[e] * sigmoidf_(z[e]);
                store_bf4(mixin + (size_t)t * 1024 + n, o);
            }
        }
    }
};
struct EpiStoreSS {
    bf16_t* dst; float* ss; int m0, n0;
    __device__ __forceinline__ void operator()(f32x4 (&acc)[4][4], int r0, int c0) const {
#pragma unroll
        for (int mi = 0; mi < 4; ++mi) {
            const int t = m0 + r0 + mi * 16; float s = 0.f;
#pragma unroll
            for (int ni = 0; ni < 4; ++ni) { const f32x4 v = acc[mi][ni]; s += (v[0] * v[0] + v[1] * v[1]) + (v[2] * v[2] + v[3] * v[3]); store_bf4(dst + (size_t)t * 1024 + n0 + c0 + ni * 16, v); }
            s += __shfl_xor(s, 16); s += __shfl_xor(s, 32);
            if ((threadIdx.x & 48) == 0) ss[(size_t)t * 16 + (n0 >> 7) * 2 + (c0 >> 6)] = s;
        }
    }
};
struct EpiFinal {
    const float* x; const bf16_t* mix; const bf16_t* eraw; const float* rstd; const float* gpost; const float* gple; float* out; int m0, n0;
    __device__ __forceinline__ void operator()(f32x4 (&acc)[4][4], int r0, int c0) const {
#pragma unroll
        for (int mi = 0; mi < 4; ++mi) {
            const int t = m0 + r0 + mi * 16; const float rp = rstd[t], re = rstd[T + t];
#pragma unroll
            for (int ni = 0; ni < 4; ++ni) {
                const int n = n0 + c0 + ni * 16; const size_t off = (size_t)t * 1024 + n;
                const f32x4 xv = *(const f32x4*)(x + off), gp = *(const f32x4*)(gpost + n), ge = *(const f32x4*)(gple + n);
                const f32x4 mv = load_bf4(mix + off), ev = load_bf4(eraw + off); f32x4 o;
#pragma unroll
                for (int e = 0; e < 4; ++e) { const float h = xv[e] + mv[e] * rp * gp[e]; o[e] = h + sigmoidf_(acc[mi][ni][e]) * (ev[e] * re * ge[e]); }
                *(f32x4*)(out + off) = o;
            }
        }
    }
};

__device__ __forceinline__ void ktab_unit(const Params& P, int u, float* ldsf) {
    const int dir = u >> 8, g = (u >> 3) & 31, mr = u & 7, tid = threadIdx.x;
    float2* lp = (float2*)ldsf;
    float2* bb = lp + 64 * 65;
    float2* lampow = (float2*)(P.ws + OFF_LAM); float2* bbar = (float2*)(P.ws + OFF_BBAR); float* ktab = (float*)(P.ws + OFF_KTAB);
    if (tid < 64) {
        const int p = tid, idx = (dir * 32 + g) * 64 + p;
        const float ar = P.a_re[idx], ai = P.a_im[idx], dt = expf(P.log_dt[dir * 32 + g]);
        const float mag = expf(dt * ar), ang = dt * ai; const float lr = mag * cosf(ang), li = mag * sinf(ang);
        const float nr = lr - 1.f, ni = li, den = ar * ar + ai * ai;
        const float cr = (nr * ar + ni * ai) / den, ci = (ni * ar - nr * ai) / den;
        float pr = 1.f, pi = 0.f;
        for (int m = 0; m <= 64; ++m) { lp[p * 65 + m] = make_float2(pr, pi); if (mr == 0) lampow[(size_t)idx * 65 + m] = make_float2(pr, pi); const float tt = pr * lr - pi * li; pi = pr * li + pi * lr; pr = tt; }
        for (int h = 0; h < 16; ++h) { const float br = P.b_re[idx * 16 + h], bi = P.b_im[idx * 16 + h]; const float2 v = make_float2(cr * br - ci * bi, cr * bi + ci * br); bb[p * 16 + h] = v; if (mr == 0) bbar[(size_t)idx * 16 + h] = v; }
    }
    __syncthreads();
    const int h = tid >> 4, h2 = tid & 15;
    const float* crp = P.c_re + ((dir * 32 + g) * 16 + h) * 64; const float* cip = P.c_im + ((dir * 32 + g) * 16 + h) * 64;
    for (int mm = 0; mm < 8; ++mm) {
        const int m = mr * 8 + mm; float s = 0.f;
        for (int p = 0; p < 64; ++p) { const float2 l = lp[p * 65 + m], b = bb[p * 16 + h2]; s += crp[p] * (l.x * b.x - l.y * b.y) - cip[p] * (l.x * b.y + l.y * b.x); }
        ktab[((size_t)((dir * 32 + g) * 64 + m)) * 256 + h * 16 + h2] = s;
    }
    __syncthreads();
}
__device__ __forceinline__ void transpose_unit(const float* W, int K, int N, const float* gain, bf16_t* Wt, int item, float* ldsf) {
    const int nblk = N / 64, kb = item / nblk, nbk = item % nblk, k0 = kb * 64, n0 = nbk * 64, tid = threadIdx.x;
#pragma unroll 4
    for (int i = 0; i < 16; ++i) { const int kk = i * 4 + (tid >> 6), nn = tid & 63; float v = W[(size_t)(k0 + kk) * N + n0 + nn]; if (gain) v *= gain[k0 + kk]; ldsf[kk * 65 + nn] = v; }
    __syncthreads();
#pragma unroll 4
    for (int i = 0; i < 8; ++i) { const int nn = i * 8 + (tid >> 5), kk = (tid & 31) * 2; *(unsigned*)(Wt + (size_t)(n0 + nn) * K + k0 + kk) = pk2(ldsf[kk * 65 + nn], ldsf[(kk + 1) * 65 + nn]); }
    __syncthreads();
}
__device__ __forceinline__ float wave_sum(float v) {
#pragma unroll
    for (int o = 1; o < 64; o <<= 1) v += __shfl_xor(v, o);
    return v;
}
__device__ __forceinline__ void phase0(const Params& P, int bid, int nb, unsigned char* lds) {
    float* ldsf = (float*)lds;
    constexpr int U_K = 512, I_IN = 16 * 48, I_GLU = 64, I_OUT = 256, I_PLE = 4 * 16, I_PG = 256, U_T = I_IN + I_GLU + I_OUT + I_PLE + I_PG, U_X = T / 4, U_P = (T * DPLE) / 2048;
    constexpr int NU = U_K + U_T + U_X + U_P;
    const int tid = threadIdx.x, lane = tid & 63, wid = tid >> 6;
    for (int u = bid; u < NU; u += nb) {
        int r = u;
        if (r < U_K) { ktab_unit(P, r, ldsf); continue; } r -= U_K;
        if (r < U_T) {
            if (r < I_IN) { transpose_unit(P.w_in, 1024, 3072, P.norm_pre, (bf16_t*)(P.ws + OFF_WIN), r, ldsf); continue; } r -= I_IN;
            if (r < I_GLU) { transpose_unit(P.w_glu, 512, 512, nullptr, (bf16_t*)(P.ws + OFF_WGLU), r, ldsf); continue; } r -= I_GLU;
            if (r < I_OUT) { transpose_unit(P.w_out, 1024, 1024, nullptr, (bf16_t*)(P.ws + OFF_WOUT), r, ldsf); continue; } r -= I_OUT;
            if (r < I_PLE) { transpose_unit(P.w_ple, 256, 1024, nullptr, (bf16_t*)(P.ws + OFF_WPLE), r, ldsf); continue; } r -= I_PLE;
            transpose_unit(P.w_pg, 1024, 1024, nullptr, (bf16_t*)(P.ws + OFF_WPG), r, ldsf); continue;
        }
        r -= U_T;
        if (r < U_X) {
            const int t = r * 4 + wid; const f32x4* xr = (const f32x4*)(P.x + (size_t)t * 1024) + lane; f32x4 v[4]; float s = 0.f;
#pragma unroll
            for (int j = 0; j < 4; ++j) { v[j] = xr[64 * j]; s += (v[j][0] * v[j][0] + v[j][1] * v[j][1]) + (v[j][2] * v[j][2] + v[j][3] * v[j][3]); }
            const float rs = rsqrtf(wave_sum(s) * (1.f / 1024.f) + EPS);
            bf16_t* o = (bf16_t*)(P.ws + OFF_XN) + (size_t)t * 1024 + lane * 4;
#pragma unroll
            for (int j = 0; j < 4; ++j) store_bf4(o + 256 * j, v[j] * rs);
            continue;
        }
        r -= U_X;
        {
            const size_t e0 = (size_t)r * 2048 + tid * 8; const f32x4 a = *(const f32x4*)(P.p + e0), b = *(const f32x4*)(P.p + e0 + 4);
            u32x4 w; w.x = pk2(a[0], a[1]); w.y = pk2(a[2], a[3]); w.z = pk2(b[0], b[1]); w.w = pk2(b[2], b[3]);
            *(u32x4*)((bf16_t*)(P.ws + OFF_PB) + e0) = w;
        }
    }
}

__device__ __forceinline__ void tq_unit(const Params& P, int u) {
    const int g = u / LC, i = u % LC, tid = threadIdx.x;
    const float* ktab = (const float*)(P.ws + OFF_KTAB); const float2* lampow = (const float2*)(P.ws + OFF_LAM); bf16_t* tq = (bf16_t*)(P.ws + OFF_TQ);
    for (int idx = tid; idx < 16 * (KA / 2); idx += 256) {
        const int h = idx / (KA / 2), c = (idx % (KA / 2)) * 2; float v0, v1;
        if (c < KU) {
            const int j = c >> 4, h2 = c & 15;
            if (i > j) { const float* kp = ktab + ((size_t)((0 * 32 + g) * 64 + (i - j))) * 256 + h * 16 + h2; v0 = kp[0]; v1 = kp[1]; }
            else if (j > i) { const float* kp = ktab + ((size_t)((1 * 32 + g) * 64 + (j - i))) * 256 + h * 16 + h2; v0 = kp[0]; v1 = kp[1]; }
            else { const float* kf = ktab + ((size_t)((0 * 32 + g) * 64)) * 256 + h * 16 + h2; const float* kb = ktab + ((size_t)((1 * 32 + g) * 64)) * 256 + h * 16 + h2; const float dd = P.ssm_d[g * 16 + h];
                v0 = kf[0] + kb[0] + (h == h2 ? dd : 0.f); v1 = kf[1] + kb[1] + (h == h2 + 1 ? dd : 0.f); }
        } else {
            const int n = c - KU, dir = n >> 7, p = (n & 127) >> 1, m = dir == 0 ? i + 1 : LC - i;
            const float2 l = lampow[((size_t)((dir * 32 + g) * 64 + p)) * 65 + m]; const float cr = P.c_re[((dir * 32 + g) * 16 + h) * 64 + p], ci = P.c_im[((dir * 32 + g) * 16 + h) * 64 + p];
            v0 = cr * l.x - ci * l.y; v1 = -(cr * l.y + ci * l.x);
        }
        *(unsigned*)(tq + ((size_t)(g * KU + i * 16 + h)) * KA + c) = pk2(v0, v1);
    }
}
__device__ __forceinline__ void pm_unit(const Params& P, int u) {
    const int g = u >> 4, rg = u & 15, tid = threadIdx.x;
    const float2* lampow = (const float2*)(P.ws + OFF_LAM); const float2* bbar = (const float2*)(P.ws + OFF_BBAR); bf16_t* pm = (bf16_t*)(P.ws + OFF_PM);
    for (int idx = tid; idx < 16 * (KU / 2); idx += 256) {
        const int rr = idx / (KU / 2), c = (idx % (KU / 2)) * 2, n = rg * 16 + rr, dir = n >> 7, p = (n & 127) >> 1, ri = n & 1;
        const int j = c >> 4, h2 = c & 15, m = dir == 0 ? LC - 1 - j : j;
        const float2 l = lampow[((size_t)((dir * 32 + g) * 64 + p)) * 65 + m]; const float2 b0 = bbar[((size_t)((dir * 32 + g) * 64 + p)) * 16 + h2], b1 = bbar[((size_t)((dir * 32 + g) * 64 + p)) * 16 + h2 + 1];
        const float v0 = ri ? (l.x * b0.y + l.y * b0.x) : (l.x * b0.x - l.y * b0.y), v1 = ri ? (l.x * b1.y + l.y * b1.x) : (l.x * b1.x - l.y * b1.y);
        *(unsigned*)(pm + ((size_t)(g * NS + n)) * KU + c) = pk2(v0, v1);
    }
}
__device__ __forceinline__ void phase1(const Params& P, int bid, int nb, unsigned char* lds) {
    constexpr int NT = DIN / 128, U_G = (T / 128) * NT, U_TQ = 32 * LC, U_PM = 32 * 16, NU = U_G + U_TQ + U_PM;
    for (int u = bid; u < NU; u += nb) {
        if (u < U_G) {
            const int nt = u % NT, mt = u / NT; EpiInProj epi{P.ws, mt * 128, nt * 128};
            gemm_tile((const bf16_t*)(P.ws + OFF_XN) + (size_t)mt * 128 * 1024, 1024, (const bf16_t*)(P.ws + OFF_WIN) + (size_t)nt * 128 * 1024, 1024, 1024, (bf16_t*)lds, epi);
        } else if (u < U_G + U_TQ) tq_unit(P, u - U_G);
        else pm_unit(P, u - U_G - U_TQ);
    }
}

__device__ __forceinline__ void na_unit(const Params& P, int u) {
    const int tid = threadIdx.x, lane = tid & 63, cb = tid >> 6, fr = lane & 15, fq = lane >> 4;
    const int r = u & 127, head = (u >> 7) & 7, b = u >> 10;
    const bf16_t* q = (const bf16_t*)(P.ws + OFF_Q); const bf16_t* k = (const bf16_t*)(P.ws + OFF_K); const bf16_t* vt = (const bf16_t*)(P.ws + OFF_VT); const bf16_t* zn = (const bf16_t*)(P.ws + OFF_ZN);
    bf16_t* mixin = (bf16_t*)(P.ws + OFF_MIXIN);
    const int rs = min(max(r - 4, 0), 120);
    const int cw0 = cb == 0 ? 0 : (cb == 1 ? 8 : (cb == 2 ? 24 : 32));
    const int c = cb * 16 + fr, cs = min(max(c - 8, 0), 48);
    const size_t tq = (size_t)b * SEQ + r * 64 + c;
    const bf16x8 qf0 = *(const bf16x8*)(q + tq * 512 + head * 64 + fq * 8), qf1 = *(const bf16x8*)(q + tq * 512 + head * 64 + 32 + fq * 8);
    f32x4 s[16];
    const int kcol = cw0 + (fr >> 2) * 8 + (fr & 3);
#pragma unroll
    for (int t = 0; t < 16; ++t) {
        const int i = t >> 1, odd = t & 1;
        const bf16_t* kp = k + ((size_t)b * SEQ + (rs + i) * 64 + kcol + odd * 4) * 512 + head * 64 + fq * 8;
        const bf16x8 k0 = *(const bf16x8*)kp, k1 = *(const bf16x8*)(kp + 32);
        f32x4 z = (f32x4){0.f, 0.f, 0.f, 0.f};
        z = __builtin_amdgcn_mfma_f32_16x16x32_bf16(k0, qf0, z, 0, 0, 0);
        z = __builtin_amdgcn_mfma_f32_16x16x32_bf16(k1, qf1, z, 0, 0, 0);
        s[t] = z;
    }
    const float* rp = P.rpb + head * 15 * 31;
    float mx = -3.0e38f;
#pragma unroll
    for (int t = 0; t < 16; ++t) {
        const int i = t >> 1, odd = t & 1, dr = rs + i - r + 7;
#pragma unroll
        for (int e = 0; e < 4; ++e) {
            const int ck = cw0 + fq * 8 + odd * 4 + e; const bool valid = (ck >= cs) && (ck < cs + 16);
            const int dc = min(max(ck - c + 15, 0), 30);
            const float bv = rp[dr * 31 + dc];
            const float sv = valid ? s[t][e] + bv : -3.0e38f;
            s[t][e] = sv; mx = fmaxf(mx, sv);
        }
    }
    mx = fmaxf(mx, __shfl_xor(mx, 16)); mx = fmaxf(mx, __shfl_xor(mx, 32));
    float l = 0.f;
#pragma unroll
    for (int t = 0; t < 16; ++t)
#pragma unroll
        for (int e = 0; e < 4; ++e) { const float pv = __expf(s[t][e] - mx); s[t][e] = pv; l += pv; }
    l += __shfl_xor(l, 16); l += __shfl_xor(l, 32);
    f32x4 o[4];
#pragma unroll
    for (int dt = 0; dt < 4; ++dt) o[dt] = (f32x4){0.f, 0.f, 0.f, 0.f};
#pragma unroll
    for (int kk = 0; kk < 8; ++kk) {
        u32x4 pw; pw.x = pk2(s[2 * kk][0], s[2 * kk][1]); pw.y = pk2(s[2 * kk][2], s[2 * kk][3]); pw.z = pk2(s[2 * kk + 1][0], s[2 * kk + 1][1]); pw.w = pk2(s[2 * kk + 1][2], s[2 * kk + 1][3]);
        const bf16x8 pf = __builtin_bit_cast(bf16x8, pw);
        const bf16_t* vp = vt + ((size_t)(b * 512 + head * 64 + fr)) * SEQ + (rs + kk) * 64 + cw0 + fq * 8;
#pragma unroll
        for (int dt = 0; dt < 4; ++dt) { const bf16x8 vf = *(const bf16x8*)(vp + (size_t)dt * 16 * SEQ); o[dt] = __builtin_amdgcn_mfma_f32_16x16x32_bf16(vf, pf, o[dt], 0, 0, 0); }
    }
    const float inv = 1.f / l;
#pragma unroll
    for (int dt = 0; dt < 4; ++dt) {
        const int d0 = head * 64 + dt * 16 + fq * 4; const f32x4 z = load_bf4(zn + tq * 512 + d0); f32x4 ov;
#pragma unroll
        for (int e = 0; e < 4; ++e) ov[e] = o[dt][e] * inv * z[e] * sigmoidf_(z[e]);
        store_bf4(mixin + tq * 1024 + 512 + d0, ov);
    }
}
__device__ __forceinline__ void phase2(const Params& P, int bid, int nb, unsigned char* lds) {
    constexpr int MT = NCH / 128, U_G = 32 * MT * 2, U_NA = 4 * 8 * 128, NU = U_G + U_NA;
    for (int u = bid; u < NU; u += nb) {
        if (u < U_G) {
            const int mt = u % MT, nt = (u / MT) & 1, g = u / (MT * 2); EpiS epi{(float*)(P.ws + OFF_S) + (size_t)g * NCH * NS, mt * 128, nt * 128};
            gemm_tile((const bf16_t*)(P.ws + OFF_UA) + ((size_t)g * NCH + mt * 128) * KA, KA, (const bf16_t*)(P.ws + OFF_PM) + ((size_t)g * NS + nt * 128) * KU, KU, KU, (bf16_t*)lds, epi);
        } else na_unit(P, u - U_G);
    }
}

__device__ __forceinline__ void phase3(const Params& P, int bid, int nb) {
    const float2* lampow = (const float2*)(P.ws + OFF_LAM); const float2* S = (const float2*)(P.ws + OFF_S); bf16_t* ua = (bf16_t*)(P.ws + OFF_UA);
    for (int sidx = bid * 256 + threadIdx.x; sidx < 4 * 2 * 32 * 64; sidx += nb * 256) {
        const int p = sidx & 63, g = (sidx >> 6) & 31, dir = (sidx >> 11) & 1, b = sidx >> 12;
        const float2 L = lampow[((size_t)((dir * 32 + g) * 64 + p)) * 65 + LC];
        float hr = 0.f, hi = 0.f;
        const float2* Sp = S + ((size_t)(g * NCH + b * CPB)) * (NS / 2) + dir * 64 + p;
        bf16_t* up = ua + ((size_t)(g * NCH + b * CPB)) * KA + KU + dir * 128 + p * 2;
        for (int cb0 = 0; cb0 < CPB; cb0 += 16) {
            float2 sv[16];
#pragma unroll
            for (int uu = 0; uu < 16; ++uu) { const int c = dir == 0 ? cb0 + uu : CPB - 1 - (cb0 + uu); sv[uu] = Sp[(size_t)c * (NS / 2)]; }
#pragma unroll
            for (int uu = 0; uu < 16; ++uu) {
                const int c = dir == 0 ? cb0 + uu : CPB - 1 - (cb0 + uu);
                *(unsigned*)(up + (size_t)c * KA) = pk2(hr, hi);
                const float tr = L.x * hr - L.y * hi + sv[uu].x; hi = L.x * hi + L.y * hr + sv[uu].y; hr = tr;
            }
        }
    }
}

__device__ __forceinline__ void phase4(const Params& P, int bid, int nb, unsigned char* lds) {
    constexpr int MT = NCH / 128, NT = KU / 128, NU = 32 * MT * NT;
    for (int u = bid; u < NU; u += nb) {
        const int mt = u % MT, nt = (u / MT) % NT, g = u / (MT * NT); EpiY epi{(bf16_t*)(P.ws + OFF_YS), g, mt * 128, nt * 128};
        gemm_tile((const bf16_t*)(P.ws + OFF_UA) + ((size_t)g * NCH + mt * 128) * KA, KA, (const bf16_t*)(P.ws + OFF_TQ) + ((size_t)g * KU + nt * 128) * KA, KA, KA, (bf16_t*)lds, epi);
    }
}
__device__ __forceinline__ void phase5(const Params& P, int bid, int nb, unsigned char* lds) {
    constexpr int NT = 4, NU = (T / 128) * NT;
    for (int u = bid; u < NU; u += nb) {
        const int nt = u % NT, mt = u / NT; EpiGlu epi{(const bf16_t*)(P.ws + OFF_YS), (const bf16_t*)(P.ws + OFF_ZS), P.b_glu, (bf16_t*)(P.ws + OFF_MIXIN), mt * 128, nt * 128};
        gemm_tile((const bf16_t*)(P.ws + OFF_YS) + (size_t)mt * 128 * 512, 512, (const bf16_t*)(P.ws + OFF_WGLU) + (size_t)nt * 128 * 512, 512, 512, (bf16_t*)lds, epi);
    }
}
__device__ __forceinline__ void phase6(const Params& P, int bid, int nb, unsigned char* lds) {
    constexpr int NT = 8, U1 = (T / 128) * NT, NU = 2 * U1;
    for (int u = bid; u < NU; u += nb) {
        if (u < U1) {
            const int nt = u % NT, mt = u / NT; EpiStoreSS epi{(bf16_t*)(P.ws + OFF_MIX), (float*)(P.ws + OFF_SS), mt * 128, nt * 128};
            gemm_tile((const bf16_t*)(P.ws + OFF_MIXIN) + (size_t)mt * 128 * 1024, 1024, (const bf16_t*)(P.ws + OFF_WOUT) + (size_t)nt * 128 * 1024, 1024, 1024, (bf16_t*)lds, epi);
        } else {
            const int v = u - U1, nt = v % NT, mt = v / NT; EpiStoreSS epi{(bf16_t*)(P.ws + OFF_ERAW), (float*)(P.ws + OFF_ESS), mt * 128, nt * 128};
            gemm_tile((const bf16_t*)(P.ws + OFF_PB) + (size_t)mt * 128 * 256, 256, (const bf16_t*)(P.ws + OFF_WPLE) + (size_t)nt * 128 * 256, 256, 256, (bf16_t*)lds, epi);
        }
    }
}
__device__ __forceinline__ void phase7(const Params& P, int bid, int nb) {
    const int tid = threadIdx.x, lane = tid & 63, wid = tid >> 6;
    const float* ss = (const float*)(P.ws + OFF_SS); const float* ess = (const float*)(P.ws + OFF_ESS); float* rstd = (float*)(P.ws + OFF_RSTD);
    const bf16_t* mix = (const bf16_t*)(P.ws + OFF_MIX); bf16_t* hb = (bf16_t*)(P.ws + OFF_HB);
    for (int u = bid; u < T / 4; u += nb) {
        const int t = u * 4 + wid;
        float v = lane < 16 ? ss[(size_t)t * 16 + lane] : (lane < 32 ? ess[(size_t)t * 16 + lane - 16] : 0.f);
        v += __shfl_xor(v, 1); v += __shfl_xor(v, 2); v += __shfl_xor(v, 4); v += __shfl_xor(v, 8);
        const float rp = rsqrtf(__shfl(v, 0) * (1.f / 1024.f) + EPS), re = rsqrtf(__shfl(v, 16) * (1.f / 1024.f) + EPS);
        if (lane == 0) { rstd[t] = rp; rstd[T + t] = re; }
#pragma unroll
        for (int j = 0; j < 4; ++j) {
            const int n = lane * 4 + 256 * j; const size_t off = (size_t)t * 1024 + n;
            const f32x4 xv = *(const f32x4*)(P.x + off), gp = *(const f32x4*)(P.norm_post + n), mv = load_bf4(mix + off); f32x4 h;
#pragma unroll
            for (int e = 0; e < 4; ++e) h[e] = xv[e] + mv[e] * rp * gp[e];
            store_bf4(hb + off, h);
        }
    }
}
__device__ __forceinline__ void phase8(const Params& P, int bid, int nb, unsigned char* lds) {
    constexpr int NT = 8, NU = (T / 128) * NT;
    for (int u = bid; u < NU; u += nb) {
        const int nt = u % NT, mt = u / NT;
        EpiFinal epi{P.x, (const bf16_t*)(P.ws + OFF_MIX), (const bf16_t*)(P.ws + OFF_ERAW), (const float*)(P.ws + OFF_RSTD), P.norm_post, P.ple_norm, P.out, mt * 128, nt * 128};
        gemm_tile((const bf16_t*)(P.ws + OFF_HB) + (size_t)mt * 128 * 1024, 1024, (const bf16_t*)(P.ws + OFF_WPG) + (size_t)nt * 128 * 1024, 1024, 1024, (bf16_t*)lds, epi);
    }
}

extern __shared__ __attribute__((aligned(16))) unsigned char dyn_lds[];

#if MK_MULTI
__global__ void __launch_bounds__(256, 2) k_phase(Params P, int ph) {
    const int bid = blockIdx.x, nb = gridDim.x;
    switch (ph) {
        case 0: phase0(P, bid, nb, dyn_lds); break;
        case 1: phase1(P, bid, nb, dyn_lds); break;
        case 2: phase2(P, bid, nb, dyn_lds); break;
        case 3: phase3(P, bid, nb); break;
        case 4: phase4(P, bid, nb, dyn_lds); break;
        case 5: phase5(P, bid, nb, dyn_lds); break;
        case 6: phase6(P, bid, nb, dyn_lds); break;
        case 7: phase7(P, bid, nb); break;
        default: phase8(P, bid, nb, dyn_lds); break;
    }
}
#else
__global__ void __launch_bounds__(256, 2) k_mega(Params P) {
    cg::grid_group grid = cg::this_grid();
    const int bid = blockIdx.x, nb = gridDim.x;
    phase0(P, bid, nb, dyn_lds); grid.sync();
    phase1(P, bid, nb, dyn_lds); grid.sync();
    phase2(P, bid, nb, dyn_lds); grid.sync();
    phase3(P, bid, nb); grid.sync();
    phase4(P, bid, nb, dyn_lds); grid.sync();
    phase5(P, bid, nb, dyn_lds); grid.sync();
    phase6(P, bid, nb, dyn_lds); grid.sync();
    phase7(P, bid, nb); grid.sync();
    phase8(P, bid, nb, dyn_lds);
}
#endif

extern "C" void kernel_launch(void* const* d_in, const int* in_sizes, int n_in, void* d_out, int out_size, void* d_ws, size_t ws_size, hipStream_t stream) {
    static int grid = 0;
    if (grid == 0) {
        if (n_in != 20 || ws_size < WS_END) { fprintf(stderr, "kernel_launch: unexpected n_in %d or ws_size %zu (< %zu)\n", n_in, ws_size, (size_t)WS_END); grid = -1; return; }
        int dev = 0, cus = 0, per_cu = 0;
        hipGetDevice(&dev); hipDeviceGetAttribute(&cus, hipDeviceAttributeMultiprocessorCount, dev);
#if MK_MULTI
        hipFuncSetAttribute((const void*)k_phase, hipFuncAttributeMaxDynamicSharedMemorySize, LDS_BYTES);
        hipOccupancyMaxActiveBlocksPerMultiprocessor(&per_cu, (const void*)k_phase, 256, LDS_BYTES);
#else
        hipFuncSetAttribute((const void*)k_mega, hipFuncAttributeMaxDynamicSharedMemorySize, LDS_BYTES);
        hipOccupancyMaxActiveBlocksPerMultiprocessor(&per_cu, (const void*)k_mega, 256, LDS_BYTES);
#endif
        if (per_cu < 1) per_cu = 1;
        if (per_cu > 2) per_cu = 2;
        grid = cus * per_cu;
        (void)hipGetLastError();
    }
    if (grid < 0) return;
    Params P{};
    const float** pp = (const float**)&P;
    for (int i = 0; i < 20; ++i) pp[i] = (const float*)d_in[i];
    P.out = (float*)d_out; P.ws = (unsigned char*)d_ws;
#if MK_MULTI
    for (int ph = 0; ph < 9; ++ph) hipLaunchKernelGGL(k_phase, dim3(grid), dim3(256), LDS_BYTES, stream, P, ph);
#else
    void* args[] = {&P};
    hipError_t e = hipLaunchCooperativeKernel((const void*)k_mega, dim3(grid), dim3(256), args, LDS_BYTES, stream);
    if (e != hipSuccess) fprintf(stderr, "cooperative launch failed: %s (grid %d)\n", hipGetErrorString(e), grid);
#endif
}
```

```cpp
#include <hip/hip_runtime.h>
#include <hip/hip_cooperative_groups.h>
#include <stdint.h>
#include <stdio.h>
namespace cg = cooperative_groups;

#ifndef MK_MULTI
#define MK_MULTI 0
#endif

typedef unsigned short bf16_t;
typedef short bf16x8 __attribute__((ext_vector_type(8)));
typedef float f32x4 __attribute__((ext_vector_type(4)));
typedef unsigned u32x4 __attribute__((ext_vector_type(4)));
typedef unsigned u32x2 __attribute__((ext_vector_type(2)));

constexpr int T = 32768, DM = 1024, SEQ = 8192, DPLE = 256, DIN = 3072;
constexpr int LC = 64;
constexpr int NCH = T / LC;
constexpr int CPB = SEQ / LC;
constexpr int KU = LC * 16;
constexpr int NS = 256;
constexpr int KA = KU + NS;
constexpr float EPS = 1e-6f;

constexpr size_t MB = 1ull << 20;
constexpr size_t OFF_XN = 0;
constexpr size_t OFF_MIXIN = OFF_XN;
constexpr size_t OFF_PB = OFF_XN + 64 * MB;
constexpr size_t OFF_WIN = OFF_PB + 16 * MB;
constexpr size_t OFF_WGLU = OFF_WIN + 6 * MB;
constexpr size_t OFF_WOUT = OFF_WGLU + 1 * MB;
constexpr size_t OFF_WPLE = OFF_WOUT + 2 * MB;
constexpr size_t OFF_WPG = OFF_WPLE + 1 * MB;
constexpr size_t OFF_UA = OFF_WPG + 2 * MB;
constexpr size_t OFF_ZS = OFF_UA + 40 * MB;
constexpr size_t OFF_Q = OFF_ZS + 32 * MB;
constexpr size_t OFF_K = OFF_Q + 32 * MB;
constexpr size_t OFF_VT = OFF_K + 32 * MB;
constexpr size_t OFF_ZN = OFF_VT + 32 * MB;
constexpr size_t OFF_MIX = OFF_Q;
constexpr size_t OFF_HB = OFF_VT;
constexpr size_t OFF_LAM = OFF_ZN + 32 * MB;
constexpr size_t OFF_BBAR = OFF_LAM + 3 * MB;
constexpr size_t OFF_KTAB = OFF_BBAR + 1 * MB;
constexpr size_t OFF_TQ = OFF_KTAB + 4 * MB;
constexpr size_t OFF_ERAW = OFF_TQ;
constexpr size_t OFF_PM = OFF_TQ + 80 * MB;
constexpr size_t OFF_S = OFF_PM + 16 * MB;
constexpr size_t OFF_YS = OFF_S + 16 * MB;
constexpr size_t OFF_SS = OFF_YS + 32 * MB;
constexpr size_t OFF_ESS = OFF_SS + 2 * MB;
constexpr size_t OFF_RSTD = OFF_ESS + 2 * MB;
constexpr size_t WS_END = OFF_RSTD + 1 * MB;

struct Params {
    const float *x, *p, *norm_pre, *norm_post, *w_in, *a_re, *a_im, *log_dt, *b_re, *b_im, *c_re, *c_im, *ssm_d, *w_glu, *b_glu, *rpb, *w_out, *w_ple, *ple_norm, *w_pg;
    float* out;
    unsigned char* ws;
};

__device__ __forceinline__ unsigned pk2(float lo, float hi) { unsigned r; asm("v_cvt_pk_bf16_f32 %0, %1, %2" : "=v"(r) : "v"(lo), "v"(hi)); return r; }
__device__ __forceinline__ float bflo(unsigned w) { return __uint_as_float(w << 16); }
__device__ __forceinline__ float bfhi(unsigned w) { return __uint_as_float(w & 0xffff0000u); }
__device__ __forceinline__ void store_bf4(bf16_t* p, f32x4 v) { u32x2 w; w.x = pk2(v[0], v[1]); w.y = pk2(v[2], v[3]); *(u32x2*)p = w; }
__device__ __forceinline__ f32x4 load_bf4(const bf16_t* p) { u32x2 w = *(const u32x2*)p; f32x4 v; v[0] = bflo(w.x); v[1] = bfhi(w.x); v[2] = bflo(w.y); v[3] = bfhi(w.y); return v; }
__device__ __forceinline__ float sigmoidf_(float v) { return 1.f / (1.f + __expf(-v)); }
__device__ __forceinline__ float gelu_tanh(float v) { const float u = 0.7978845608028654f * (v + 0.044715f * v * v * v); const float th = 1.f - 2.f / (__expf(2.f * u) + 1.f); return 0.5f * v * (1.f + th); }

constexpr int LDS_ROW = 72;
constexpr int LDS_TILE = 128 * LDS_ROW;
constexpr int LDS_BYTES = 4 * LDS_TILE * 2;

template <class Epi>
__device__ __forceinline__ void gemm_tile(const bf16_t* __restrict__ A, int lda, const bf16_t* __restrict__ Bt, int ldb, int K, bf16_t* lds, const Epi& epi) {
    const int tid = threadIdx.x, lane = tid & 63, wid = tid >> 6, wm = wid >> 1, wn = wid & 1, fr = lane & 15, fq = lane >> 4;
    const int sr = tid >> 3, sc = (tid & 7) * 8;
    const bf16_t* ga = A + (size_t)sr * lda + sc;
    const bf16_t* gb = Bt + (size_t)sr * ldb + sc;
    f32x4 acc[4][4];
#pragma unroll
    for (int mi = 0; mi < 4; ++mi)
#pragma unroll
        for (int ni = 0; ni < 4; ++ni) acc[mi][ni] = (f32x4){0.f, 0.f, 0.f, 0.f};
    u32x4 ra[4], rb[4];
    const int nk = K >> 6;
#pragma unroll
    for (int i = 0; i < 4; ++i) { ra[i] = *(const u32x4*)(ga + (size_t)(32 * i) * lda); rb[i] = *(const u32x4*)(gb + (size_t)(32 * i) * ldb); }
#pragma unroll
    for (int i = 0; i < 4; ++i) { *(u32x4*)(lds + (sr + 32 * i) * LDS_ROW + sc) = ra[i]; *(u32x4*)(lds + 2 * LDS_TILE + (sr + 32 * i) * LDS_ROW + sc) = rb[i]; }
    __syncthreads();
    for (int kt = 0; kt < nk; ++kt) {
        const int buf = kt & 1;
        if (kt + 1 < nk) {
#pragma unroll
            for (int i = 0; i < 4; ++i) { ra[i] = *(const u32x4*)(ga + (size_t)(32 * i) * lda + (kt + 1) * 64); rb[i] = *(const u32x4*)(gb + (size_t)(32 * i) * ldb + (kt + 1) * 64); }
        }
        const bf16_t* as = lds + buf * LDS_TILE + (wm * 64 + fr) * LDS_ROW + fq * 8;
        const bf16_t* bs = lds + (2 + buf) * LDS_TILE + (wn * 64 + fr) * LDS_ROW + fq * 8;
#pragma unroll
        for (int ks = 0; ks < 2; ++ks) {
            bf16x8 af[4], bfr[4];
#pragma unroll
            for (int i = 0; i < 4; ++i) { af[i] = *(const bf16x8*)(as + i * 16 * LDS_ROW + ks * 32); bfr[i] = *(const bf16x8*)(bs + i * 16 * LDS_ROW + ks * 32); }
#pragma unroll
            for (int mi = 0; mi < 4; ++mi)
#pragma unroll
                for (int ni = 0; ni < 4; ++ni) acc[mi][ni] = __builtin_amdgcn_mfma_f32_16x16x32_bf16(bfr[ni], af[mi], acc[mi][ni], 0, 0, 0);
        }
        if (kt + 1 < nk) {
            const int nb = buf ^ 1;
#pragma unroll
            for (int i = 0; i < 4; ++i) { *(u32x4*)(lds + nb * LDS_TILE + (sr + 32 * i) * LDS_ROW + sc) = ra[i]; *(u32x4*)(lds + (2 + nb) * LDS_TILE + (sr + 32 * i) * LDS_ROW + sc) = rb[i]; }
        }
        __syncthreads();
    }
    epi(acc, wm * 64 + fr, wn * 64 + fq * 4);
}

struct EpiInProj {
    unsigned char* ws; int m0, n0;
    __device__ __forceinline__ void operator()(f32x4 (&acc)[4][4], int r0, int c0) const {
        const int sec = n0 >> 9;
#pragma unroll
        for (int mi = 0; mi < 4; ++mi) {
            const int t = m0 + r0 + mi * 16;
#pragma unroll
            for (int ni = 0; ni < 4; ++ni) {
                const int nn = (n0 + c0 + ni * 16) & 511; f32x4 v = acc[mi][ni];
                if (sec == 0) { const int g = nn >> 4, hh = nn & 15, ch = t / LC, j = t % LC; store_bf4((bf16_t*)(ws + OFF_UA) + ((size_t)(g * NCH + ch)) * KA + j * 16 + hh, v); }
                else if (sec == 1) store_bf4((bf16_t*)(ws + OFF_ZS) + (size_t)t * 512 + nn, v);
                else if (sec == 2) store_bf4((bf16_t*)(ws + OFF_Q) + (size_t)t * 512 + nn, v * 0.125f);
                else if (sec == 3) store_bf4((bf16_t*)(ws + OFF_K) + (size_t)t * 512 + nn, v);
                else if (sec == 4) { const int b = t >> 13, l = t & 8191; bf16_t* vt = (bf16_t*)(ws + OFF_VT) + ((size_t)(b * 512 + nn)) * SEQ + l; const unsigned w0 = pk2(v[0], v[1]), w1 = pk2(v[2], v[3]);
                    vt[0] = (bf16_t)(w0 & 0xffff); vt[SEQ] = (bf16_t)(w0 >> 16); vt[2 * SEQ] = (bf16_t)(w1 & 0xffff); vt[3 * SEQ] = (bf16_t)(w1 >> 16); }
                else store_bf4((bf16_t*)(ws + OFF_ZN) + (size_t)t * 512 + nn, v);
            }
        }
    }
};
struct EpiS {
    float* S; int m0, n0;
    __device__ __forceinline__ void operator()(f32x4 (&acc)[4][4], int r0, int c0) const {
#pragma unroll
        for (int mi = 0; mi < 4; ++mi)
#pragma unroll
            for (int ni = 0; ni < 4; ++ni) *(f32x4*)(S + (size_t)(m0 + r0 + mi * 16) * NS + n0 + c0 + ni * 16) = acc[mi][ni];
    }
};
struct EpiY {
    bf16_t* ys; int g, m0, n0;
    __device__ __forceinline__ void operator()(f32x4 (&acc)[4][4], int r0, int c0) const {
#pragma unroll
        for (int mi = 0; mi < 4; ++mi) {
            const int ch = m0 + r0 + mi * 16;
#pragma unroll
            for (int ni = 0; ni < 4; ++ni) {
                const int n = n0 + c0 + ni * 16, i = n >> 4, h = n & 15; f32x4 v = acc[mi][ni];
#pragma unroll
                for (int e = 0; e < 4; ++e) v[e] = gelu_tanh(v[e]);
                store_bf4(ys + ((size_t)ch * LC + i) * 512 + g * 16 + h, v);
            }
        }
    }
};
struct EpiGlu {
    const bf16_t* ys; const bf16_t* zs; const float* bglu; bf16_t* mixin; int m0, n0;
    __device__ __forceinline__ void operator()(f32x4 (&acc)[4][4], int r0, int c0) const {
#pragma unroll
        for (int mi = 0; mi < 4; ++mi) {
            const int t = m0 + r0 + mi * 16;
#pragma unroll
            for (int ni = 0; ni < 4; ++ni) {
                const int n = n0 + c0 + ni * 16; const f32x4 bv = *(const f32x4*)(bglu + n);
                const f32x4 y = load_bf4(ys + (size_t)t * 512 + n), z = load_bf4(zs + (size_t)t * 512 + n); f32x4 o;
#pragma unroll
                for (int e = 0; e < 4; ++e) o[e] = y[e] * sigmoidf_(acc[mi][ni][e] + bv[e]) * z[e] * sigmoidf_(z[e]);
                store_bf4(mixin + (size_t)t * 1024 + n, o);
            }
        }
    }
};
struct EpiStoreSS {
    bf16_t* dst; float* ss; int m0, n0;
    __device__ __forceinline__ void operator()(f32x4 (&acc)[4][4], int r0, int c0) const {
#pragma unroll
        for (int mi = 0; mi < 4; ++mi) {
            const int t = m0 + r0 + mi * 16; float s = 0.f;
#pragma unroll
            for (int ni = 0; ni < 4; ++ni) { const f32x4 v = acc[mi][ni]; s += (v[0] * v[0] + v[1] * v[1]) + (v[2] * v[2] + v[3] * v[3]); store_bf4(dst + (size_t)t * 1024 + n0 + c0 + ni * 16, v); }
            s += __shfl_xor(s, 16); s += __shfl_xor(s, 32);
            if ((threadIdx.x & 48) == 0) ss[(size_t)t * 16 + (n0 >> 7) * 2 + (c0 >> 6)] = s;
        }
    }
};
struct EpiFinal {
    const float* x; const bf16_t* mix; const bf16_t* eraw; const float* rstd; const float* gpost; const float* gple; float* out; int m0, n0;
    __device__ __forceinline__ void operator()(f32x4 (&acc)[4][4], int r0, int c0) const {
#pragma unroll
        for (int mi = 0; mi < 4; ++mi) {
            const int t = m0 + r0 + mi * 16; const float rp = rstd[t], re = rstd[T + t];
#pragma unroll
            for (int ni = 0; ni < 4; ++ni) {
                const int n = n0 + c0 + ni * 16; const size_t off = (size_t)t * 1024 + n;
                const f32x4 xv = *(const f32x4*)(x + off), gp = *(const f32x4*)(gpost + n), ge = *(const f32x4*)(gple + n);
                const f32x4 mv = load_bf4(mix + off), ev = load_bf4(eraw + off); f32x4 o;
#pragma unroll
                for (int e = 0; e < 4; ++e) { const float h = xv[e] + mv[e] * rp * gp[e]; o[e] = h + sigmoidf_(acc[mi][ni][e]) * (ev[e] * re * ge[e]); }
                *(f32x4*)(out + off) = o;
            }
        }
    }
};

__device__ __forceinline__ void ktab_unit(const Params& P, int u, float* ldsf) {
    const int dir = u >> 8, g = (u >> 3) & 31, mr = u & 7, tid = threadIdx.x;
    float2* lp = (float2*)ldsf;
    float2* bb = lp + 64 * 65;
    float2* lampow = (float2*)(P.ws + OFF_LAM); float2* bbar = (float2*)(P.ws + OFF_BBAR); float* ktab = (float*)(P.ws + OFF_KTAB);
    if (tid < 64) {
        const int p = tid, idx = (dir * 32 + g) * 64 + p;
        const float ar = P.a_re[idx], ai = P.a_im[idx], dt = expf(P.log_dt[dir * 32 + g]);
        const float mag = expf(dt * ar), ang = dt * ai; const float lr = mag * cosf(ang), li = mag * sinf(ang);
        const float nr = lr - 1.f, ni = li, den = ar * ar + ai * ai;
        const float cr = (nr * ar + ni * ai) / den, ci = (ni * ar - nr * ai) / den;
        float pr = 1.f, pi = 0.f;
        for (int m = 0; m <= 64; ++m) { lp[p * 65 + m] = make_float2(pr, pi); if (mr == 0) lampow[(size_t)idx * 65 + m] = make_float2(pr, pi); const float tt = pr * lr - pi * li; pi = pr * li + pi * lr; pr = tt; }
        for (int h = 0; h < 16; ++h) { const float br = P.b_re[idx * 16 + h], bi = P.b_im[idx * 16 + h]; const float2 v = make_float2(cr * br - ci * bi, cr * bi + ci * br); bb[p * 16 + h] = v; if (mr == 0) bbar[(size_t)idx * 16 + h] = v; }
    }
    __syncthreads();
    const int h = tid >> 4, h2 = tid & 15;
    const float* crp = P.c_re + ((dir * 32 + g) * 16 + h) * 64; const float* cip = P.c_im + ((dir * 32 + g) * 16 + h) * 64;
    for (int mm = 0; mm < 8; ++mm) {
        const int m = mr * 8 + mm; float s = 0.f;
        for (int p = 0; p < 64; ++p) { const float2 l = lp[p * 65 + m], b = bb[p * 16 + h2]; s += crp[p] * (l.x * b.x - l.y * b.y) - cip[p] * (l.x * b.y + l.y * b.x); }
        ktab[((size_t)((dir * 32 + g) * 64 + m)) * 256 + h * 16 + h2] = s;
    }
    __syncthreads();
}
__device__ __forceinline__ void transpose_unit(const float* W, int K, int N, const float* gain, bf16_t* Wt, int item, float* ldsf) {
    const int nblk = N / 64, kb = item / nblk, nbk = item % nblk, k0 = kb * 64, n0 = nbk * 64, tid = threadIdx.x;
#pragma unroll 4
    for (int i = 0; i < 16; ++i) { const int kk = i * 4 + (tid >> 6), nn = tid & 63; float v = W[(size_t)(k0 + kk) * N + n0 + nn]; if (gain) v *= gain[k0 + kk]; ldsf[kk * 65 + nn] = v; }
    __syncthreads();
#pragma unroll 4
    for (int i = 0; i < 8; ++i) { const int nn = i * 8 + (tid >> 5), kk = (tid & 31) * 2; *(unsigned*)(Wt + (size_t)(n0 + nn) * K + k0 + kk) = pk2(ldsf[kk * 65 + nn], ldsf[(kk + 1) * 65 + nn]); }
    __syncthreads();
}
__device__ __forceinline__ float wave_sum(float v) {
#pragma unroll
    for (int o = 1; o < 64; o <<= 1) v += __shfl_xor(v, o);
    return v;
}
__device__ __forceinline__ void phase0(const Params& P, int bid, int nb, unsigned char* lds) {
    float* ldsf = (float*)lds;
    constexpr int U_K = 512, I_IN = 16 * 48, I_GLU = 64, I_OUT = 256, I_PLE = 4 * 16, I_PG = 256, U_T = I_IN + I_GLU + I_OUT + I_PLE + I_PG, U_X = T / 4, U_P = (T * DPLE) / 2048;
    constexpr int NU = U_K + U_T + U_X + U_P;
    const int tid = threadIdx.x, lane = tid & 63, wid = tid >> 6;
    for (int u = bid; u < NU; u += nb) {
        int r = u;
        if (r < U_K) { ktab_unit(P, r, ldsf); continue; } r -= U_K;
        if (r < U_T) {
            if (r < I_IN) { transpose_unit(P.w_in, 1024, 3072, P.norm_pre, (bf16_t*)(P.ws + OFF_WIN), r, ldsf); continue; } r -= I_IN;
            if (r < I_GLU) { transpose_unit(P.w_glu, 512, 512, nullptr, (bf16_t*)(P.ws + OFF_WGLU), r, ldsf); continue; } r -= I_GLU;
            if (r < I_OUT) { transpose_unit(P.w_out, 1024, 1024, nullptr, (bf16_t*)(P.ws + OFF_WOUT), r, ldsf); continue; } r -= I_OUT;
            if (r < I_PLE) { transpose_unit(P.w_ple, 256, 1024, nullptr, (bf16_t*)(P.ws + OFF_WPLE), r, ldsf); continue; } r -= I_PLE;
            transpose_unit(P.w_pg, 1024, 1024, nullptr, (bf16_t*)(P.ws + OFF_WPG), r, ldsf); continue;
        }
        r -= U_T;
        if (r < U_X) {
            const int t = r * 4 + wid; const f32x4* xr = (const f32x4*)(P.x + (size_t)t * 1024) + lane; f32x4 v[4]; float s = 0.f;
#pragma unroll
            for (int j = 0; j < 4; ++j) { v[j] = xr[64 * j]; s += (v[j][0] * v[j][0] + v[j][1] * v[j][1]) + (v[j][2] * v[j][2] + v[j][3] * v[j][3]); }
            const float rs = rsqrtf(wave_sum(s) * (1.f / 1024.f) + EPS);
            bf16_t* o = (bf16_t*)(P.ws + OFF_XN) + (size_t)t * 1024 + lane * 4;
#pragma unroll
            for (int j = 0; j < 4; ++j) store_bf4(o + 256 * j, v[j] * rs);
            continue;
        }
        r -= U_X;
        {
            const size_t e0 = (size_t)r * 2048 + tid * 8; const f32x4 a = *(const f32x4*)(P.p + e0), b = *(const f32x4*)(P.p + e0 + 4);
            u32x4 w; w.x = pk2(a[0], a[1]); w.y = pk2(a[2], a[3]); w.z = pk2(b[0], b[1]); w.w = pk2(b[2], b[3]);
            *(u32x4*)((bf16_t*)(P.ws + OFF_PB) + e0) = w;
        }
    }
}

__device__ __forceinline__ void tq_unit(const Params& P, int u) {
    const int g = u / LC, i = u % LC, tid = threadIdx.x;
    const float* ktab = (const float*)(P.ws + OFF_KTAB); const float2* lampow = (const float2*)(P.ws + OFF_LAM); bf16_t* tq = (bf16_t*)(P.ws + OFF_TQ);
    for (int idx = tid; idx < 16 * (KA / 2); idx += 256) {
        const int h = idx / (KA / 2), c = (idx % (KA / 2)) * 2; float v0, v1;
        if (c < KU) {
            const int j = c >> 4, h2 = c & 15;
            if (i > j) { const float* kp = ktab + ((size_t)((0 * 32 + g) * 64 + (i - j))) * 256 + h * 16 + h2; v0 = kp[0]; v1 = kp[1]; }
            else if (j > i) { const float* kp = ktab + ((size_t)((1 * 32 + g) * 64 + (j - i))) * 256 + h * 16 + h2; v0 = kp[0]; v1 = kp[1]; }
            else { const float* kf = ktab + ((size_t)((0 * 32 + g) * 64)) * 256 + h * 16 + h2; const float* kb = ktab + ((size_t)((1 * 32 + g) * 64)) * 256 + h * 16 + h2; const float dd = P.ssm_d[g * 16 + h];
                v0 = kf[0] + kb[0] + (h == h2 ? dd : 0.f); v1 = kf[1] + kb[1] + (h == h2 + 1 ? dd : 0.f); }
        } else {
            const int n = c - KU, dir = n >> 7, p = (n & 127) >> 1, m = dir == 0 ? i + 1 : LC - i;
            const float2 l = lampow[((size_t)((dir * 32 + g) * 64 + p)) * 65 + m]; const float cr = P.c_re[((dir * 32 + g) * 16 + h) * 64 + p], ci = P.c_im[((dir * 32 + g) * 16 + h) * 64 + p];
            v0 = cr * l.x - ci * l.y; v1 = -(cr * l.y + ci * l.x);
        }
        *(unsigned*)(tq + ((size_t)(g * KU + i * 16 + h)) * KA + c) = pk2(v0, v1);
    }
}
__device__ __forceinline__ void pm_unit(const Params& P, int u) {
    const int g = u >> 4, rg = u & 15, tid = threadIdx.x;
    const float2* lampow = (const float2*)(P.ws + OFF_LAM); const float2* bbar = (const float2*)(P.ws + OFF_BBAR); bf16_t* pm = (bf16_t*)(P.ws + OFF_PM);
    for (int idx = tid; idx < 16 * (KU / 2); idx += 256) {
        const int rr = idx / (KU / 2), c = (idx % (KU / 2)) * 2, n = rg * 16 + rr, dir = n >> 7, p = (n & 127) >> 1, ri = n & 1;
        const int j = c >> 4, h2 = c & 15, m = dir == 0 ? LC - 1 - j : j;
        const float2 l = lampow[((size_t)((dir * 32 + g) * 64 + p)) * 65 + m]; const float2 b0 = bbar[((size_t)((dir * 32 + g) * 64 + p)) * 16 + h2], b1 = bbar[((size_t)((dir * 32 + g) * 64 + p)) * 16 + h2 + 1];
        const float v0 = ri ? (l.x * b0.y + l.y * b0.x) : (l.x * b0.x - l.y * b0.y), v1 = ri ? (l.x * b1.y + l.y * b1.x) : (l.x * b1.x - l.y * b1.y);
        *(unsigned*)(pm + ((size_t)(g * NS + n)) * KU + c) = pk2(v0, v1);
    }
}
__device__ __forceinline__ void phase1(const Params& P, int bid, int nb, unsigned char* lds) {
    constexpr int NT = DIN / 128, U_G = (T / 128) * NT, U_TQ = 32 * LC, U_PM = 32 * 16, NU = U_G + U_TQ + U_PM;
    for (int u = bid; u < NU; u += nb) {
        if (u < U_G) {
            const int nt = u % NT, mt = u / NT; EpiInProj epi{P.ws, mt * 128, nt * 128};
            gemm_tile((const bf16_t*)(P.ws + OFF_XN) + (size_t)mt * 128 * 1024, 1024, (const bf16_t*)(P.ws + OFF_WIN) + (size_t)nt * 128 * 1024, 1024, 1024, (bf16_t*)lds, epi);
        } else if (u < U_G + U_TQ) tq_unit(P, u - U_G);
        else pm_unit(P, u - U_G - U_TQ);
    }
}

__device__ __forceinline__ void na_unit(const Params& P, int u) {
    const int tid = threadIdx.x, lane = tid & 63, cb = tid >> 6, fr = lane & 15, fq = lane >> 4;
    const int r = u & 127, head = (u >> 7) & 7, b = u >> 10;
    const bf16_t* q = (const bf16_t*)(P.ws + OFF_Q); const bf16_t* k = (const bf16_t*)(P.ws + OFF_K); const bf16_t* vt = (const bf16_t*)(P.ws + OFF_VT); const bf16_t* zn = (const bf16_t*)(P.ws + OFF_ZN);
    bf16_t* mixin = (bf16_t*)(P.ws + OFF_MIXIN);
    const int rs = min(max(r - 4, 0), 120);
    const int cw0 = cb == 0 ? 0 : (cb == 1 ? 8 : (cb == 2 ? 24 : 32));
    const int c = cb * 16 + fr, cs = min(max(c - 8, 0), 48);
    const size_t tq = (size_t)b * SEQ + r * 64 + c;
    const bf16x8 qf0 = *(const bf16x8*)(q + tq * 512 + head * 64 + fq * 8), qf1 = *(const bf16x8*)(q + tq * 512 + head * 64 + 32 + fq * 8);
    f32x4 s[16];
    const int kcol = cw0 + (fr >> 2) * 8 + (fr & 3);
#pragma unroll
    for (int t = 0; t < 16; ++t) {
        const int i = t >> 1, odd = t & 1;
        const bf16_t* kp = k + ((size_t)b * SEQ + (rs + i) * 64 + kcol + odd * 4) * 512 + head * 64 + fq * 8;
        const bf16x8 k0 = *(const bf16x8*)kp, k1 = *(const bf16x8*)(kp + 32);
        f32x4 z = (f32x4){0.f, 0.f, 0.f, 0.f};
        z = __builtin_amdgcn_mfma_f32_16x16x32_bf16(k0, qf0, z, 0, 0, 0);
        z = __builtin_amdgcn_mfma_f32_16x16x32_bf16(k1, qf1, z, 0, 0, 0);
        s[t] = z;
    }
    const float* rp = P.rpb + head * 15 * 31;
    float mx = -3.0e38f;
#pragma unroll
    for (int t = 0; t < 16; ++t) {
        const int i = t >> 1, odd = t & 1, dr = rs + i - r + 7;
#pragma unroll
        for (int e = 0; e < 4; ++e) {
            const int ck = cw0 + fq * 8 + odd * 4 + e; const bool valid = (ck >= cs) && (ck < cs + 16);
            const int dc = min(max(ck - c + 15, 0), 30);
            const float bv = rp[dr * 31 + dc];
            const float sv = valid ? s[t][e] + bv : -3.0e38f;
            s[t][e] = sv; mx = fmaxf(mx, sv);
        }
    }
    mx = fmaxf(mx, __shfl_xor(mx, 16)); mx = fmaxf(mx, __shfl_xor(mx, 32));
    float l = 0.f;
#pragma unroll
    for (int t = 0; t < 16; ++t)
#pragma unroll
        for (int e = 0; e < 4; ++e) { const float pv = __expf(s[t][e] - mx); s[t][e] = pv; l += pv; }
    l += __shfl_xor(l, 16); l += __shfl_xor(l, 32);
    f32x4 o[4];
#pragma unroll
    for (int dt = 0; dt < 4; ++dt) o[dt] = (f32x4){0.f, 0.f, 0.f, 0.f};
#pragma unroll
    for (int kk = 0; kk < 8; ++kk) {
        u32x4 pw; pw.x = pk2(s[2 * kk][0], s[2 * kk][1]); pw.y = pk2(s[2 * kk][2], s[2 * kk][3]); pw.z = pk2(s[2 * kk + 1][0], s[2 * kk + 1][1]); pw.w = pk2(s[2 * kk + 1][2], s[2 * kk + 1][3]);
        const bf16x8 pf = __builtin_bit_cast(bf16x8, pw);
        const bf16_t* vp = vt + ((size_t)(b * 512 + head * 64 + fr)) * SEQ + (rs + kk) * 64 + cw0 + fq * 8;
#pragma unroll
        for (int dt = 0; dt < 4; ++dt) { const bf16x8 vf = *(const bf16x8*)(vp + (size_t)dt * 16 * SEQ); o[dt] = __builtin_amdgcn_mfma_f32_16x16x32_bf16(vf, pf, o[dt], 0, 0, 0); }
    }
    const float inv = 1.f / l;
#pragma unroll
    for (int dt = 0; dt < 4; ++dt) {
        const int d0 = head * 64 + dt * 16 + fq * 4; const f32x4 z = load_bf4(zn + tq * 512 + d0); f32x4 ov;
#pragma unroll
        for (int e = 0; e < 4; ++e) ov[e] = o[dt][e] * inv * z[e] * sigmoidf_(z[e]);
        store_bf4(mixin + tq * 1024 + 512 + d0, ov);
    }
}
__device__ __forceinline__ void phase2(const Params& P, int bid, int nb, unsigned char* lds) {
    constexpr int MT = NCH / 128, U_G = 32 * MT * 2, U_NA = 4 * 8 * 128, NU = U_G + U_NA;
    for (int u = bid; u < NU; u += nb) {
        if (u < U_G) {
            const int mt = u % MT, nt = (u / MT) & 1, g = u / (MT * 2); EpiS epi{(float*)(P.ws + OFF_S) + (size_t)g * NCH * NS, mt * 128, nt * 128};
            gemm_tile((const bf16_t*)(P.ws + OFF_UA) + ((size_t)g * NCH + mt * 128) * KA, KA, (const bf16_t*)(P.ws + OFF_PM) + ((size_t)g * NS + nt * 128) * KU, KU, KU, (bf16_t*)lds, epi);
        } else na_unit(P, u - U_G);
    }
}

__device__ __forceinline__ void phase3(const Params& P, int bid, int nb) {
    const float2* lampow = (const float2*)(P.ws + OFF_LAM); const float2* S = (const float2*)(P.ws + OFF_S); bf16_t* ua = (bf16_t*)(P.ws + OFF_UA);
    for (int sidx = bid * 256 + threadIdx.x; sidx < 4 * 2 * 32 * 64; sidx += nb * 256) {
        const int p = sidx & 63, g = (sidx >> 6) & 31, dir = (sidx >> 11) & 1, b = sidx >> 12;
        const float2 L = lampow[((size_t)((dir * 32 + g) * 64 + p)) * 65 + LC];
        float hr = 0.f, hi = 0.f;
        const float2* Sp = S + ((size_t)(g * NCH + b * CPB)) * (NS / 2) + dir * 64 + p;
        bf16_t* up = ua + ((size_t)(g * NCH + b * CPB)) * KA + KU + dir * 128 + p * 2;
        for (int cb0 = 0; cb0 < CPB; cb0 += 16) {
            float2 sv[16];
#pragma unroll
            for (int uu = 0; uu < 16; ++uu) { const int c = dir == 0 ? cb0 + uu : CPB - 1 - (cb0 + uu); sv[uu] = Sp[(size_t)c * (NS / 2)]; }
#pragma unroll
            for (int uu = 0; uu < 16; ++uu) {
                const int c = dir == 0 ? cb0 + uu : CPB - 1 - (cb0 + uu);
                *(unsigned*)(up + (size_t)c * KA) = pk2(hr, hi);
                const float tr = L.x * hr - L.y * hi + sv[uu].x; hi = L.x * hi + L.y * hr + sv[uu].y; hr = tr;
            }
        }
    }
}

__device__ __forceinline__ void phase4(const Params& P, int bid, int nb, unsigned char* lds) {
    constexpr int MT = NCH / 128, NT = KU / 128, NU = 32 * MT * NT;
    for (int u = bid; u < NU; u += nb) {
        const int mt = u % MT, nt = (u / MT) % NT, g = u / (MT * NT); EpiY epi{(bf16_t*)(P.ws + OFF_YS), g, mt * 128, nt * 128};
        gemm_tile((const bf16_t*)(P.ws + OFF_UA) + ((size_t)g * NCH + mt * 128) * KA, KA, (const bf16_t*)(P.ws + OFF_TQ) + ((size_t)g * KU + nt * 128) * KA, KA, KA, (bf16_t*)lds, epi);
    }
}
__device__ __forceinline__ void phase5(const Params& P, int bid, int nb, unsigned char* lds) {
    constexpr int NT = 4, NU = (T / 128) * NT;
    for (int u = bid; u < NU; u += nb) {
        const int nt = u % NT, mt = u / NT; EpiGlu epi{(const bf16_t*)(P.ws + OFF_YS), (const bf16_t*)(P.ws + OFF_ZS), P.b_glu, (bf16_t*)(P.ws + OFF_MIXIN), mt * 128, nt * 128};
        gemm_tile((const bf16_t*)(P.ws + OFF_YS) + (size_t)mt * 128 * 512, 512, (const bf16_t*)(P.ws + OFF_WGLU) + (size_t)nt * 128 * 512, 512, 512, (bf16_t*)lds, epi);
    }
}
__device__ __forceinline__ void phase6(const Params& P, int bid, int nb, unsigned char* lds) {
    constexpr int NT = 8, U1 = (T / 128) * NT, NU = 2 * U1;
    for (int u = bid; u < NU; u += nb) {
        if (u < U1) {
            const int nt = u % NT, mt = u / NT; EpiStoreSS epi{(bf16_t*)(P.ws + OFF_MIX), (float*)(P.ws + OFF_SS), mt * 128, nt * 128};
            gemm_tile((const bf16_t*)(P.ws + OFF_MIXIN) + (size_t)mt * 128 * 1024, 1024, (const bf16_t*)(P.ws + OFF_WOUT) + (size_t)nt * 128 * 1024, 1024, 1024, (bf16_t*)lds, epi);
        } else {
            const int v = u - U1, nt = v % NT, mt = v / NT; EpiStoreSS epi{(bf16_t*)(P.ws + OFF_ERAW), (float*)(P.ws + OFF_ESS), mt * 128, nt * 128};
            gemm_tile((const bf16_t*)(P.ws + OFF_PB) + (size_t)mt * 128 * 256, 256, (const bf16_t*)(P.ws + OFF_WPLE) + (size_t)nt * 128 * 256, 256, 256, (bf16_t*)lds, epi);
        }
    }
}
__device__ __forceinline__ void phase7(const Params& P, int bid, int nb) {
    const int tid = threadIdx.x, lane = tid & 63, wid = tid >> 6;
    const float* ss = (const float*)(P.ws + OFF_SS); const float* ess = (const float*)(P.ws + OFF_ESS); float* rstd = (float*)(P.ws + OFF_RSTD);
    const bf16_t* mix = (const bf16_t*)(P.ws + OFF_MIX); bf16_t* hb = (bf16_t*)(P.ws + OFF_HB);
    for (int u = bid; u < T / 4; u += nb) {
        const int t = u * 4 + wid;
        float v = lane < 16 ? ss[(size_t)t * 16 + lane] : (lane < 32 ? ess[(size_t)t * 16 + lane - 16] : 0.f);
        v += __shfl_xor(v, 1); v += __shfl_xor(v, 2); v += __shfl_xor(v, 4); v += __shfl_xor(v, 8);
        const float rp = rsqrtf(__shfl(v, 0) * (1.f / 1024.f) + EPS), re = rsqrtf(__shfl(v, 16) * (1.f / 1024.f) + EPS);
        if (lane == 0) { rstd[t] = rp; rstd[T + t] = re; }
#pragma unroll
        for (int j = 0; j < 4; ++j) {
            const int n = lane * 4 + 256 * j; const size_t off = (size_t)t * 1024 + n;
            const f32x4 xv = *(const f32x4*)(P.x + off), gp = *(const f32x4*)(P.norm_post + n), mv = load_bf4(mix + off); f32x4 h;
#pragma unroll
            for (int e = 0; e < 4; ++e) h[e] = xv[e] + mv[e] * rp * gp[e];
            store_bf4(hb + off, h);
        }
    }
}
__device__ __forceinline__ void phase8(const Params& P, int bid, int nb, unsigned char* lds) {
    constexpr int NT = 8, NU = (T / 128) * NT;
    for (int u = bid; u < NU; u += nb) {
        const int nt = u % NT, mt = u / NT;
        EpiFinal epi{P.x, (const bf16_t*)(P.ws + OFF_MIX), (const bf16_t*)(P.ws + OFF_ERAW), (const float*)(P.ws + OFF_RSTD), P.norm_post, P.ple_norm, P.out, mt * 128, nt * 128};
        gemm_tile((const bf16_t*)(P.ws + OFF_HB) + (size_t)mt * 128 * 1024, 1024, (const bf16_t*)(P.ws + OFF_WPG) + (size_t)nt * 128 * 1024, 1024, 1024, (bf16_t*)lds, epi);
    }
}

extern __shared__ __attribute__((aligned(16))) unsigned char dyn_lds[];

#if MK_MULTI
__global__ void __launch_bounds__(256, 2) k_phase(Params P, int ph) {
    const int bid = blockIdx.x, nb = gridDim.x;
    switch (ph) {
        case 0: phase0(P, bid, nb, dyn_lds); break;
        case 1: phase1(P, bid, nb, dyn_lds); break;
        case 2: phase2(P, bid, nb, dyn_lds); break;
        case 3: phase3(P, bid, nb); break;
        case 4: phase4(P, bid, nb, dyn_lds); break;
        case 5: phase5(P, bid, nb, dyn_lds); break;
        case 6: phase6(P, bid, nb, dyn_lds); break;
        case 7: phase7(P, bid, nb); break;
        default: phase8(P, bid, nb, dyn_lds); break;
    }
}
#else
__global__ void __launch_bounds__(256, 2) k_mega(Params P) {
    cg::grid_group grid = cg::this_grid();
    const int bid = blockIdx.x, nb = gridDim.x;
    phase0(P, bid, nb, dyn_lds); grid.sync();
    phase1(P, bid, nb, dyn_lds); grid.sync();
    phase2(P, bid, nb, dyn_lds); grid.sync();
    phase3(P, bid, nb); grid.sync();
    phase4(P, bid, nb, dyn_lds); grid.sync();
    phase5(P, bid, nb, dyn_lds); grid.sync();
    phase6(P, bid, nb, dyn_lds); grid.sync();
    phase7(P, bid, nb); grid.sync();
    phase8(P, bid, nb, dyn_lds);
}
#endif

extern "C" void kernel_launch(void* const* d_in, const int* in_sizes, int n_in, void* d_out, int out_size, void* d_ws, size_t ws_size, hipStream_t stream) {
    static int grid = 0;
    if (grid == 0) {
        if (n_in != 20 || ws_size < WS_END) { fprintf(stderr, "kernel_launch: unexpected n_in %d or ws_size %zu (< %zu)\n", n_in, ws_size, (size_t)WS_END); grid = -1; return; }
        int dev = 0, cus = 0, per_cu = 0;
        hipGetDevice(&dev); hipDeviceGetAttribute(&cus, hipDeviceAttributeMultiprocessorCount, dev);
#if MK_MULTI
        hipFuncSetAttribute((const void*)k_phase, hipFuncAttributeMaxDynamicSharedMemorySize, LDS_BYTES);
        hipOccupancyMaxActiveBlocksPerMultiprocessor(&per_cu, (const void*)k_phase, 256, LDS_BYTES);
#else
        hipFuncSetAttribute((const void*)k_mega, hipFuncAttributeMaxDynamicSharedMemorySize, LDS_BYTES);
        hipOccupancyMaxActiveBlocksPerMultiprocessor(&per_cu, (const void*)k_mega, 256, LDS_BYTES);
#endif
        if (per_cu < 1) per_cu = 1;
        if (per_cu > 2) per_cu = 2;
        grid = cus * per_cu;
        (void)hipGetLastError();
    }
    if (grid < 0) return;
    Params P{};
    const float** pp = (const float**)&P;
    for (int i = 0; i < 20; ++i) pp[i] = (const float*)d_in[i];
    P.out = (float*)d_out; P.ws = (unsigned char*)d_ws;
#if MK_MULTI
    for (int ph = 0; ph < 9; ++ph) hipLaunchKernelGGL(k_phase, dim3(grid), dim3(256), LDS_BYTES, stream, P, ph);
#else
    void* args[] = {&P};
    hipError_t e = hipLaunchCooperativeKernel((const void*)k_mega, dim3(grid), dim3(256), args, LDS_BYTES, stream);
    if (e != hipSuccess) fprintf(stderr, "cooperative launch failed: %s (grid %d)\n", hipGetErrorString(e), grid);
#endif
}
```

```cpp
#include <hip/hip_runtime.h>
#include <hip/hip_cooperative_groups.h>
#include <stdint.h>
#include <stdio.h>
namespace cg = cooperative_groups;

#ifndef MK_MULTI
#define MK_MULTI 0
#endif

typedef unsigned short bf16_t;
typedef short bf16x8 __attribute__((ext_vector_type(8)));
typedef float f32x4 __attribute__((ext_vector_type(4)));
typedef unsigned u32x4 __attribute__((ext_vector_type(4)));
typedef unsigned u32x2 __attribute__((ext_vector_type(2)));

constexpr int T = 32768, DM = 1024, SEQ = 8192, DPLE = 256, DIN = 3072;
constexpr int LC = 64;
constexpr int NCH = T / LC;
constexpr int CPB = SEQ / LC;
constexpr int KU = LC * 16;
constexpr int NS = 256;
constexpr int KA = KU + NS;
constexpr float EPS = 1e-6f;

constexpr size_t MB = 1ull << 20;
constexpr size_t OFF_XN = 0;
constexpr size_t OFF_MIXIN = OFF_XN;
constexpr size_t OFF_PB = OFF_XN + 64 * MB;
constexpr size_t OFF_WIN = OFF_PB + 16 * MB;
constexpr size_t OFF_WGLU = OFF_WIN + 6 * MB;
constexpr size_t OFF_WOUT = OFF_WGLU + 1 * MB;
constexpr size_t OFF_WPLE = OFF_WOUT + 2 * MB;
constexpr size_t OFF_WPG = OFF_WPLE + 1 * MB;
constexpr size_t OFF_UA = OFF_WPG + 2 * MB;
constexpr size_t OFF_ZS = OFF_UA + 40 * MB;
constexpr size_t OFF_Q = OFF_ZS + 32 * MB;
constexpr size_t OFF_K = OFF_Q + 32 * MB;
constexpr size_t OFF_VT = OFF_K + 32 * MB;
constexpr size_t OFF_ZN = OFF_VT + 32 * MB;
constexpr size_t OFF_MIX = OFF_Q;
constexpr size_t OFF_HB = OFF_VT;
constexpr size_t OFF_LAM = OFF_ZN + 32 * MB;
constexpr size_t OFF_BBAR = OFF_LAM + 3 * MB;
constexpr size_t OFF_KTAB = OFF_BBAR + 1 * MB;
constexpr size_t OFF_TQ = OFF_KTAB + 4 * MB;
constexpr size_t OFF_ERAW = OFF_TQ;
constexpr size_t OFF_PM = OFF_TQ + 80 * MB;
constexpr size_t OFF_S = OFF_PM + 16 * MB;
constexpr size_t OFF_YS = OFF_S + 16 * MB;
constexpr size_t OFF_SS = OFF_YS + 32 * MB;
constexpr size_t OFF_ESS = OFF_SS + 2 * MB;
constexpr size_t OFF_RSTD = OFF_ESS + 2 * MB;
constexpr size_t OFF_BAR = OFF_RSTD + 1 * MB;
constexpr size_t WS_END = OFF_BAR + 1 * MB;

struct Params {
    const float *x, *p, *norm_pre, *norm_post, *w_in, *a_re, *a_im, *log_dt, *b_re, *b_im, *c_re, *c_im, *ssm_d, *w_glu, *b_glu, *rpb, *w_out, *w_ple, *ple_norm, *w_pg;
    float* out;
    unsigned char* ws;
};

__device__ __forceinline__ unsigned pk2(float lo, float hi) { unsigned r; asm("v_cvt_pk_bf16_f32 %0, %1, %2" : "=v"(r) : "v"(lo), "v"(hi)); return r; }
__device__ __forceinline__ float bflo(unsigned w) { return __uint_as_float(w << 16); }
__device__ __forceinline__ float bfhi(unsigned w) { return __uint_as_float(w & 0xffff0000u); }
__device__ __forceinline__ void store_bf4(bf16_t* p, f32x4 v) { u32x2 w; w.x = pk2(v[0], v[1]); w.y = pk2(v[2], v[3]); *(u32x2*)p = w; }
__device__ __forceinline__ f32x4 load_bf4(const bf16_t* p) { u32x2 w = *(const u32x2*)p; f32x4 v; v[0] = bflo(w.x); v[1] = bfhi(w.x); v[2] = bflo(w.y); v[3] = bfhi(w.y); return v; }
__device__ __forceinline__ float sigmoidf_(float v) { return 1.f / (1.f + __expf(-v)); }
__device__ __forceinline__ float gelu_tanh(float v) { const float u = 0.7978845608028654f * (v + 0.044715f * v * v * v); const float th = 1.f - 2.f / (__expf(2.f * u) + 1.f); return 0.5f * v * (1.f + th); }

constexpr int LDS_ROW = 72;
constexpr int LDS_TILE = 128 * LDS_ROW;
constexpr int LDS_BYTES = 4 * LDS_TILE * 2;

template <class Epi>
__device__ __forceinline__ void gemm_tile(const bf16_t* __restrict__ A, int lda, const bf16_t* __restrict__ Bt, int ldb, int K, bf16_t* lds, const Epi& epi) {
    const int tid = threadIdx.x, lane = tid & 63, wid = tid >> 6, wm = wid >> 1, wn = wid & 1, fr = lane & 15, fq = lane >> 4;
    const int sr = tid >> 3, sc = (tid & 7) * 8;
    const bf16_t* ga = A + (size_t)sr * lda + sc;
    const bf16_t* gb = Bt + (size_t)sr * ldb + sc;
    f32x4 acc[4][4];
#pragma unroll
    for (int mi = 0; mi < 4; ++mi)
#pragma unroll
        for (int ni = 0; ni < 4; ++ni) acc[mi][ni] = (f32x4){0.f, 0.f, 0.f, 0.f};
    u32x4 ra[4], rb[4];
    const int nk = K >> 6;
#pragma unroll
    for (int i = 0; i < 4; ++i) { ra[i] = *(const u32x4*)(ga + (size_t)(32 * i) * lda); rb[i] = *(const u32x4*)(gb + (size_t)(32 * i) * ldb); }
#pragma unroll
    for (int i = 0; i < 4; ++i) { *(u32x4*)(lds + (sr + 32 * i) * LDS_ROW + sc) = ra[i]; *(u32x4*)(lds + 2 * LDS_TILE + (sr + 32 * i) * LDS_ROW + sc) = rb[i]; }
    __syncthreads();
    for (int kt = 0; kt < nk; ++kt) {
        const int buf = kt & 1;
        if (kt + 1 < nk) {
#pragma unroll
            for (int i = 0; i < 4; ++i) { ra[i] = *(const u32x4*)(ga + (size_t)(32 * i) * lda + (kt + 1) * 64); rb[i] = *(const u32x4*)(gb + (size_t)(32 * i) * ldb + (kt + 1) * 64); }
        }
        const bf16_t* as = lds + buf * LDS_TILE + (wm * 64 + fr) * LDS_ROW + fq * 8;
        const bf16_t* bs = lds + (2 + buf) * LDS_TILE + (wn * 64 + fr) * LDS_ROW + fq * 8;
#pragma unroll
        for (int ks = 0; ks < 2; ++ks) {
            bf16x8 af[4], bfr[4];
#pragma unroll
            for (int i = 0; i < 4; ++i) { af[i] = *(const bf16x8*)(as + i * 16 * LDS_ROW + ks * 32); bfr[i] = *(const bf16x8*)(bs + i * 16 * LDS_ROW + ks * 32); }
#pragma unroll
            for (int mi = 0; mi < 4; ++mi)
#pragma unroll
                for (int ni = 0; ni < 4; ++ni) acc[mi][ni] = __builtin_amdgcn_mfma_f32_16x16x32_bf16(bfr[ni], af[mi], acc[mi][ni], 0, 0, 0);
        }
        if (kt + 1 < nk) {
            const int nb = buf ^ 1;
#pragma unroll
            for (int i = 0; i < 4; ++i) { *(u32x4*)(lds + nb * LDS_TILE + (sr + 32 * i) * LDS_ROW + sc) = ra[i]; *(u32x4*)(lds + (2 + nb) * LDS_TILE + (sr + 32 * i) * LDS_ROW + sc) = rb[i]; }
        }
        __syncthreads();
    }
    epi(acc, wm * 64 + fr, wn * 64 + fq * 4);
}

struct EpiInProj {
    unsigned char* ws; int m0, n0;
    __device__ __forceinline__ void operator()(f32x4 (&acc)[4][4], int r0, int c0) const {
        const int sec = n0 >> 9;
#pragma unroll
        for (int mi = 0; mi < 4; ++mi) {
            const int t = m0 + r0 + mi * 16;
#pragma unroll
            for (int ni = 0; ni < 4; ++ni) {
                const int nn = (n0 + c0 + ni * 16) & 511; f32x4 v = acc[mi][ni];
                if (sec == 0) { const int g = nn >> 4, hh = nn & 15, ch = t / LC, j = t % LC; store_bf4((bf16_t*)(ws + OFF_UA) + ((size_t)(g * NCH + ch)) * KA + j * 16 + hh, v); }
                else if (sec == 1) store_bf4((bf16_t*)(ws + OFF_ZS) + (size_t)t * 512 + nn, v);
                else if (sec == 2) store_bf4((bf16_t*)(ws + OFF_Q) + (size_t)t * 512 + nn, v * 0.125f);
                else if (sec == 3) store_bf4((bf16_t*)(ws + OFF_K) + (size_t)t * 512 + nn, v);
                else if (sec == 4) { const int b = t >> 13, l = t & 8191; bf16_t* vt = (bf16_t*)(ws + OFF_VT) + ((size_t)(b * 512 + nn)) * SEQ + l; const unsigned w0 = pk2(v[0], v[1]), w1 = pk2(v[2], v[3]);
                    vt[0] = (bf16_t)(w0 & 0xffff); vt[SEQ] = (bf16_t)(w0 >> 16); vt[2 * SEQ] = (bf16_t)(w1 & 0xffff); vt[3 * SEQ] = (bf16_t)(w1 >> 16); }
                else store_bf4((bf16_t*)(ws + OFF_ZN) + (size_t)t * 512 + nn, v);
            }
        }
    }
};
struct EpiS {
    float* S; int m0, n0;
    __device__ __forceinline__ void operator()(f32x4 (&acc)[4][4], int r0, int c0) const {
#pragma unroll
        for (int mi = 0; mi < 4; ++mi)
#pragma unroll
            for (int ni = 0; ni < 4; ++ni) *(f32x4*)(S + (size_t)(m0 + r0 + mi * 16) * NS + n0 + c0 + ni * 16) = acc[mi][ni];
    }
};
struct EpiY {
    bf16_t* ys; int g, m0, n0;
    __device__ __forceinline__ void operator()(f32x4 (&acc)[4][4], int r0, int c0) const {
#pragma unroll
        for (int mi = 0; mi < 4; ++mi) {
            const int ch = m0 + r0 + mi * 16;
#pragma unroll
            for (int ni = 0; ni < 4; ++ni) {
                const int n = n0 + c0 + ni * 16, i = n >> 4, h = n & 15; f32x4 v = acc[mi][ni];
#pragma unroll
                for (int e = 0; e < 4; ++e) v[e] = gelu_tanh(v[e]);
                store_bf4(ys + ((size_t)ch * LC + i) * 512 + g * 16 + h, v);
            }
        }
    }
};
struct EpiGlu {
    const bf16_t* ys; const bf16_t* zs; const float* bglu; bf16_t* mixin; int m0, n0;
    __device__ __forceinline__ void operator()(f32x4 (&acc)[4][4], int r0, int c0) const {
#pragma unroll
        for (int mi = 0; mi < 4; ++mi) {
            const int t = m0 + r0 + mi * 16;
#pragma unroll
            for (int ni = 0; ni < 4; ++ni) {
                const int n = n0 + c0 + ni * 16; const f32x4 bv = *(const f32x4*)(bglu + n);
                const f32x4 y = load_bf4(ys + (size_t)t * 512 + n), z = load_bf4(zs + (size_t)t * 512 + n); f32x4 o;
#pragma unroll
                for (int e = 0; e < 4; ++e) o[e] = y[e] * sigmoidf_(acc[mi][ni][e] + bv[e]) * z[e] * sigmoidf_(z[e]);
                store_bf4(mixin + (size_t)t * 1024 + n, o);
            }
        }
    }
};
struct EpiStoreSS {
    bf16_t* dst; float* ss; int m0, n0;
    __device__ __forceinline__ void operator()(f32x4 (&acc)[4][4], int r0, int c0) const {
#pragma unroll
        for (int mi = 0; mi < 4; ++mi) {
            const int t = m0 + r0 + mi * 16; float s = 0.f;
#pragma unroll
            for (int ni = 0; ni < 4; ++ni) { const f32x4 v = acc[mi][ni]; s += (v[0] * v[0] + v[1] * v[1]) + (v[2] * v[2] + v[3] * v[3]); store_bf4(dst + (size_t)t * 1024 + n0 + c0 + ni * 16, v); }
            s += __shfl_xor(s, 16); s += __shfl_xor(s, 32);
            if ((threadIdx.x & 48) == 0) ss[(size_t)t * 16 + (n0 >> 7) * 2 + (c0 >> 6)] = s;
        }
    }
};
struct EpiFinal {
    const float* x; const bf16_t* mix; const bf16_t* eraw; const float* rstd; const float* gpost; const float* gple; float* out; int m0, n0;
    __device__ __forceinline__ void operator()(f32x4 (&acc)[4][4], int r0, int c0) const {
#pragma unroll
        for (int mi = 0; mi < 4; ++mi) {
            const int t = m0 + r0 + mi * 16; const float rp = rstd[t], re = rstd[T + t];
#pragma unroll
            for (int ni = 0; ni < 4; ++ni) {
                const int n = n0 + c0 + ni * 16; const size_t off = (size_t)t * 1024 + n;
                const f32x4 xv = *(const f32x4*)(x + off), gp = *(const f32x4*)(gpost + n), ge = *(const f32x4*)(gple + n);
                const f32x4 mv = load_bf4(mix + off), ev = load_bf4(eraw + off); f32x4 o;
#pragma unroll
                for (int e = 0; e < 4; ++e) { const float h = xv[e] + mv[e] * rp * gp[e]; o[e] = h + sigmoidf_(acc[mi][ni][e]) * (ev[e] * re * ge[e]); }
                *(f32x4*)(out + off) = o;
            }
        }
    }
};

__device__ __forceinline__ void ktab_unit(const Params& P, int u, float* ldsf) {
    const int dir = u >> 8, g = (u >> 3) & 31, mr = u & 7, tid = threadIdx.x;
    float2* lp = (float2*)ldsf;
    float2* bb = lp + 64 * 65;
    float2* lampow = (float2*)(P.ws + OFF_LAM); float2* bbar = (float2*)(P.ws + OFF_BBAR); float* ktab = (float*)(P.ws + OFF_KTAB);
    if (tid < 64) {
        const int p = tid, idx = (dir * 32 + g) * 64 + p;
        const float ar = P.a_re[idx], ai = P.a_im[idx], dt = expf(P.log_dt[dir * 32 + g]);
        const float mag = expf(dt * ar), ang = dt * ai; const float lr = mag * cosf(ang), li = mag * sinf(ang);
        const float nr = lr - 1.f, ni = li, den = ar * ar + ai * ai;
        const float cr = (nr * ar + ni * ai) / den, ci = (ni * ar - nr * ai) / den;
        float pr = 1.f, pi = 0.f;
        for (int m = 0; m <= 64; ++m) { lp[p * 65 + m] = make_float2(pr, pi); if (mr == 0) lampow[(size_t)idx * 65 + m] = make_float2(pr, pi); const float tt = pr * lr - pi * li; pi = pr * li + pi * lr; pr = tt; }
        for (int h = 0; h < 16; ++h) { const float br = P.b_re[idx * 16 + h], bi = P.b_im[idx * 16 + h]; const float2 v = make_float2(cr * br - ci * bi, cr * bi + ci * br); bb[p * 16 + h] = v; if (mr == 0) bbar[(size_t)idx * 16 + h] = v; }
    }
    __syncthreads();
    const int h = tid >> 4, h2 = tid & 15;
    const float* crp = P.c_re + ((dir * 32 + g) * 16 + h) * 64; const float* cip = P.c_im + ((dir * 32 + g) * 16 + h) * 64;
    for (int mm = 0; mm < 8; ++mm) {
        const int m = mr * 8 + mm; float s = 0.f;
        for (int p = 0; p < 64; ++p) { const float2 l = lp[p * 65 + m], b = bb[p * 16 + h2]; s += crp[p] * (l.x * b.x - l.y * b.y) - cip[p] * (l.x * b.y + l.y * b.x); }
        ktab[((size_t)((dir * 32 + g) * 64 + m)) * 256 + h * 16 + h2] = s;
    }
    __syncthreads();
}
__device__ __forceinline__ void transpose_unit(const float* W, int K, int N, const float* gain, bf16_t* Wt, int item, float* ldsf) {
    const int nblk = N / 64, kb = item / nblk, nbk = item % nblk, k0 = kb * 64, n0 = nbk * 64, tid = threadIdx.x;
#pragma unroll 4
    for (int i = 0; i < 16; ++i) { const int kk = i * 4 + (tid >> 6), nn = tid & 63; float v = W[(size_t)(k0 + kk) * N + n0 + nn]; if (gain) v *= gain[k0 + kk]; ldsf[kk * 65 + nn] = v; }
    __syncthreads();
#pragma unroll 4
    for (int i = 0; i < 8; ++i) { const int nn = i * 8 + (tid >> 5), kk = (tid & 31) * 2; *(unsigned*)(Wt + (size_t)(n0 + nn) * K + k0 + kk) = pk2(ldsf[kk * 65 + nn], ldsf[(kk + 1) * 65 + nn]); }
    __syncthreads();
}
__device__ __forceinline__ float wave_sum(float v) {
#pragma unroll
    for (int o = 1; o < 64; o <<= 1) v += __shfl_xor(v, o);
    return v;
}
__device__ __forceinline__ void phase0(const Params& P, int bid, int nb, unsigned char* lds) {
    float* ldsf = (float*)lds;
    constexpr int U_K = 512, I_IN = 16 * 48, I_GLU = 64, I_OUT = 256, I_PLE = 4 * 16, I_PG = 256, U_T = I_IN + I_GLU + I_OUT + I_PLE + I_PG, U_X = T / 4, U_P = (T * DPLE) / 2048;
    constexpr int NU = U_K + U_T + U_X + U_P;
    const int tid = threadIdx.x, lane = tid & 63, wid = tid >> 6;
    for (int u = bid; u < NU; u += nb) {
        int r = u;
        if (r < U_K) { ktab_unit(P, r, ldsf); continue; } r -= U_K;
        if (r < U_T) {
            if (r < I_IN) { transpose_unit(P.w_in, 1024, 3072, P.norm_pre, (bf16_t*)(P.ws + OFF_WIN), r, ldsf); continue; } r -= I_IN;
            if (r < I_GLU) { transpose_unit(P.w_glu, 512, 512, nullptr, (bf16_t*)(P.ws + OFF_WGLU), r, ldsf); continue; } r -= I_GLU;
            if (r < I_OUT) { transpose_unit(P.w_out, 1024, 1024, nullptr, (bf16_t*)(P.ws + OFF_WOUT), r, ldsf); continue; } r -= I_OUT;
            if (r < I_PLE) { transpose_unit(P.w_ple, 256, 1024, nullptr, (bf16_t*)(P.ws + OFF_WPLE), r, ldsf); continue; } r -= I_PLE;
            transpose_unit(P.w_pg, 1024, 1024, nullptr, (bf16_t*)(P.ws + OFF_WPG), r, ldsf); continue;
        }
        r -= U_T;
        if (r < U_X) {
            const int t = r * 4 + wid; const f32x4* xr = (const f32x4*)(P.x + (size_t)t * 1024) + lane; f32x4 v[4]; float s = 0.f;
#pragma unroll
            for (int j = 0; j < 4; ++j) { v[j] = xr[64 * j]; s += (v[j][0] * v[j][0] + v[j][1] * v[j][1]) + (v[j][2] * v[j][2] + v[j][3] * v[j][3]); }
            const float rs = rsqrtf(wave_sum(s) * (1.f / 1024.f) + EPS);
            bf16_t* o = (bf16_t*)(P.ws + OFF_XN) + (size_t)t * 1024 + lane * 4;
#pragma unroll
            for (int j = 0; j < 4; ++j) store_bf4(o + 256 * j, v[j] * rs);
            continue;
        }
        r -= U_X;
        {
            const size_t e0 = (size_t)r * 2048 + tid * 8; const f32x4 a = *(const f32x4*)(P.p + e0), b = *(const f32x4*)(P.p + e0 + 4);
            u32x4 w; w.x = pk2(a[0], a[1]); w.y = pk2(a[2], a[3]); w.z = pk2(b[0], b[1]); w.w = pk2(b[2], b[3]);
            *(u32x4*)((bf16_t*)(P.ws + OFF_PB) + e0) = w;
        }
    }
}

__device__ __forceinline__ void tq_unit(const Params& P, int u) {
    const int g = u / LC, i = u % LC, tid = threadIdx.x;
    const float* ktab = (const float*)(P.ws + OFF_KTAB); const float2* lampow = (const float2*)(P.ws + OFF_LAM); bf16_t* tq = (bf16_t*)(P.ws + OFF_TQ);
    for (int idx = tid; idx < 16 * (KA / 2); idx += 256) {
        const int h = idx / (KA / 2), c = (idx % (KA / 2)) * 2; float v0, v1;
        if (c < KU) {
            const int j = c >> 4, h2 = c & 15;
            if (i > j) { const float* kp = ktab + ((size_t)((0 * 32 + g) * 64 + (i - j))) * 256 + h * 16 + h2; v0 = kp[0]; v1 = kp[1]; }
            else if (j > i) { const float* kp = ktab + ((size_t)((1 * 32 + g) * 64 + (j - i))) * 256 + h * 16 + h2; v0 = kp[0]; v1 = kp[1]; }
            else { const float* kf = ktab + ((size_t)((0 * 32 + g) * 64)) * 256 + h * 16 + h2; const float* kb = ktab + ((size_t)((1 * 32 + g) * 64)) * 256 + h * 16 + h2; const float dd = P.ssm_d[g * 16 + h];
                v0 = kf[0] + kb[0] + (h == h2 ? dd : 0.f); v1 = kf[1] + kb[1] + (h == h2 + 1 ? dd : 0.f); }
        } else {
            const int n = c - KU, dir = n >> 7, p = (n & 127) >> 1, m = dir == 0 ? i + 1 : LC - i;
            const float2 l = lampow[((size_t)((dir * 32 + g) * 64 + p)) * 65 + m]; const float cr = P.c_re[((dir * 32 + g) * 16 + h) * 64 + p], ci = P.c_im[((dir * 32 + g) * 16 + h) * 64 + p];
            v0 = cr * l.x - ci * l.y; v1 = -(cr * l.y + ci * l.x);
        }
        *(unsigned*)(tq + ((size_t)(g * KU + i * 16 + h)) * KA + c) = pk2(v0, v1);
    }
}
__device__ __forceinline__ void pm_unit(const Params& P, int u) {
    const int g = u >> 4, rg = u & 15, tid = threadIdx.x;
    const float2* lampow = (const float2*)(P.ws + OFF_LAM); const float2* bbar = (const float2*)(P.ws + OFF_BBAR); bf16_t* pm = (bf16_t*)(P.ws + OFF_PM);
    for (int idx = tid; idx < 16 * (KU / 2); idx += 256) {
        const int rr = idx / (KU / 2), c = (idx % (KU / 2)) * 2, n = rg * 16 + rr, dir = n >> 7, p = (n & 127) >> 1, ri = n & 1;
        const int j = c >> 4, h2 = c & 15, m = dir == 0 ? LC - 1 - j : j;
        const float2 l = lampow[((size_t)((dir * 32 + g) * 64 + p)) * 65 + m]; const float2 b0 = bbar[((size_t)((dir * 32 + g) * 64 + p)) * 16 + h2], b1 = bbar[((size_t)((dir * 32 + g) * 64 + p)) * 16 + h2 + 1];
        const float v0 = ri ? (l.x * b0.y + l.y * b0.x) : (l.x * b0.x - l.y * b0.y), v1 = ri ? (l.x * b1.y + l.y * b1.x) : (l.x * b1.x - l.y * b1.y);
        *(unsigned*)(pm + ((size_t)(g * NS + n)) * KU + c) = pk2(v0, v1);
    }
}
__device__ __forceinline__ void phase1(const Params& P, int bid, int nb, unsigned char* lds) {
    constexpr int NT = DIN / 128, U_G = (T / 128) * NT, U_TQ = 32 * LC, U_PM = 32 * 16, NU = U_G + U_TQ + U_PM;
    for (int u = bid; u < NU; u += nb) {
        if (u < U_G) {
            const int nt = u % NT, mt = u / NT; EpiInProj epi{P.ws, mt * 128, nt * 128};
            gemm_tile((const bf16_t*)(P.ws + OFF_XN) + (size_t)mt * 128 * 1024, 1024, (const bf16_t*)(P.ws + OFF_WIN) + (size_t)nt * 128 * 1024, 1024, 1024, (bf16_t*)lds, epi);
        } else if (u < U_G + U_TQ) tq_unit(P, u - U_G);
        else pm_unit(P, u - U_G - U_TQ);
    }
}

__device__ __forceinline__ void na_unit(const Params& P, int u) {
    const int tid = threadIdx.x, lane = tid & 63, cb = tid >> 6, fr = lane & 15, fq = lane >> 4;
    const int r = u & 127, head = (u >> 7) & 7, b = u >> 10;
    const bf16_t* q = (const bf16_t*)(P.ws + OFF_Q); const bf16_t* k = (const bf16_t*)(P.ws + OFF_K); const bf16_t* vt = (const bf16_t*)(P.ws + OFF_VT); const bf16_t* zn = (const bf16_t*)(P.ws + OFF_ZN);
    bf16_t* mixin = (bf16_t*)(P.ws + OFF_MIXIN);
    const int rs = min(max(r - 4, 0), 120);
    const int cw0 = cb == 0 ? 0 : (cb == 1 ? 8 : (cb == 2 ? 24 : 32));
    const int c = cb * 16 + fr, cs = min(max(c - 8, 0), 48);
    const size_t tq = (size_t)b * SEQ + r * 64 + c;
    const bf16x8 qf0 = *(const bf16x8*)(q + tq * 512 + head * 64 + fq * 8), qf1 = *(const bf16x8*)(q + tq * 512 + head * 64 + 32 + fq * 8);
    f32x4 s[16];
    const int kcol = cw0 + (fr >> 2) * 8 + (fr & 3);
#pragma unroll
    for (int t = 0; t < 16; ++t) {
        const int i = t >> 1, odd = t & 1;
        const bf16_t* kp = k + ((size_t)b * SEQ + (rs + i) * 64 + kcol + odd * 4) * 512 + head * 64 + fq * 8;
        const bf16x8 k0 = *(const bf16x8*)kp, k1 = *(const bf16x8*)(kp + 32);
        f32x4 z = (f32x4){0.f, 0.f, 0.f, 0.f};
        z = __builtin_amdgcn_mfma_f32_16x16x32_bf16(k0, qf0, z, 0, 0, 0);
        z = __builtin_amdgcn_mfma_f32_16x16x32_bf16(k1, qf1, z, 0, 0, 0);
        s[t] = z;
    }
    const float* rp = P.rpb + head * 15 * 31;
    float mx = -3.0e38f;
#pragma unroll
    for (int t = 0; t < 16; ++t) {
        const int i = t >> 1, odd = t & 1, dr = rs + i - r + 7;
#pragma unroll
        for (int e = 0; e < 4; ++e) {
            const int ck = cw0 + fq * 8 + odd * 4 + e; const bool valid = (ck >= cs) && (ck < cs + 16);
            const int dc = min(max(ck - c + 15, 0), 30);
            const float bv = rp[dr * 31 + dc];
            const float sv = valid ? s[t][e] + bv : -3.0e38f;
            s[t][e] = sv; mx = fmaxf(mx, sv);
        }
    }
    mx = fmaxf(mx, __shfl_xor(mx, 16)); mx = fmaxf(mx, __shfl_xor(mx, 32));
    float l = 0.f;
#pragma unroll
    for (int t = 0; t < 16; ++t)
#pragma unroll
        for (int e = 0; e < 4; ++e) { const float pv = __expf(s[t][e] - mx); s[t][e] = pv; l += pv; }
    l += __shfl_xor(l, 16); l += __shfl_xor(l, 32);
    f32x4 o[4];
#pragma unroll
    for (int dt = 0; dt < 4; ++dt) o[dt] = (f32x4){0.f, 0.f, 0.f, 0.f};
#pragma unroll
    for (int kk = 0; kk < 8; ++kk) {
        u32x4 pw; pw.x = pk2(s[2 * kk][0], s[2 * kk][1]); pw.y = pk2(s[2 * kk][2], s[2 * kk][3]); pw.z = pk2(s[2 * kk + 1][0], s[2 * kk + 1][1]); pw.w = pk2(s[2 * kk + 1][2], s[2 * kk + 1][3]);
        const bf16x8 pf = __builtin_bit_cast(bf16x8, pw);
        const bf16_t* vp = vt + ((size_t)(b * 512 + head * 64 + fr)) * SEQ + (rs + kk) * 64 + cw0 + fq * 8;
#pragma unroll
        for (int dt = 0; dt < 4; ++dt) { const bf16x8 vf = *(const bf16x8*)(vp + (size_t)dt * 16 * SEQ); o[dt] = __builtin_amdgcn_mfma_f32_16x16x32_bf16(vf, pf, o[dt], 0, 0, 0); }
    }
    const float inv = 1.f / l;
#pragma unroll
    for (int dt = 0; dt < 4; ++dt) {
        const int d0 = head * 64 + dt * 16 + fq * 4; const f32x4 z = load_bf4(zn + tq * 512 + d0); f32x4 ov;
#pragma unroll
        for (int e = 0; e < 4; ++e) ov[e] = o[dt][e] * inv * z[e] * sigmoidf_(z[e]);
        store_bf4(mixin + tq * 1024 + 512 + d0, ov);
    }
}
__device__ __forceinline__ void phase2(const Params& P, int bid, int nb, unsigned char* lds) {
    constexpr int MT = NCH / 128, U_G = 32 * MT * 2, U_NA = 4 * 8 * 128, NU = U_G + U_NA;
    for (int u = bid; u < NU; u += nb) {
        if (u < U_G) {
            const int mt = u % MT, nt = (u / MT) & 1, g = u / (MT * 2); EpiS epi{(float*)(P.ws + OFF_S) + (size_t)g * NCH * NS, mt * 128, nt * 128};
            gemm_tile((const bf16_t*)(P.ws + OFF_UA) + ((size_t)g * NCH + mt * 128) * KA, KA, (const bf16_t*)(P.ws + OFF_PM) + ((size_t)g * NS + nt * 128) * KU, KU, KU, (bf16_t*)lds, epi);
        } else na_unit(P, u - U_G);
    }
}

__device__ __forceinline__ void phase3(const Params& P, int bid, int nb) {
    const float2* lampow = (const float2*)(P.ws + OFF_LAM); const float2* S = (const float2*)(P.ws + OFF_S); bf16_t* ua = (bf16_t*)(P.ws + OFF_UA);
    for (int sidx = bid * 256 + threadIdx.x; sidx < 4 * 2 * 32 * 64; sidx += nb * 256) {
        const int p = sidx & 63, g = (sidx >> 6) & 31, dir = (sidx >> 11) & 1, b = sidx >> 12;
        const float2 L = lampow[((size_t)((dir * 32 + g) * 64 + p)) * 65 + LC];
        float hr = 0.f, hi = 0.f;
        const float2* Sp = S + ((size_t)(g * NCH + b * CPB)) * (NS / 2) + dir * 64 + p;
        bf16_t* up = ua + ((size_t)(g * NCH + b * CPB)) * KA + KU + dir * 128 + p * 2;
        for (int cb0 = 0; cb0 < CPB; cb0 += 16) {
            float2 sv[16];
#pragma unroll
            for (int uu = 0; uu < 16; ++uu) { const int c = dir == 0 ? cb0 + uu : CPB - 1 - (cb0 + uu); sv[uu] = Sp[(size_t)c * (NS / 2)]; }
#pragma unroll
            for (int uu = 0; uu < 16; ++uu) {
                const int c = dir == 0 ? cb0 + uu : CPB - 1 - (cb0 + uu);
                *(unsigned*)(up + (size_t)c * KA) = pk2(hr, hi);
                const float tr = L.x * hr - L.y * hi + sv[uu].x; hi = L.x * hi + L.y * hr + sv[uu].y; hr = tr;
            }
        }
    }
}

__device__ __forceinline__ void phase4(const Params& P, int bid, int nb, unsigned char* lds) {
    constexpr int MT = NCH / 128, NT = KU / 128, NU = 32 * MT * NT;
    for (int u = bid; u < NU; u += nb) {
        const int mt = u % MT, nt = (u / MT) % NT, g = u / (MT * NT); EpiY epi{(bf16_t*)(P.ws + OFF_YS), g, mt * 128, nt * 128};
        gemm_tile((const bf16_t*)(P.ws + OFF_UA) + ((size_t)g * NCH + mt * 128) * KA, KA, (const bf16_t*)(P.ws + OFF_TQ) + ((size_t)g * KU + nt * 128) * KA, KA, KA, (bf16_t*)lds, epi);
    }
}
__device__ __forceinline__ void phase5(const Params& P, int bid, int nb, unsigned char* lds) {
    constexpr int NT = 4, NU = (T / 128) * NT;
    for (int u = bid; u < NU; u += nb) {
        const int nt = u % NT, mt = u / NT; EpiGlu epi{(const bf16_t*)(P.ws + OFF_YS), (const bf16_t*)(P.ws + OFF_ZS), P.b_glu, (bf16_t*)(P.ws + OFF_MIXIN), mt * 128, nt * 128};
        gemm_tile((const bf16_t*)(P.ws + OFF_YS) + (size_t)mt * 128 * 512, 512, (const bf16_t*)(P.ws + OFF_WGLU) + (size_t)nt * 128 * 512, 512, 512, (bf16_t*)lds, epi);
    }
}
__device__ __forceinline__ void phase6(const Params& P, int bid, int nb, unsigned char* lds) {
    constexpr int NT = 8, U1 = (T / 128) * NT, NU = 2 * U1;
    for (int u = bid; u < NU; u += nb) {
        if (u < U1) {
            const int nt = u % NT, mt = u / NT; EpiStoreSS epi{(bf16_t*)(P.ws + OFF_MIX), (float*)(P.ws + OFF_SS), mt * 128, nt * 128};
            gemm_tile((const bf16_t*)(P.ws + OFF_MIXIN) + (size_t)mt * 128 * 1024, 1024, (const bf16_t*)(P.ws + OFF_WOUT) + (size_t)nt * 128 * 1024, 1024, 1024, (bf16_t*)lds, epi);
        } else {
            const int v = u - U1, nt = v % NT, mt = v / NT; EpiStoreSS epi{(bf16_t*)(P.ws + OFF_ERAW), (float*)(P.ws + OFF_ESS), mt * 128, nt * 128};
            gemm_tile((const bf16_t*)(P.ws + OFF_PB) + (size_t)mt * 128 * 256, 256, (const bf16_t*)(P.ws + OFF_WPLE) + (size_t)nt * 128 * 256, 256, 256, (bf16_t*)lds, epi);
        }
    }
}
__device__ __forceinline__ void phase7(const Params& P, int bid, int nb) {
    const int tid = threadIdx.x, lane = tid & 63, wid = tid >> 6;
    const float* ss = (const float*)(P.ws + OFF_SS); const float* ess = (const float*)(P.ws + OFF_ESS); float* rstd = (float*)(P.ws + OFF_RSTD);
    const bf16_t* mix = (const bf16_t*)(P.ws + OFF_MIX); bf16_t* hb = (bf16_t*)(P.ws + OFF_HB);
    for (int u = bid; u < T / 4; u += nb) {
        const int t = u * 4 + wid;
        float v = lane < 16 ? ss[(size_t)t * 16 + lane] : (lane < 32 ? ess[(size_t)t * 16 + lane - 16] : 0.f);
        v += __shfl_xor(v, 1); v += __shfl_xor(v, 2); v += __shfl_xor(v, 4); v += __shfl_xor(v, 8);
        const float rp = rsqrtf(__shfl(v, 0) * (1.f / 1024.f) + EPS), re = rsqrtf(__shfl(v, 16) * (1.f / 1024.f) + EPS);
        if (lane == 0) { rstd[t] = rp; rstd[T + t] = re; }
#pragma unroll
        for (int j = 0; j < 4; ++j) {
            const int n = lane * 4 + 256 * j; const size_t off = (size_t)t * 1024 + n;
            const f32x4 xv = *(const f32x4*)(P.x + off), gp = *(const f32x4*)(P.norm_post + n), mv = load_bf4(mix + off); f32x4 h;
#pragma unroll
            for (int e = 0; e < 4; ++e) h[e] = xv[e] + mv[e] * rp * gp[e];
            store_bf4(hb + off, h);
        }
    }
}
__device__ __forceinline__ void phase8(const Params& P, int bid, int nb, unsigned char* lds) {
    constexpr int NT = 8, NU = (T / 128) * NT;
    for (int u = bid; u < NU; u += nb) {
        const int nt = u % NT, mt = u / NT;
        EpiFinal epi{P.x, (const bf16_t*)(P.ws + OFF_MIX), (const bf16_t*)(P.ws + OFF_ERAW), (const float*)(P.ws + OFF_RSTD), P.norm_post, P.ple_norm, P.out, mt * 128, nt * 128};
        gemm_tile((const bf16_t*)(P.ws + OFF_HB) + (size_t)mt * 128 * 1024, 1024, (const bf16_t*)(P.ws + OFF_WPG) + (size_t)nt * 128 * 1024, 1024, 1024, (bf16_t*)lds, epi);
    }
}

#define XB_TMO      128
#define XB_XCNT(j)  (256  + 64 * (j))
#define XB_XSUB(j)  (1280 + 64 * (j))
#define XB_XGEN(j)  (2304 + 64 * (j))
#define XB_TOP      3328
#define XB_TOPGEN   3392
#define XCD_BAR_WORDS 3456
#define XB_SPIN_CAP (1u << 20)
#define LAS __attribute__((address_space(3)))
__device__ __forceinline__ unsigned xb_ld(unsigned* p)              { return __hip_atomic_load(p, __ATOMIC_RELAXED, __HIP_MEMORY_SCOPE_AGENT); }
__device__ __forceinline__ unsigned xb_add(unsigned* p, unsigned v) { return __hip_atomic_fetch_add(p, v, __ATOMIC_RELAXED, __HIP_MEMORY_SCOPE_AGENT); }
__device__ __forceinline__ unsigned xb_xcc_id() { return (unsigned)__builtin_amdgcn_s_getreg((3 << 11) | 20) & 0xFu; }
#define XB_SPIN(cond, bar) do { unsigned _sp = 0; while (cond) { __builtin_amdgcn_s_sleep(1); \
    if ((++_sp & 255u) == 0u) { if (xb_ld(&(bar)[XB_TMO])) break; if (_sp > XB_SPIN_CAP) { atomicAdd(&(bar)[XB_TMO], 1u); break; } } } } while (0)
struct XcdBarrier { unsigned* bar; unsigned x; volatile LAS unsigned* st; };
__device__ __forceinline__ XcdBarrier xcd_barrier_post(unsigned* bar, volatile LAS unsigned* st) {
    XcdBarrier b; b.bar = bar; b.x = xb_xcc_id(); b.st = st;
    if (threadIdx.x == 0) (void)xb_add(&bar[XB_XCNT(b.x)], 1u);
    return b;
}
__device__ __forceinline__ void xcd_barrier_complete(unsigned* bar, unsigned x, unsigned& nloc, unsigned& nx) {
    const unsigned G = gridDim.x * gridDim.y * gridDim.z;
    unsigned sum, cnt, mine, sp = 0u;
    for (;;) {
        sum = 0u; cnt = 0u; mine = 0u;
#pragma unroll
        for (unsigned j = 0; j < 16; ++j) { const unsigned c = xb_ld(&bar[XB_XCNT(j)]); sum += c; cnt += (c > 0u) ? 1u : 0u; mine = (j == x) ? c : mine; }
        if (sum == G) break;
        __builtin_amdgcn_s_sleep(1);
        if ((++sp & 255u) == 0u) { if (xb_ld(&bar[XB_TMO])) break; if (sp > XB_SPIN_CAP) { atomicAdd(&bar[XB_TMO], 1u); break; } }
    }
    nloc = mine > 0u ? mine : 1u; nx = cnt > 0u ? cnt : 1u;
}
__device__ __forceinline__ void xcd_barrier(const XcdBarrier& b) {
    asm volatile("s_waitcnt vmcnt(0)" ::: "memory");
    __syncthreads();
    if (threadIdx.x == 0) {
        unsigned* bar = b.bar;
        __builtin_amdgcn_s_waitcnt(0);
        unsigned nloc = b.st[0], nx = b.st[1];
        if (nloc == 0u) { xcd_barrier_complete(bar, b.x, nloc, nx); b.st[0] = nloc; b.st[1] = nx; }
        const unsigned old = xb_add(&bar[XB_XSUB(b.x)], 1u);
        const unsigned gen = old / nloc;
        if (old + 1u == (gen + 1u) * nloc) {
            __builtin_amdgcn_fence(__ATOMIC_RELEASE, "agent");
            asm volatile("s_waitcnt vmcnt(0)" ::: "memory");
            const unsigned og = xb_add(&bar[XB_TOP], 1u);
            const unsigned tg = og / nx;
            if (og + 1u == (tg + 1u) * nx) xb_add(&bar[XB_TOPGEN], 1u);
            else XB_SPIN(xb_ld(&bar[XB_TOPGEN]) == tg, bar);
            __builtin_amdgcn_fence(__ATOMIC_ACQUIRE, "agent");
            xb_add(&bar[XB_XGEN(b.x)], 1u);
            asm volatile("s_waitcnt vmcnt(0)" ::: "memory");
        } else {
            XB_SPIN(xb_ld(&bar[XB_XGEN(b.x)]) == gen, bar);
            __builtin_amdgcn_fence(__ATOMIC_ACQUIRE, "agent");
            asm volatile("s_waitcnt vmcnt(0)" ::: "memory");
        }
    }
    __syncthreads();
}

extern __shared__ __attribute__((aligned(16))) unsigned char dyn_lds[];

#if MK_MULTI
__global__ void __launch_bounds__(256, 2) k_phase(Params P, int ph) {
    const int bid = blockIdx.x, nb = gridDim.x;
    switch (ph) {
        case 0: phase0(P, bid, nb, dyn_lds); break;
        case 1: phase1(P, bid, nb, dyn_lds); break;
        case 2: phase2(P, bid, nb, dyn_lds); break;
        case 3: phase3(P, bid, nb); break;
        case 4: phase4(P, bid, nb, dyn_lds); break;
        case 5: phase5(P, bid, nb, dyn_lds); break;
        case 6: phase6(P, bid, nb, dyn_lds); break;
        case 7: phase7(P, bid, nb); break;
        default: phase8(P, bid, nb, dyn_lds); break;
    }
}
#else
__global__ void __launch_bounds__(256, 2) k_mega(Params P) {
    __shared__ uint4 xb_words;
    if (threadIdx.x == 0) xb_words = make_uint4(0u, 0u, 0u, 0u);
    __syncthreads();
    const XcdBarrier xb = xcd_barrier_post((unsigned*)(P.ws + OFF_BAR), (volatile LAS unsigned*)&xb_words);
    const int bid = blockIdx.x, nb = gridDim.x;
#ifndef REP
#define REP -1
#endif
#define PH(n, call) do { call; xcd_barrier(xb); if (REP == n) { call; xcd_barrier(xb); } } while (0)
    PH(0, phase0(P, bid, nb, dyn_lds));
    PH(1, phase1(P, bid, nb, dyn_lds));
    PH(2, phase2(P, bid, nb, dyn_lds));
    PH(3, phase3(P, bid, nb));
    PH(4, phase4(P, bid, nb, dyn_lds));
    PH(5, phase5(P, bid, nb, dyn_lds));
    PH(6, phase6(P, bid, nb, dyn_lds));
    PH(7, phase7(P, bid, nb));
    phase8(P, bid, nb, dyn_lds);
    if (REP == 8) { xcd_barrier(xb); phase8(P, bid, nb, dyn_lds); }
}
#endif

extern "C" void kernel_launch(void* const* d_in, const int* in_sizes, int n_in, void* d_out, int out_size, void* d_ws, size_t ws_size, hipStream_t stream) {
    static int grid = 0;
    if (grid == 0) {
        if (n_in != 20 || ws_size < WS_END) { fprintf(stderr, "kernel_launch: unexpected n_in %d or ws_size %zu (< %zu)\n", n_in, ws_size, (size_t)WS_END); grid = -1; return; }
        int dev = 0, cus = 0, per_cu = 0;
        hipGetDevice(&dev); hipDeviceGetAttribute(&cus, hipDeviceAttributeMultiprocessorCount, dev);
#if MK_MULTI
        hipFuncSetAttribute((const void*)k_phase, hipFuncAttributeMaxDynamicSharedMemorySize, LDS_BYTES);
        hipOccupancyMaxActiveBlocksPerMultiprocessor(&per_cu, (const void*)k_phase, 256, LDS_BYTES);
#else
        hipFuncSetAttribute((const void*)k_mega, hipFuncAttributeMaxDynamicSharedMemorySize, LDS_BYTES);
        hipOccupancyMaxActiveBlocksPerMultiprocessor(&per_cu, (const void*)k_mega, 256, LDS_BYTES);
#endif
        if (per_cu < 1) per_cu = 1;
        if (per_cu > 2) per_cu = 2;
        grid = cus * per_cu;
        (void)hipGetLastError();
    }
    if (grid < 0) return;
    Params P{};
    const float** pp = (const float**)&P;
    for (int i = 0; i < 20; ++i) pp[i] = (const float*)d_in[i];
    P.out = (float*)d_out; P.ws = (unsigned char*)d_ws;
#if MK_MULTI
    for (int ph = 0; ph < 9; ++ph) hipLaunchKernelGGL(k_phase, dim3(grid), dim3(256), LDS_BYTES, stream, P, ph);
#else
    (void)hipMemsetAsync((unsigned char*)d_ws + OFF_BAR, 0, XCD_BAR_WORDS * 4, stream);
    void* args[] = {&P};
    hipError_t e = hipLaunchCooperativeKernel((const void*)k_mega, dim3(grid), dim3(256), args, LDS_BYTES, stream);
    if (e != hipSuccess) fprintf(stderr, "cooperative launch failed: %s (grid %d)\n", hipGetErrorString(e), grid);
#endif
}
```

```cpp
#include <hip/hip_runtime.h>
#include <hip/hip_cooperative_groups.h>
#include <stdint.h>
#include <stdio.h>
namespace cg = cooperative_groups;

#ifndef MK_MULTI
#define MK_MULTI 0
#endif

typedef unsigned short bf16_t;
typedef short bf16x8 __attribute__((ext_vector_type(8)));
typedef float f32x4 __attribute__((ext_vector_type(4)));
typedef unsigned u32x4 __attribute__((ext_vector_type(4)));
typedef unsigned u32x2 __attribute__((ext_vector_type(2)));

constexpr int T = 32768, DM = 1024, SEQ = 8192, DPLE = 256, DIN = 3072;
constexpr int LC = 64;
constexpr int NCH = T / LC;
constexpr int CPB = SEQ / LC;
constexpr int KU = LC * 16;
constexpr int NS = 256;
constexpr int KA = KU + NS;
constexpr float EPS = 1e-6f;

constexpr size_t MB = 1ull << 20;
constexpr size_t OFF_XN = 0;
constexpr size_t OFF_MIXIN = OFF_XN;
constexpr size_t OFF_PB = OFF_XN + 64 * MB;
constexpr size_t OFF_WIN = OFF_PB + 16 * MB;
constexpr size_t OFF_WGLU = OFF_WIN + 6 * MB;
constexpr size_t OFF_WOUT = OFF_WGLU + 1 * MB;
constexpr size_t OFF_WPLE = OFF_WOUT + 2 * MB;
constexpr size_t OFF_WPG = OFF_WPLE + 1 * MB;
constexpr size_t OFF_UA = OFF_WPG + 2 * MB;
constexpr size_t OFF_ZS = OFF_UA + 40 * MB;
constexpr size_t OFF_Q = OFF_ZS + 32 * MB;
constexpr size_t OFF_K = OFF_Q + 32 * MB;
constexpr size_t OFF_VT = OFF_K + 32 * MB;
constexpr size_t OFF_ZN = OFF_VT + 32 * MB;
constexpr size_t OFF_MIX = OFF_Q;
constexpr size_t OFF_HB = OFF_VT;
constexpr size_t OFF_LAM = OFF_ZN + 32 * MB;
constexpr size_t OFF_BBAR = OFF_LAM + 3 * MB;
constexpr size_t OFF_KTAB = OFF_BBAR + 1 * MB;
constexpr size_t OFF_TQ = OFF_KTAB + 4 * MB;
constexpr size_t OFF_ERAW = OFF_TQ;
constexpr size_t OFF_PM = OFF_TQ + 80 * MB;
constexpr size_t OFF_S = OFF_PM + 16 * MB;
constexpr size_t OFF_YS = OFF_S + 16 * MB;
constexpr size_t OFF_SS = OFF_YS + 32 * MB;
constexpr size_t OFF_ESS = OFF_SS + 2 * MB;
constexpr size_t OFF_RSTD = OFF_ESS + 2 * MB;
constexpr size_t OFF_BAR = OFF_RSTD + 1 * MB;
constexpr size_t WS_END = OFF_BAR + 1 * MB;

struct Params {
    const float *x, *p, *norm_pre, *norm_post, *w_in, *a_re, *a_im, *log_dt, *b_re, *b_im, *c_re, *c_im, *ssm_d, *w_glu, *b_glu, *rpb, *w_out, *w_ple, *ple_norm, *w_pg;
    float* out;
    unsigned char* ws;
};

__device__ __forceinline__ unsigned pk2(float lo, float hi) { unsigned r; asm("v_cvt_pk_bf16_f32 %0, %1, %2" : "=v"(r) : "v"(lo), "v"(hi)); return r; }
__device__ __forceinline__ float bflo(unsigned w) { return __uint_as_float(w << 16); }
__device__ __forceinline__ float bfhi(unsigned w) { return __uint_as_float(w & 0xffff0000u); }
__device__ __forceinline__ void store_bf4(bf16_t* p, f32x4 v) { u32x2 w; w.x = pk2(v[0], v[1]); w.y = pk2(v[2], v[3]); *(u32x2*)p = w; }
__device__ __forceinline__ f32x4 load_bf4(const bf16_t* p) { u32x2 w = *(const u32x2*)p; f32x4 v; v[0] = bflo(w.x); v[1] = bfhi(w.x); v[2] = bflo(w.y); v[3] = bfhi(w.y); return v; }
__device__ __forceinline__ float sigmoidf_(float v) { return 1.f / (1.f + __expf(-v)); }
__device__ __forceinline__ float gelu_tanh(float v) { const float u = 0.7978845608028654f * (v + 0.044715f * v * v * v); const float th = 1.f - 2.f / (__expf(2.f * u) + 1.f); return 0.5f * v * (1.f + th); }

constexpr int LDS_TILE = 128 * 64;
constexpr int LDS_BYTES = 4 * LDS_TILE * 2;

template <class Epi, int MODE = 7>
__device__ __forceinline__ void gemm_tile(const bf16_t* __restrict__ A, int lda, const bf16_t* __restrict__ Bt, int ldb, int K, bf16_t* lds, const Epi& epi) {
    const int tid = threadIdx.x, lane = tid & 63, wid = tid >> 6, wm = wid >> 1, wn = wid & 1, fr = lane & 15, fq = lane >> 4;
    const int sr = tid >> 3, sc = (tid & 7) * 8;
    const int sw = sr * 64 + (((tid & 7) ^ (sr & 7)) * 8);
    const bf16_t* ga = A + (size_t)sr * lda + sc;
    const bf16_t* gb = Bt + (size_t)sr * ldb + sc;
    f32x4 acc[4][4];
#pragma unroll
    for (int mi = 0; mi < 4; ++mi)
#pragma unroll
        for (int ni = 0; ni < 4; ++ni) acc[mi][ni] = (f32x4){0.f, 0.f, 0.f, 0.f};
    u32x4 ra[4], rb[4];
    const int nk = K >> 6;
    const int fo0 = ((fq ^ (fr & 7)) * 8), fo1 = (((4 + fq) ^ (fr & 7)) * 8);
    const int arow = (wm * 64 + fr) * 64, brow = 2 * LDS_TILE + (wn * 64 + fr) * 64;
    if (MODE & 1) {
#pragma unroll
        for (int i = 0; i < 4; ++i) { ra[i] = *(const u32x4*)(ga + (size_t)(32 * i) * lda); rb[i] = *(const u32x4*)(gb + (size_t)(32 * i) * ldb); }
#pragma unroll
        for (int i = 0; i < 4; ++i) { *(u32x4*)(lds + sw + 32 * 64 * i) = ra[i]; *(u32x4*)(lds + 2 * LDS_TILE + sw + 32 * 64 * i) = rb[i]; }
    }
    __syncthreads();
    for (int kt = 0; kt < nk; ++kt) {
        const int buf = kt & 1;
        if (MODE & 1) {
            const int kp = kt + 1 < nk ? kt + 1 : kt;
#pragma unroll
            for (int i = 0; i < 4; ++i) { ra[i] = *(const u32x4*)(ga + (size_t)(32 * i) * lda + kp * 64); rb[i] = *(const u32x4*)(gb + (size_t)(32 * i) * ldb + kp * 64); }
        }
        __builtin_amdgcn_sched_barrier(0);
        if (MODE & 2) {
            const bf16_t* as = lds + buf * LDS_TILE + arow;
            const bf16_t* bs = lds + buf * LDS_TILE + brow;
            bf16x8 af[2][4], bfr[2][4];
#pragma unroll
            for (int ks = 0; ks < 2; ++ks) {
                const int fo = ks ? fo1 : fo0;
#pragma unroll
                for (int i = 0; i < 4; ++i) { af[ks][i] = *(const bf16x8*)(as + i * 16 * 64 + fo); bfr[ks][i] = *(const bf16x8*)(bs + i * 16 * 64 + fo); }
            }
            __builtin_amdgcn_sched_barrier(0);
#pragma unroll
            for (int ks = 0; ks < 2; ++ks)
#pragma unroll
                for (int mi = 0; mi < 4; ++mi)
#pragma unroll
                    for (int ni = 0; ni < 4; ++ni) acc[mi][ni] = __builtin_amdgcn_mfma_f32_16x16x32_bf16(bfr[ks][ni], af[ks][mi], acc[mi][ni], 0, 0, 0);
        }
        __builtin_amdgcn_sched_barrier(0);
        if ((MODE & 1) && kt + 1 < nk) {
            const int nb = buf ^ 1;
#pragma unroll
            for (int i = 0; i < 4; ++i) { *(u32x4*)(lds + nb * LDS_TILE + sw + 32 * 64 * i) = ra[i]; *(u32x4*)(lds + (2 + nb) * LDS_TILE + sw + 32 * 64 * i) = rb[i]; }
        }
        if (MODE & 4) __syncthreads();
    }
    epi(acc, wm * 64 + fr, wn * 64 + fq * 4);
}

struct EpiInProj {
    unsigned char* ws; int m0, n0;
    __device__ __forceinline__ void operator()(f32x4 (&acc)[4][4], int r0, int c0) const {
        const int sec = n0 >> 9;
#pragma unroll
        for (int mi = 0; mi < 4; ++mi) {
            const int t = m0 + r0 + mi * 16;
#pragma unroll
            for (int ni = 0; ni < 4; ++ni) {
                const int nn = (n0 + c0 + ni * 16) & 511; f32x4 v = acc[mi][ni];
                if (sec == 0) { const int g = nn >> 4, hh = nn & 15, ch = t / LC, j = t % LC; store_bf4((bf16_t*)(ws + OFF_UA) + ((size_t)(g * NCH + ch)) * KA + j * 16 + hh, v); }
                else if (sec == 1) store_bf4((bf16_t*)(ws + OFF_ZS) + (size_t)t * 512 + nn, v);
                else if (sec == 2) store_bf4((bf16_t*)(ws + OFF_Q) + (size_t)t * 512 + nn, v * 0.125f);
                else if (sec == 3) store_bf4((bf16_t*)(ws + OFF_K) + (size_t)t * 512 + nn, v);
                else if (sec == 4) { const int b = t >> 13, l = t & 8191; bf16_t* vt = (bf16_t*)(ws + OFF_VT) + ((size_t)(b * 512 + nn)) * SEQ + l; const unsigned w0 = pk2(v[0], v[1]), w1 = pk2(v[2], v[3]);
                    vt[0] = (bf16_t)(w0 & 0xffff); vt[SEQ] = (bf16_t)(w0 >> 16); vt[2 * SEQ] = (bf16_t)(w1 & 0xffff); vt[3 * SEQ] = (bf16_t)(w1 >> 16); }
                else store_bf4((bf16_t*)(ws + OFF_ZN) + (size_t)t * 512 + nn, v);
            }
        }
    }
};
struct EpiS {
    float* S; int m0, n0;
    __device__ __forceinline__ void operator()(f32x4 (&acc)[4][4], int r0, int c0) const {
#pragma unroll
        for (int mi = 0; mi < 4; ++mi)
#pragma unroll
            for (int ni = 0; ni < 4; ++ni) *(f32x4*)(S + (size_t)(m0 + r0 + mi * 16) * NS + n0 + c0 + ni * 16) = acc[mi][ni];
    }
};
struct EpiY {
    bf16_t* ys; int g, m0, n0;
    __device__ __forceinline__ void operator()(f32x4 (&acc)[4][4], int r0, int c0) const {
#pragma unroll
        for (int mi = 0; mi < 4; ++mi) {
            const int ch = m0 + r0 + mi * 16;
#pragma unroll
            for (int ni = 0; ni < 4; ++ni) {
                const int n = n0 + c0 + ni * 16, i = n >> 4, h = n & 15; f32x4 v = acc[mi][ni];
#pragma unroll
                for (int e = 0; e < 4; ++e) v[e] = gelu_tanh(v[e]);
                store_bf4(ys + ((size_t)ch * LC + i) * 512 + g * 16 + h, v);
            }
        }
    }
};
struct EpiGlu {
    const bf16_t* ys; const bf16_t* zs; const float* bglu; bf16_t* mixin; int m0, n0;
    __device__ __forceinline__ void operator()(f32x4 (&acc)[4][4], int r0, int c0) const {
#pragma unroll
        for (int mi = 0; mi < 4; ++mi) {
            const int t = m0 + r0 + mi * 16;
#pragma unroll
            for (int ni = 0; ni < 4; ++ni) {
                const int n = n0 + c0 + ni * 16; const f32x4 bv = *(const f32x4*)(bglu + n);
                const f32x4 y = load_bf4(ys + (size_t)t * 512 + n), z = load_bf4(zs + (size_t)t * 512 + n); f32x4 o;
#pragma unroll
                for (int e = 0; e < 4; ++e) o[e] = y[e] * sigmoidf_(acc[mi][ni][e] + bv[e]) * z[e] * sigmoidf_(z[e]);
                store_bf4(mixin + (size_t)t * 1024 + n, o);
            }
        }
    }
};
struct EpiStoreSS {
    bf16_t* dst; float* ss; int m0, n0;
    __device__ __forceinline__ void operator()(f32x4 (&acc)[4][4], int r0, int c0) const {
#pragma unroll
        for (int mi = 0; mi < 4; ++mi) {
            const int t = m0 + r0 + mi * 16; float s = 0.f;
#pragma unroll
            for (int ni = 0; ni < 4; ++ni) { const f32x4 v = acc[mi][ni]; s += (v[0] * v[0] + v[1] * v[1]) + (v[2] * v[2] + v[3] * v[3]); store_bf4(dst + (size_t)t * 1024 + n0 + c0 + ni * 16, v); }
            s += __shfl_xor(s, 16); s += __shfl_xor(s, 32);
            if ((threadIdx.x & 48) == 0) ss[(size_t)t * 16 + (n0 >> 7) * 2 + (c0 >> 6)] = s;
        }
    }
};
struct EpiFinal {
    const bf16_t* hb; const bf16_t* eraw; const float* rstd; const float* gple; float* out; int m0, n0;
    __device__ __forceinline__ void operator()(f32x4 (&acc)[4][4], int r0, int c0) const {
#pragma unroll
        for (int mi = 0; mi < 4; ++mi) {
            const int t = m0 + r0 + mi * 16; const float re = rstd[T + t];
#pragma unroll
            for (int ni = 0; ni < 4; ++ni) {
                const int n = n0 + c0 + ni * 16; const size_t off = (size_t)t * 1024 + n;
                const f32x4 ge = *(const f32x4*)(gple + n), hv = load_bf4(hb + off), ev = load_bf4(eraw + off); f32x4 o;
#pragma unroll
                for (int e = 0; e < 4; ++e) o[e] = hv[e] + sigmoidf_(acc[mi][ni][e]) * (ev[e] * re * ge[e]);
                *(f32x4*)(out + off) = o;
            }
        }
    }
};

__device__ __forceinline__ void ktab_unit(const Params& P, int u, float* ldsf) {
    const int dir = u >> 8, g = (u >> 3) & 31, mr = u & 7, tid = threadIdx.x;
    float2* lp = (float2*)ldsf;
    float2* bb = lp + 64 * 65;
    float2* lampow = (float2*)(P.ws + OFF_LAM); float2* bbar = (float2*)(P.ws + OFF_BBAR); float* ktab = (float*)(P.ws + OFF_KTAB);
    if (tid < 64) {
        const int p = tid, idx = (dir * 32 + g) * 64 + p;
        const float ar = P.a_re[idx], ai = P.a_im[idx], dt = expf(P.log_dt[dir * 32 + g]);
        const float mag = expf(dt * ar), ang = dt * ai; const float lr = mag * cosf(ang), li = mag * sinf(ang);
        const float nr = lr - 1.f, ni = li, den = ar * ar + ai * ai;
        const float cr = (nr * ar + ni * ai) / den, ci = (ni * ar - nr * ai) / den;
        float pr = 1.f, pi = 0.f;
        for (int m = 0; m <= 64; ++m) { lp[p * 65 + m] = make_float2(pr, pi); if (mr == 0) lampow[(size_t)idx * 65 + m] = make_float2(pr, pi); const float tt = pr * lr - pi * li; pi = pr * li + pi * lr; pr = tt; }
        for (int h = 0; h < 16; ++h) { const float br = P.b_re[idx * 16 + h], bi = P.b_im[idx * 16 + h]; const float2 v = make_float2(cr * br - ci * bi, cr * bi + ci * br); bb[p * 16 + h] = v; if (mr == 0) bbar[(size_t)idx * 16 + h] = v; }
    }
    __syncthreads();
    const int h = tid >> 4, h2 = tid & 15;
    const float* crp = P.c_re + ((dir * 32 + g) * 16 + h) * 64; const float* cip = P.c_im + ((dir * 32 + g) * 16 + h) * 64;
    for (int mm = 0; mm < 8; ++mm) {
        const int m = mr * 8 + mm; float s = 0.f;
        for (int p = 0; p < 64; ++p) { const float2 l = lp[p * 65 + m], b = bb[p * 16 + h2]; s += crp[p] * (l.x * b.x - l.y * b.y) - cip[p] * (l.x * b.y + l.y * b.x); }
        ktab[((size_t)((dir * 32 + g) * 64 + m)) * 256 + h * 16 + h2] = s;
    }
    __syncthreads();
}
__device__ __forceinline__ void transpose_unit(const float* W, int K, int N, const float* gain, bf16_t* Wt, int item, float* ldsf) {
    const int nblk = N / 64, kb = item / nblk, nbk = item % nblk, k0 = kb * 64, n0 = nbk * 64, tid = threadIdx.x;
#pragma unroll 4
    for (int i = 0; i < 16; ++i) { const int kk = i * 4 + (tid >> 6), nn = tid & 63; float v = W[(size_t)(k0 + kk) * N + n0 + nn]; if (gain) v *= gain[k0 + kk]; ldsf[kk * 65 + nn] = v; }
    __syncthreads();
#pragma unroll 4
    for (int i = 0; i < 8; ++i) { const int nn = i * 8 + (tid >> 5), kk = (tid & 31) * 2; *(unsigned*)(Wt + (size_t)(n0 + nn) * K + k0 + kk) = pk2(ldsf[kk * 65 + nn], ldsf[(kk + 1) * 65 + nn]); }
    __syncthreads();
}
__device__ __forceinline__ float wave_sum(float v) {
#pragma unroll
    for (int o = 1; o < 64; o <<= 1) v += __shfl_xor(v, o);
    return v;
}
__device__ __forceinline__ void phase0(const Params& P, int bid, int nb, unsigned char* lds) {
    float* ldsf = (float*)lds;
    constexpr int U_K = 512, I_IN = 16 * 48, I_GLU = 64, I_OUT = 256, I_PLE = 4 * 16, I_PG = 256, U_T = I_IN + I_GLU + I_OUT + I_PLE + I_PG, U_X = T / 8, U_P = (T * DPLE) / 2048;
    constexpr int NU = U_K + U_T + U_X + U_P;
    const int tid = threadIdx.x, lane = tid & 63, wid = tid >> 6;
    for (int u = bid; u < NU; u += nb) {
        int r = u;
        if (r < U_K) { ktab_unit(P, r, ldsf); continue; } r -= U_K;
        if (r < U_T) {
            if (r < I_IN) { transpose_unit(P.w_in, 1024, 3072, P.norm_pre, (bf16_t*)(P.ws + OFF_WIN), r, ldsf); continue; } r -= I_IN;
            if (r < I_GLU) { transpose_unit(P.w_glu, 512, 512, nullptr, (bf16_t*)(P.ws + OFF_WGLU), r, ldsf); continue; } r -= I_GLU;
            if (r < I_OUT) { transpose_unit(P.w_out, 1024, 1024, nullptr, (bf16_t*)(P.ws + OFF_WOUT), r, ldsf); continue; } r -= I_OUT;
            if (r < I_PLE) { transpose_unit(P.w_ple, 256, 1024, nullptr, (bf16_t*)(P.ws + OFF_WPLE), r, ldsf); continue; } r -= I_PLE;
            transpose_unit(P.w_pg, 1024, 1024, nullptr, (bf16_t*)(P.ws + OFF_WPG), r, ldsf); continue;
        }
        r -= U_T;
        if (r < U_X) {
            const int t = r * 8 + wid * 2; const f32x4* xr = (const f32x4*)(P.x + (size_t)t * 1024) + lane; f32x4 v[8]; float s0 = 0.f, s1 = 0.f;
#pragma unroll
            for (int j = 0; j < 8; ++j) v[j] = xr[64 * j];
#pragma unroll
            for (int j = 0; j < 4; ++j) { s0 += (v[j][0] * v[j][0] + v[j][1] * v[j][1]) + (v[j][2] * v[j][2] + v[j][3] * v[j][3]); s1 += (v[4 + j][0] * v[4 + j][0] + v[4 + j][1] * v[4 + j][1]) + (v[4 + j][2] * v[4 + j][2] + v[4 + j][3] * v[4 + j][3]); }
            const float rs0 = rsqrtf(wave_sum(s0) * (1.f / 1024.f) + EPS), rs1 = rsqrtf(wave_sum(s1) * (1.f / 1024.f) + EPS);
            bf16_t* o = (bf16_t*)(P.ws + OFF_XN) + (size_t)t * 1024 + lane * 4;
#pragma unroll
            for (int j = 0; j < 4; ++j) { store_bf4(o + 256 * j, v[j] * rs0); store_bf4(o + 1024 + 256 * j, v[4 + j] * rs1); }
            continue;
        }
        r -= U_X;
        {
            const size_t e0 = (size_t)r * 2048 + tid * 8; const f32x4 a = *(const f32x4*)(P.p + e0), b = *(const f32x4*)(P.p + e0 + 4);
            u32x4 w; w.x = pk2(a[0], a[1]); w.y = pk2(a[2], a[3]); w.z = pk2(b[0], b[1]); w.w = pk2(b[2], b[3]);
            *(u32x4*)((bf16_t*)(P.ws + OFF_PB) + e0) = w;
        }
    }
}

__device__ __forceinline__ void tq_unit(const Params& P, int u) {
    const int g = u / LC, i = u % LC, tid = threadIdx.x;
    const float* ktab = (const float*)(P.ws + OFF_KTAB); const float2* lampow = (const float2*)(P.ws + OFF_LAM); bf16_t* tq = (bf16_t*)(P.ws + OFF_TQ);
    for (int idx = tid; idx < 16 * (KA / 2); idx += 256) {
        const int h = idx / (KA / 2), c = (idx % (KA / 2)) * 2; float v0, v1;
        if (c < KU) {
            const int j = c >> 4, h2 = c & 15;
            if (i > j) { const float* kp = ktab + ((size_t)((0 * 32 + g) * 64 + (i - j))) * 256 + h * 16 + h2; v0 = kp[0]; v1 = kp[1]; }
            else if (j > i) { const float* kp = ktab + ((size_t)((1 * 32 + g) * 64 + (j - i))) * 256 + h * 16 + h2; v0 = kp[0]; v1 = kp[1]; }
            else { const float* kf = ktab + ((size_t)((0 * 32 + g) * 64)) * 256 + h * 16 + h2; const float* kb = ktab + ((size_t)((1 * 32 + g) * 64)) * 256 + h * 16 + h2; const float dd = P.ssm_d[g * 16 + h];
                v0 = kf[0] + kb[0] + (h == h2 ? dd : 0.f); v1 = kf[1] + kb[1] + (h == h2 + 1 ? dd : 0.f); }
        } else {
            const int n = c - KU, dir = n >> 7, p = (n & 127) >> 1, m = dir == 0 ? i + 1 : LC - i;
            const float2 l = lampow[((size_t)((dir * 32 + g) * 64 + p)) * 65 + m]; const float cr = P.c_re[((dir * 32 + g) * 16 + h) * 64 + p], ci = P.c_im[((dir * 32 + g) * 16 + h) * 64 + p];
            v0 = cr * l.x - ci * l.y; v1 = -(cr * l.y + ci * l.x);
        }
        *(unsigned*)(tq + ((size_t)(g * KU + i * 16 + h)) * KA + c) = pk2(v0, v1);
    }
}
__device__ __forceinline__ void pm_unit(const Params& P, int u) {
    const int g = u >> 4, rg = u & 15, tid = threadIdx.x;
    const float2* lampow = (const float2*)(P.ws + OFF_LAM); const float2* bbar = (const float2*)(P.ws + OFF_BBAR); bf16_t* pm = (bf16_t*)(P.ws + OFF_PM);
    for (int idx = tid; idx < 16 * (KU / 2); idx += 256) {
        const int rr = idx / (KU / 2), c = (idx % (KU / 2)) * 2, n = rg * 16 + rr, dir = n >> 7, p = (n & 127) >> 1, ri = n & 1;
        const int j = c >> 4, h2 = c & 15, m = dir == 0 ? LC - 1 - j : j;
        const float2 l = lampow[((size_t)((dir * 32 + g) * 64 + p)) * 65 + m]; const float2 b0 = bbar[((size_t)((dir * 32 + g) * 64 + p)) * 16 + h2], b1 = bbar[((size_t)((dir * 32 + g) * 64 + p)) * 16 + h2 + 1];
        const float v0 = ri ? (l.x * b0.y + l.y * b0.x) : (l.x * b0.x - l.y * b0.y), v1 = ri ? (l.x * b1.y + l.y * b1.x) : (l.x * b1.x - l.y * b1.y);
        *(unsigned*)(pm + ((size_t)(g * NS + n)) * KU + c) = pk2(v0, v1);
    }
}
__device__ __forceinline__ void phase1(const Params& P, int bid, int nb, unsigned char* lds) {
    constexpr int U_TQ = 32 * LC, U_PM = 32 * 16;
    const int xcd = bid & 7, rank = bid >> 3, R = nb >> 3;
    for (int l = rank; l < 768; l += R) {
        const int nt = (xcd & 1) * 12 + l % 12, mt = (xcd >> 1) * 64 + l / 12; EpiInProj epi{P.ws, mt * 128, nt * 128};
        gemm_tile((const bf16_t*)(P.ws + OFF_XN) + (size_t)mt * 128 * 1024, 1024, (const bf16_t*)(P.ws + OFF_WIN) + (size_t)nt * 128 * 1024, 1024, 1024, (bf16_t*)lds, epi);
    }
    for (int u = bid; u < U_TQ + U_PM; u += nb) {
        if (u < U_TQ) tq_unit(P, u);
        else pm_unit(P, u - U_TQ);
    }
}

__device__ __forceinline__ void na_unit(const Params& P, int u) {
    const int tid = threadIdx.x, lane = tid & 63, cb = tid >> 6, fr = lane & 15, fq = lane >> 4;
    const int r = u & 127, head = (u >> 7) & 7, b = u >> 10;
    const bf16_t* q = (const bf16_t*)(P.ws + OFF_Q); const bf16_t* k = (const bf16_t*)(P.ws + OFF_K); const bf16_t* vt = (const bf16_t*)(P.ws + OFF_VT); const bf16_t* zn = (const bf16_t*)(P.ws + OFF_ZN);
    bf16_t* mixin = (bf16_t*)(P.ws + OFF_MIXIN);
    const int rs = min(max(r - 4, 0), 120);
    const int cw0 = cb == 0 ? 0 : (cb == 1 ? 8 : (cb == 2 ? 24 : 32));
    const int c = cb * 16 + fr, cs = min(max(c - 8, 0), 48);
    const size_t tq = (size_t)b * SEQ + r * 64 + c;
    const bf16x8 qf0 = *(const bf16x8*)(q + tq * 512 + head * 64 + fq * 8), qf1 = *(const bf16x8*)(q + tq * 512 + head * 64 + 32 + fq * 8);
    f32x4 s[16];
    const int kcol = cw0 + (fr >> 2) * 8 + (fr & 3);
#pragma unroll
    for (int t = 0; t < 16; ++t) {
        const int i = t >> 1, odd = t & 1;
        const bf16_t* kp = k + ((size_t)b * SEQ + (rs + i) * 64 + kcol + odd * 4) * 512 + head * 64 + fq * 8;
        const bf16x8 k0 = *(const bf16x8*)kp, k1 = *(const bf16x8*)(kp + 32);
        f32x4 z = (f32x4){0.f, 0.f, 0.f, 0.f};
        z = __builtin_amdgcn_mfma_f32_16x16x32_bf16(k0, qf0, z, 0, 0, 0);
        z = __builtin_amdgcn_mfma_f32_16x16x32_bf16(k1, qf1, z, 0, 0, 0);
        s[t] = z;
    }
    const float* rp = P.rpb + head * 15 * 31;
    float mx = -3.0e38f;
#pragma unroll
    for (int t = 0; t < 16; ++t) {
        const int i = t >> 1, odd = t & 1, dr = rs + i - r + 7;
#pragma unroll
        for (int e = 0; e < 4; ++e) {
            const int ck = cw0 + fq * 8 + odd * 4 + e; const bool valid = (ck >= cs) && (ck < cs + 16);
            const int dc = min(max(ck - c + 15, 0), 30);
            const float bv = rp[dr * 31 + dc];
            const float sv = valid ? s[t][e] + bv : -3.0e38f;
            s[t][e] = sv; mx = fmaxf(mx, sv);
        }
    }
    mx = fmaxf(mx, __shfl_xor(mx, 16)); mx = fmaxf(mx, __shfl_xor(mx, 32));
    float l = 0.f;
#pragma unroll
    for (int t = 0; t < 16; ++t)
#pragma unroll
        for (int e = 0; e < 4; ++e) { const float pv = __expf(s[t][e] - mx); s[t][e] = pv; l += pv; }
    l += __shfl_xor(l, 16); l += __shfl_xor(l, 32);
    f32x4 o[4];
#pragma unroll
    for (int dt = 0; dt < 4; ++dt) o[dt] = (f32x4){0.f, 0.f, 0.f, 0.f};
#pragma unroll
    for (int kk = 0; kk < 8; ++kk) {
        u32x4 pw; pw.x = pk2(s[2 * kk][0], s[2 * kk][1]); pw.y = pk2(s[2 * kk][2], s[2 * kk][3]); pw.z = pk2(s[2 * kk + 1][0], s[2 * kk + 1][1]); pw.w = pk2(s[2 * kk + 1][2], s[2 * kk + 1][3]);
        const bf16x8 pf = __builtin_bit_cast(bf16x8, pw);
        const bf16_t* vp = vt + ((size_t)(b * 512 + head * 64 + fr)) * SEQ + (rs + kk) * 64 + cw0 + fq * 8;
#pragma unroll
        for (int dt = 0; dt < 4; ++dt) { const bf16x8 vf = *(const bf16x8*)(vp + (size_t)dt * 16 * SEQ); o[dt] = __builtin_amdgcn_mfma_f32_16x16x32_bf16(vf, pf, o[dt], 0, 0, 0); }
    }
    const float inv = 1.f / l;
#pragma unroll
    for (int dt = 0; dt < 4; ++dt) {
        const int d0 = head * 64 + dt * 16 + fq * 4; const f32x4 z = load_bf4(zn + tq * 512 + d0); f32x4 ov;
#pragma unroll
        for (int e = 0; e < 4; ++e) ov[e] = o[dt][e] * inv * z[e] * sigmoidf_(z[e]);
        store_bf4(mixin + tq * 1024 + 512 + d0, ov);
    }
}
__device__ __forceinline__ void phase2(const Params& P, int bid, int nb, unsigned char* lds) {
    constexpr int MT = NCH / 128;
    const int xcd = bid & 7, rank = bid >> 3, R = nb >> 3;
    for (int l = rank; l < 4 * MT * 2; l += R) {
        const int mt = l % MT, nt = (l / MT) & 1, g = xcd + 8 * (l / (MT * 2)); EpiS epi{(float*)(P.ws + OFF_S) + (size_t)g * NCH * NS, mt * 128, nt * 128};
        gemm_tile((const bf16_t*)(P.ws + OFF_UA) + ((size_t)g * NCH + mt * 128) * KA, KA, (const bf16_t*)(P.ws + OFF_PM) + ((size_t)g * NS + nt * 128) * KU, KU, KU, (bf16_t*)lds, epi);
    }
    for (int l = rank; l < 512; l += R) na_unit(P, xcd * 512 + l);
}

__device__ __forceinline__ void phase3(const Params& P, int bid, int nb) {
    const float2* lampow = (const float2*)(P.ws + OFF_LAM); const float2* S = (const float2*)(P.ws + OFF_S); bf16_t* ua = (bf16_t*)(P.ws + OFF_UA);
    for (int sidx = bid * 256 + threadIdx.x; sidx < 4 * 2 * 32 * 64; sidx += nb * 256) {
        const int p = sidx & 63, g = (sidx >> 6) & 31, dir = (sidx >> 11) & 1, b = sidx >> 12;
        const float2 L = lampow[((size_t)((dir * 32 + g) * 64 + p)) * 65 + LC];
        float hr = 0.f, hi = 0.f;
        const float2* Sp = S + ((size_t)(g * NCH + b * CPB)) * (NS / 2) + dir * 64 + p;
        bf16_t* up = ua + ((size_t)(g * NCH + b * CPB)) * KA + KU + dir * 128 + p * 2;
        for (int cb0 = 0; cb0 < CPB; cb0 += 16) {
            float2 sv[16];
#pragma unroll
            for (int uu = 0; uu < 16; ++uu) { const int c = dir == 0 ? cb0 + uu : CPB - 1 - (cb0 + uu); sv[uu] = Sp[(size_t)c * (NS / 2)]; }
#pragma unroll
            for (int uu = 0; uu < 16; ++uu) {
                const int c = dir == 0 ? cb0 + uu : CPB - 1 - (cb0 + uu);
                *(unsigned*)(up + (size_t)c * KA) = pk2(hr, hi);
                const float tr = L.x * hr - L.y * hi + sv[uu].x; hi = L.x * hi + L.y * hr + sv[uu].y; hr = tr;
            }
        }
    }
}

__device__ __forceinline__ void phase4(const Params& P, int bid, int nb, unsigned char* lds) {
    constexpr int MT = NCH / 128, NT = KU / 128;
    const int xcd = bid & 7, rank = bid >> 3, R = nb >> 3;
    for (int l = rank; l < 4 * MT * NT; l += R) {
        const int mt = l % MT, nt = (l / MT) % NT, g = xcd + 8 * (l / (MT * NT)); EpiY epi{(bf16_t*)(P.ws + OFF_YS), g, mt * 128, nt * 128};
        gemm_tile((const bf16_t*)(P.ws + OFF_UA) + ((size_t)g * NCH + mt * 128) * KA, KA, (const bf16_t*)(P.ws + OFF_TQ) + ((size_t)g * KU + nt * 128) * KA, KA, KA, (bf16_t*)lds, epi);
    }
}
__device__ __forceinline__ void phase5(const Params& P, int bid, int nb, unsigned char* lds) {
    const int xcd = bid & 7, rank = bid >> 3, R = nb >> 3;
    for (int l = rank; l < 128; l += R) {
        const int nt = l & 3, mt = xcd * 32 + (l >> 2); EpiGlu epi{(const bf16_t*)(P.ws + OFF_YS), (const bf16_t*)(P.ws + OFF_ZS), P.b_glu, (bf16_t*)(P.ws + OFF_MIXIN), mt * 128, nt * 128};
        gemm_tile((const bf16_t*)(P.ws + OFF_YS) + (size_t)mt * 128 * 512, 512, (const bf16_t*)(P.ws + OFF_WGLU) + (size_t)nt * 128 * 512, 512, 512, (bf16_t*)lds, epi);
    }
}
__device__ __forceinline__ void phase6(const Params& P, int bid, int nb, unsigned char* lds) {
    const int xcd = bid & 7, rank = bid >> 3, R = nb >> 3;
    for (int l = rank; l < 512; l += R) {
        const int v = l & 255, nt = v & 7, mt = xcd * 32 + (v >> 3);
        if (l < 256) {
            EpiStoreSS epi{(bf16_t*)(P.ws + OFF_MIX), (float*)(P.ws + OFF_SS), mt * 128, nt * 128};
            gemm_tile((const bf16_t*)(P.ws + OFF_MIXIN) + (size_t)mt * 128 * 1024, 1024, (const bf16_t*)(P.ws + OFF_WOUT) + (size_t)nt * 128 * 1024, 1024, 1024, (bf16_t*)lds, epi);
        } else {
            EpiStoreSS epi{(bf16_t*)(P.ws + OFF_ERAW), (float*)(P.ws + OFF_ESS), mt * 128, nt * 128};
            gemm_tile((const bf16_t*)(P.ws + OFF_PB) + (size_t)mt * 128 * 256, 256, (const bf16_t*)(P.ws + OFF_WPLE) + (size_t)nt * 128 * 256, 256, 256, (bf16_t*)lds, epi);
        }
    }
}
__device__ __forceinline__ void phase7(const Params& P, int bid, int nb) {
    const int tid = threadIdx.x, lane = tid & 63, wid = tid >> 6;
    const float* ss = (const float*)(P.ws + OFF_SS); const float* ess = (const float*)(P.ws + OFF_ESS); float* rstd = (float*)(P.ws + OFF_RSTD);
    const bf16_t* mix = (const bf16_t*)(P.ws + OFF_MIX); bf16_t* hb = (bf16_t*)(P.ws + OFF_HB);
    for (int u = bid; u < T / 8; u += nb) {
        const int t = u * 8 + wid * 2;
        const int tl = t + (lane >> 5), l5 = lane & 31;
        f32x4 xv[8], mv[8];
#pragma unroll
        for (int j = 0; j < 8; ++j) { const size_t off = (size_t)(t + (j >> 2)) * 1024 + lane * 4 + 256 * (j & 3); xv[j] = *(const f32x4*)(P.x + off); mv[j] = load_bf4(mix + off); }
        float v = l5 < 16 ? ss[(size_t)tl * 16 + l5] : ess[(size_t)tl * 16 + l5 - 16];
        v += __shfl_xor(v, 1); v += __shfl_xor(v, 2); v += __shfl_xor(v, 4); v += __shfl_xor(v, 8);
        const float rp0 = rsqrtf(__shfl(v, 0) * (1.f / 1024.f) + EPS), re0 = rsqrtf(__shfl(v, 16) * (1.f / 1024.f) + EPS);
        const float rp1 = rsqrtf(__shfl(v, 32) * (1.f / 1024.f) + EPS), re1 = rsqrtf(__shfl(v, 48) * (1.f / 1024.f) + EPS);
        if (lane == 0) { rstd[t] = rp0; rstd[T + t] = re0; rstd[t + 1] = rp1; rstd[T + t + 1] = re1; }
#pragma unroll
        for (int j = 0; j < 8; ++j) {
            const int n = lane * 4 + 256 * (j & 3); const size_t off = (size_t)(t + (j >> 2)) * 1024 + n; const float rp = (j >> 2) ? rp1 : rp0;
            const f32x4 gp = *(const f32x4*)(P.norm_post + n); f32x4 h;
#pragma unroll
            for (int e = 0; e < 4; ++e) h[e] = xv[j][e] + mv[j][e] * rp * gp[e];
            store_bf4(hb + off, h);
        }
    }
}
__device__ __forceinline__ void phase8(const Params& P, int bid, int nb, unsigned char* lds) {
    const int xcd = bid & 7, rank = bid >> 3, R = nb >> 3;
    for (int l = rank; l < 256; l += R) {
        const int nt = l & 7, mt = xcd * 32 + (l >> 3);
        EpiFinal epi{(const bf16_t*)(P.ws + OFF_HB), (const bf16_t*)(P.ws + OFF_ERAW), (const float*)(P.ws + OFF_RSTD), P.ple_norm, P.out, mt * 128, nt * 128};
        gemm_tile((const bf16_t*)(P.ws + OFF_HB) + (size_t)mt * 128 * 1024, 1024, (const bf16_t*)(P.ws + OFF_WPG) + (size_t)nt * 128 * 1024, 1024, 1024, (bf16_t*)lds, epi);
    }
}

#ifndef XMODE
#define XMODE -1
#endif
struct EpiDummy { float* out;
    __device__ __forceinline__ void operator()(f32x4 (&acc)[4][4], int r0, int c0) const {
        float s = 0.f;
#pragma unroll
        for (int mi = 0; mi < 4; ++mi)
#pragma unroll
            for (int ni = 0; ni < 4; ++ni) s += acc[mi][ni][0] + acc[mi][ni][1] + acc[mi][ni][2] + acc[mi][ni][3];
        if (s == 123456.789f) out[r0 + c0] = s;
    }
};
template <int MODE>
__device__ __forceinline__ void phaseX(const Params& P, int bid, int nb, unsigned char* lds) {
    const int xcd = bid & 7, rank = bid >> 3, R = nb >> 3;
    for (int l = rank; l < 256; l += R) {
        const int nt = l & 7, mt = xcd * 32 + (l >> 3); EpiDummy epi{(float*)(P.ws + OFF_S)};
        gemm_tile<EpiDummy, MODE>((const bf16_t*)(P.ws + OFF_HB) + (size_t)mt * 128 * 1024, 1024, (const bf16_t*)(P.ws + OFF_WPG) + (size_t)nt * 128 * 1024, 1024, 1024, (bf16_t*)lds, epi);
    }
}

#define XB_TMO      128
#define XB_XCNT(j)  (256  + 64 * (j))
#define XB_XSUB(j)  (1280 + 64 * (j))
#define XB_XGEN(j)  (2304 + 64 * (j))
#define XB_TOP      3328
#define XB_TOPGEN   3392
#define XCD_BAR_WORDS 3456
#define XB_SPIN_CAP (1u << 20)
#define LAS __attribute__((address_space(3)))
__device__ __forceinline__ unsigned xb_ld(unsigned* p)              { return __hip_atomic_load(p, __ATOMIC_RELAXED, __HIP_MEMORY_SCOPE_AGENT); }
__device__ __forceinline__ unsigned xb_add(unsigned* p, unsigned v) { return __hip_atomic_fetch_add(p, v, __ATOMIC_RELAXED, __HIP_MEMORY_SCOPE_AGENT); }
__device__ __forceinline__ unsigned xb_xcc_id() { return (unsigned)__builtin_amdgcn_s_getreg((3 << 11) | 20) & 0xFu; }
#define XB_SPIN(cond, bar) do { unsigned _sp = 0; while (cond) { __builtin_amdgcn_s_sleep(1); \
    if ((++_sp & 255u) == 0u) { if (xb_ld(&(bar)[XB_TMO])) break; if (_sp > XB_SPIN_CAP) { atomicAdd(&(bar)[XB_TMO], 1u); break; } } } } while (0)
struct XcdBarrier { unsigned* bar; unsigned x; volatile LAS unsigned* st; };
__device__ __forceinline__ XcdBarrier xcd_barrier_post(unsigned* bar, volatile LAS unsigned* st) {
    XcdBarrier b; b.bar = bar; b.x = xb_xcc_id(); b.st = st;
    if (threadIdx.x == 0) (void)xb_add(&bar[XB_XCNT(b.x)], 1u);
    return b;
}
__device__ __forceinline__ void xcd_barrier_complete(unsigned* bar, unsigned x, unsigned& nloc, unsigned& nx) {
    const unsigned G = gridDim.x * gridDim.y * gridDim.z;
    unsigned sum, cnt, mine, sp = 0u;
    for (;;) {
        sum = 0u; cnt = 0u; mine = 0u;
#pragma unroll
        for (unsigned j = 0; j < 16; ++j) { const unsigned c = xb_ld(&bar[XB_XCNT(j)]); sum += c; cnt += (c > 0u) ? 1u : 0u; mine = (j == x) ? c : mine; }
        if (sum == G) break;
        __builtin_amdgcn_s_sleep(1);
        if ((++sp & 255u) == 0u) { if (xb_ld(&bar[XB_TMO])) break; if (sp > XB_SPIN_CAP) { atomicAdd(&bar[XB_TMO], 1u); break; } }
    }
    nloc = mine > 0u ? mine : 1u; nx = cnt > 0u ? cnt : 1u;
}
__device__ __forceinline__ void xcd_barrier(const XcdBarrier& b) {
    asm volatile("s_waitcnt vmcnt(0)" ::: "memory");
    __syncthreads();
    if (threadIdx.x == 0) {
        unsigned* bar = b.bar;
        __builtin_amdgcn_s_waitcnt(0);
        unsigned nloc = b.st[0], nx = b.st[1];
        if (nloc == 0u) { xcd_barrier_complete(bar, b.x, nloc, nx); b.st[0] = nloc; b.st[1] = nx; }
        const unsigned old = xb_add(&bar[XB_XSUB(b.x)], 1u);
        const unsigned gen = old / nloc;
        if (old + 1u == (gen + 1u) * nloc) {
            __builtin_amdgcn_fence(__ATOMIC_RELEASE, "agent");
            asm volatile("s_waitcnt vmcnt(0)" ::: "memory");
            const unsigned og = xb_add(&bar[XB_TOP], 1u);
            const unsigned tg = og / nx;
            if (og + 1u == (tg + 1u) * nx) xb_add(&bar[XB_TOPGEN], 1u);
            else XB_SPIN(xb_ld(&bar[XB_TOPGEN]) == tg, bar);
            __builtin_amdgcn_fence(__ATOMIC_ACQUIRE, "agent");
            xb_add(&bar[XB_XGEN(b.x)], 1u);
            asm volatile("s_waitcnt vmcnt(0)" ::: "memory");
        } else {
            XB_SPIN(xb_ld(&bar[XB_XGEN(b.x)]) == gen, bar);
            __builtin_amdgcn_fence(__ATOMIC_ACQUIRE, "agent");
            asm volatile("s_waitcnt vmcnt(0)" ::: "memory");
        }
    }
    __syncthreads();
}

extern __shared__ __attribute__((aligned(16))) unsigned char dyn_lds[];

#if MK_MULTI
__global__ void __launch_bounds__(256, 2) k_phase(Params P, int ph) {
    const int bid = blockIdx.x, nb = gridDim.x;
    switch (ph) {
        case 0: phase0(P, bid, nb, dyn_lds); break;
        case 1: phase1(P, bid, nb, dyn_lds); break;
        case 2: phase2(P, bid, nb, dyn_lds); break;
        case 3: phase3(P, bid, nb); break;
        case 4: phase4(P, bid, nb, dyn_lds); break;
        case 5: phase5(P, bid, nb, dyn_lds); break;
        case 6: phase6(P, bid, nb, dyn_lds); break;
        case 7: phase7(P, bid, nb); break;
        default: phase8(P, bid, nb, dyn_lds); break;
    }
}
#else
__global__ void __launch_bounds__(256, 2) k_mega(Params P) {
    __shared__ uint4 xb_words;
    if (threadIdx.x == 0) xb_words = make_uint4(0u, 0u, 0u, 0u);
    __syncthreads();
    const XcdBarrier xb = xcd_barrier_post((unsigned*)(P.ws + OFF_BAR), (volatile LAS unsigned*)&xb_words);
    const int bid = blockIdx.x, nb = gridDim.x;
#ifndef REP
#define REP -1
#endif
#define PH(n, call) do { call; xcd_barrier(xb); if (REP == n) { call; xcd_barrier(xb); } } while (0)
    PH(0, phase0(P, bid, nb, dyn_lds));
    PH(1, phase1(P, bid, nb, dyn_lds));
    PH(2, phase2(P, bid, nb, dyn_lds));
    PH(3, phase3(P, bid, nb));
    PH(4, phase4(P, bid, nb, dyn_lds));
    PH(5, phase5(P, bid, nb, dyn_lds));
    PH(6, phase6(P, bid, nb, dyn_lds));
    PH(7, phase7(P, bid, nb));
    phase8(P, bid, nb, dyn_lds);
    if (REP == 8) { xcd_barrier(xb); phase8(P, bid, nb, dyn_lds); }
#if XMODE >= 0
    xcd_barrier(xb); phaseX<XMODE>(P, bid, nb, dyn_lds);
#endif
}
#endif

extern "C" void kernel_launch(void* const* d_in, const int* in_sizes, int n_in, void* d_out, int out_size, void* d_ws, size_t ws_size, hipStream_t stream) {
    static int grid = 0;
    if (grid == 0) {
        if (n_in != 20 || ws_size < WS_END) { fprintf(stderr, "kernel_launch: unexpected n_in %d or ws_size %zu (< %zu)\n", n_in, ws_size, (size_t)WS_END); grid = -1; return; }
        int dev = 0, cus = 0, per_cu = 0;
        hipGetDevice(&dev); hipDeviceGetAttribute(&cus, hipDeviceAttributeMultiprocessorCount, dev);
#if MK_MULTI
        hipFuncSetAttribute((const void*)k_phase, hipFuncAttributeMaxDynamicSharedMemorySize, LDS_BYTES);
        hipOccupancyMaxActiveBlocksPerMultiprocessor(&per_cu, (const void*)k_phase, 256, LDS_BYTES);
#else
        hipFuncSetAttribute((const void*)k_mega, hipFuncAttributeMaxDynamicSharedMemorySize, LDS_BYTES);
        hipOccupancyMaxActiveBlocksPerMultiprocessor(&per_cu, (const void*)k_mega, 256, LDS_BYTES);
#endif
        if (per_cu < 1) per_cu = 1;
        if (per_cu > 2) per_cu = 2;
        grid = (cus * per_cu) & ~7;
        (void)hipGetLastError();
    }
    if (grid < 0) return;
    Params P{};
    const float** pp = (const float**)&P;
    for (int i = 0; i < 20; ++i) pp[i] = (const float*)d_in[i];
    P.out = (float*)d_out; P.ws = (unsigned char*)d_ws;
#if MK_MULTI
    for (int ph = 0; ph < 9; ++ph) hipLaunchKernelGGL(k_phase, dim3(grid), dim3(256), LDS_BYTES, stream, P, ph);
#else
    (void)hipMemsetAsync((unsigned char*)d_ws + OFF_BAR, 0, XCD_BAR_WORDS * 4, stream);
    void* args[] = {&P};
    hipError_t e = hipLaunchCooperativeKernel((const void*)k_mega, dim3(grid), dim3(256), args, LDS_BYTES, stream);
    if (e != hipSuccess) fprintf(stderr, "cooperative launch failed: %s (grid %d)\n", hipGetErrorString(e), grid);
#endif
}
```

```cpp
#include <hip/hip_runtime.h>
#include <hip/hip_cooperative_groups.h>
#include <stdint.h>
#include <stdio.h>
namespace cg = cooperative_groups;

#ifndef MK_MULTI
#define MK_MULTI 0
#endif

typedef unsigned short bf16_t;
typedef short bf16x8 __attribute__((ext_vector_type(8)));
typedef float f32x4 __attribute__((ext_vector_type(4)));
typedef unsigned u32x4 __attribute__((ext_vector_type(4)));
typedef unsigned u32x2 __attribute__((ext_vector_type(2)));

constexpr int T = 32768, DM = 1024, SEQ = 8192, DPLE = 256, DIN = 3072;
constexpr int LC = 64;
constexpr int NCH = T / LC;
constexpr int CPB = SEQ / LC;
constexpr int KU = LC * 16;
constexpr int NS = 256;
constexpr int KA = KU + NS;
constexpr float EPS = 1e-6f;

constexpr size_t MB = 1ull << 20;
constexpr size_t OFF_XN = 0;
constexpr size_t OFF_MIXIN = OFF_XN;
constexpr size_t OFF_PB = OFF_XN + 64 * MB;
constexpr size_t OFF_WIN = OFF_PB + 16 * MB;
constexpr size_t OFF_WGLU = OFF_WIN + 6 * MB;
constexpr size_t OFF_WOUT = OFF_WGLU + 1 * MB;
constexpr size_t OFF_WPLE = OFF_WOUT + 2 * MB;
constexpr size_t OFF_WPG = OFF_WPLE + 1 * MB;
constexpr size_t OFF_UA = OFF_WPG + 2 * MB;
constexpr size_t OFF_ZS = OFF_UA + 40 * MB;
constexpr size_t OFF_Q = OFF_ZS + 32 * MB;
constexpr size_t OFF_K = OFF_Q + 32 * MB;
constexpr size_t OFF_VT = OFF_K + 32 * MB;
constexpr size_t OFF_ZN = OFF_VT + 32 * MB;
constexpr size_t OFF_MIX = OFF_Q;
constexpr size_t OFF_HB = OFF_VT;
constexpr size_t OFF_LAM = OFF_ZN + 32 * MB;
constexpr size_t OFF_BBAR = OFF_LAM + 3 * MB;
constexpr size_t OFF_KTAB = OFF_BBAR + 1 * MB;
constexpr size_t OFF_TQ = OFF_KTAB + 4 * MB;
constexpr size_t OFF_ERAW = OFF_TQ;
constexpr size_t OFF_PM = OFF_TQ + 80 * MB;
constexpr size_t OFF_S = OFF_PM + 16 * MB;
constexpr size_t OFF_YS = OFF_S + 16 * MB;
constexpr size_t OFF_SS = OFF_YS + 32 * MB;
constexpr size_t OFF_ESS = OFF_SS + 2 * MB;
constexpr size_t OFF_RSTD = OFF_ESS + 2 * MB;
constexpr size_t OFF_BAR = OFF_RSTD + 1 * MB;
constexpr size_t WS_END = OFF_BAR + 1 * MB;

struct Params {
    const float *x, *p, *norm_pre, *norm_post, *w_in, *a_re, *a_im, *log_dt, *b_re, *b_im, *c_re, *c_im, *ssm_d, *w_glu, *b_glu, *rpb, *w_out, *w_ple, *ple_norm, *w_pg;
    float* out;
    unsigned char* ws;
};

__device__ __forceinline__ unsigned pk2(float lo, float hi) { unsigned r; asm("v_cvt_pk_bf16_f32 %0, %1, %2" : "=v"(r) : "v"(lo), "v"(hi)); return r; }
__device__ __forceinline__ float bflo(unsigned w) { return __uint_as_float(w << 16); }
__device__ __forceinline__ float bfhi(unsigned w) { return __uint_as_float(w & 0xffff0000u); }
__device__ __forceinline__ void store_bf4(bf16_t* p, f32x4 v) { u32x2 w; w.x = pk2(v[0], v[1]); w.y = pk2(v[2], v[3]); *(u32x2*)p = w; }
__device__ __forceinline__ f32x4 load_bf4(const bf16_t* p) { u32x2 w = *(const u32x2*)p; f32x4 v; v[0] = bflo(w.x); v[1] = bfhi(w.x); v[2] = bflo(w.y); v[3] = bfhi(w.y); return v; }
__device__ __forceinline__ float sigmoidf_(float v) { return 1.f / (1.f + __expf(-v)); }
__device__ __forceinline__ float gelu_tanh(float v) { const float u = 0.7978845608028654f * (v + 0.044715f * v * v * v); const float th = 1.f - 2.f / (__expf(2.f * u) + 1.f); return 0.5f * v * (1.f + th); }

constexpr int LDS_TILE = 128 * 64;
constexpr int LDS_BYTES = 4 * LDS_TILE * 2;

template <class Epi, int MODE = 7>
__device__ __forceinline__ void gemm_tile(const bf16_t* __restrict__ A, int lda, const bf16_t* __restrict__ Bt, int ldb, int K, bf16_t* lds, const Epi& epi) {
    const int tid = threadIdx.x, lane = tid & 63, wid = tid >> 6, wm = wid >> 1, wn = wid & 1, fr = lane & 15, fq = lane >> 4;
    const int sr = tid >> 3, sc = (tid & 7) * 8;
    const int sw = sr * 64 + (((tid & 7) ^ (sr & 7)) * 8);
    const bf16_t* ga = A + (size_t)sr * lda + sc;
    const bf16_t* gb = Bt + (size_t)sr * ldb + sc;
    f32x4 acc[4][4];
#pragma unroll
    for (int mi = 0; mi < 4; ++mi)
#pragma unroll
        for (int ni = 0; ni < 4; ++ni) acc[mi][ni] = (f32x4){0.f, 0.f, 0.f, 0.f};
    u32x4 ra[4], rb[4];
    const int nk = K >> 6;
    const int fo0 = ((fq ^ (fr & 7)) * 8), fo1 = (((4 + fq) ^ (fr & 7)) * 8);
    const int arow = (wm * 64 + fr) * 64, brow = 2 * LDS_TILE + (wn * 64 + fr) * 64;
    if (MODE & 1) {
#pragma unroll
        for (int i = 0; i < 4; ++i) { ra[i] = *(const u32x4*)(ga + (size_t)(32 * i) * lda); rb[i] = *(const u32x4*)(gb + (size_t)(32 * i) * ldb); }
#pragma unroll
        for (int i = 0; i < 4; ++i) { *(u32x4*)(lds + sw + 32 * 64 * i) = ra[i]; *(u32x4*)(lds + 2 * LDS_TILE + sw + 32 * 64 * i) = rb[i]; }
    }
    __syncthreads();
    for (int kt = 0; kt < nk; ++kt) {
        const int buf = kt & 1;
        if (MODE & 1) {
            const int kp = kt + 1 < nk ? kt + 1 : kt;
#pragma unroll
            for (int i = 0; i < 4; ++i) { ra[i] = *(const u32x4*)(ga + (size_t)(32 * i) * lda + kp * 64); rb[i] = *(const u32x4*)(gb + (size_t)(32 * i) * ldb + kp * 64); }
        }
        __builtin_amdgcn_sched_barrier(0);
        if (MODE & 2) {
            const bf16_t* as = lds + buf * LDS_TILE + arow;
            const bf16_t* bs = lds + buf * LDS_TILE + brow;
            bf16x8 af[2][4], bfr[2][4];
#pragma unroll
            for (int ks = 0; ks < 2; ++ks) {
                const int fo = ks ? fo1 : fo0;
#pragma unroll
                for (int i = 0; i < 4; ++i) { af[ks][i] = *(const bf16x8*)(as + i * 16 * 64 + fo); bfr[ks][i] = *(const bf16x8*)(bs + i * 16 * 64 + fo); }
            }
            __builtin_amdgcn_sched_barrier(0);
#pragma unroll
            for (int ks = 0; ks < 2; ++ks)
#pragma unroll
                for (int mi = 0; mi < 4; ++mi)
#pragma unroll
                    for (int ni = 0; ni < 4; ++ni) acc[mi][ni] = __builtin_amdgcn_mfma_f32_16x16x32_bf16(bfr[ks][ni], af[ks][mi], acc[mi][ni], 0, 0, 0);
        }
        __builtin_amdgcn_sched_barrier(0);
        if ((MODE & 1) && kt + 1 < nk) {
            const int nb = buf ^ 1;
#pragma unroll
            for (int i = 0; i < 4; ++i) { *(u32x4*)(lds + nb * LDS_TILE + sw + 32 * 64 * i) = ra[i]; *(u32x4*)(lds + (2 + nb) * LDS_TILE + sw + 32 * 64 * i) = rb[i]; }
        }
        if (MODE & 4) __syncthreads();
    }
    epi(acc, wm * 64 + fr, wn * 64 + fq * 4);
}

struct EpiInProj {
    unsigned char* ws; int m0, n0;
    __device__ __forceinline__ void operator()(f32x4 (&acc)[4][4], int r0, int c0) const {
        const int sec = n0 >> 9;
#pragma unroll
        for (int mi = 0; mi < 4; ++mi) {
            const int t = m0 + r0 + mi * 16;
#pragma unroll
            for (int ni = 0; ni < 4; ++ni) {
                const int nn = (n0 + c0 + ni * 16) & 511; f32x4 v = acc[mi][ni];
                if (sec == 0) { const int g = nn >> 4, hh = nn & 15, ch = t / LC, j = t % LC; store_bf4((bf16_t*)(ws + OFF_UA) + ((size_t)(g * NCH + ch)) * KA + j * 16 + hh, v); }
                else if (sec == 1) store_bf4((bf16_t*)(ws + OFF_ZS) + (size_t)t * 512 + nn, v);
                else if (sec == 2) store_bf4((bf16_t*)(ws + OFF_Q) + (size_t)t * 512 + nn, v * 0.125f);
                else if (sec == 3) store_bf4((bf16_t*)(ws + OFF_K) + (size_t)t * 512 + nn, v);
                else if (sec == 4) { const int b = t >> 13, l = t & 8191; bf16_t* vt = (bf16_t*)(ws + OFF_VT) + ((size_t)(b * 512 + nn)) * SEQ + l; const unsigned w0 = pk2(v[0], v[1]), w1 = pk2(v[2], v[3]);
                    vt[0] = (bf16_t)(w0 & 0xffff); vt[SEQ] = (bf16_t)(w0 >> 16); vt[2 * SEQ] = (bf16_t)(w1 & 0xffff); vt[3 * SEQ] = (bf16_t)(w1 >> 16); }
                else store_bf4((bf16_t*)(ws + OFF_ZN) + (size_t)t * 512 + nn, v);
            }
        }
    }
};
struct EpiS {
    float* S; int m0, n0;
    __device__ __forceinline__ void operator()(f32x4 (&acc)[4][4], int r0, int c0) const {
#pragma unroll
        for (int mi = 0; mi < 4; ++mi)
#pragma unroll
            for (int ni = 0; ni < 4; ++ni) *(f32x4*)(S + (size_t)(m0 + r0 + mi * 16) * NS + n0 + c0 + ni * 16) = acc[mi][ni];
    }
};
struct EpiY {
    bf16_t* ys; int g, m0, n0;
    __device__ __forceinline__ void operator()(f32x4 (&acc)[4][4], int r0, int c0) const {
#pragma unroll
        for (int mi = 0; mi < 4; ++mi) {
            const int ch = m0 + r0 + mi * 16;
#pragma unroll
            for (int ni = 0; ni < 4; ++ni) {
                const int n = n0 + c0 + ni * 16, i = n >> 4, h = n & 15; f32x4 v = acc[mi][ni];
#pragma unroll
                for (int e = 0; e < 4; ++e) v[e] = gelu_tanh(v[e]);
                store_bf4(ys + ((size_t)ch * LC + i) * 512 + g * 16 + h, v);
            }
        }
    }
};
struct EpiGlu {
    const bf16_t* ys; const bf16_t* zs; const float* bglu; bf16_t* mixin; int m0, n0;
    __device__ __forceinline__ void operator()(f32x4 (&acc)[4][4], int r0, int c0) const {
#pragma unroll
        for (int mi = 0; mi < 4; ++mi) {
            const int t = m0 + r0 + mi * 16;
#pragma unroll
            for (int ni = 0; ni < 4; ++ni) {
                const int n = n0 + c0 + ni * 16; const f32x4 bv = *(const f32x4*)(bglu + n);
                const f32x4 y = load_bf4(ys + (size_t)t * 512 + n), z = load_bf4(zs + (size_t)t * 512 + n); f32x4 o;
#pragma unroll
                for (int e = 0; e < 4; ++e) o[e] = y[e] * sigmoidf_(acc[mi][ni][e] + bv[e]) * z[e] * sigmoidf_(z[e]);
                store_bf4(mixin + (size_t)t * 1024 + n, o);
            }
        }
    }
};
struct EpiStoreSS {
    bf16_t* dst; float* ss; int m0, n0;
    __device__ __forceinline__ void operator()(f32x4 (&acc)[4][4], int r0, int c0) const {
#pragma unroll
        for (int mi = 0; mi < 4; ++mi) {
            const int t = m0 + r0 + mi * 16; float s = 0.f;
#pragma unroll
            for (int ni = 0; ni < 4; ++ni) { const f32x4 v = acc[mi][ni]; s += (v[0] * v[0] + v[1] * v[1]) + (v[2] * v[2] + v[3] * v[3]); store_bf4(dst + (size_t)t * 1024 + n0 + c0 + ni * 16, v); }
            s += __shfl_xor(s, 16); s += __shfl_xor(s, 32);
            if ((threadIdx.x & 48) == 0) ss[(size_t)t * 16 + (n0 >> 7) * 2 + (c0 >> 6)] = s;
        }
    }
};
struct EpiFinal {
    const bf16_t* hb; const bf16_t* eraw; const float* rstd; const float* gple; float* out; int m0, n0;
    __device__ __forceinline__ void operator()(f32x4 (&acc)[4][4], int r0, int c0) const {
#pragma unroll
        for (int mi = 0; mi < 4; ++mi) {
            const int t = m0 + r0 + mi * 16; const float re = rstd[T + t];
#pragma unroll
            for (int ni = 0; ni < 4; ++ni) {
                const int n = n0 + c0 + ni * 16; const size_t off = (size_t)t * 1024 + n;
                const f32x4 ge = *(const f32x4*)(gple + n), hv = load_bf4(hb + off), ev = load_bf4(eraw + off); f32x4 o;
#pragma unroll
                for (int e = 0; e < 4; ++e) o[e] = hv[e] + sigmoidf_(acc[mi][ni][e]) * (ev[e] * re * ge[e]);
                *(f32x4*)(out + off) = o;
            }
        }
    }
};

__device__ __forceinline__ void ktab_unit(const Params& P, int u, float* ldsf) {
    const int dir = u >> 8, g = (u >> 3) & 31, mr = u & 7, tid = threadIdx.x;
    float2* lp = (float2*)ldsf;
    float2* bb = lp + 64 * 65;
    float2* cc = bb + 64 * 16;
    float2* lampow = (float2*)(P.ws + OFF_LAM); float2* bbar = (float2*)(P.ws + OFF_BBAR); float* ktab = (float*)(P.ws + OFF_KTAB);
    if (tid < 64) {
        const int p = tid, idx = (dir * 32 + g) * 64 + p;
        const float ar = P.a_re[idx], ai = P.a_im[idx], dt = expf(P.log_dt[dir * 32 + g]);
        const float mag = expf(dt * ar), ang = dt * ai; const float lr = mag * cosf(ang), li = mag * sinf(ang);
        const float nr = lr - 1.f, ni = li, den = ar * ar + ai * ai;
        const float cr = (nr * ar + ni * ai) / den, ci = (ni * ar - nr * ai) / den;
        float brv[16], biv[16];
#pragma unroll
        for (int h = 0; h < 16; ++h) { brv[h] = P.b_re[idx * 16 + h]; biv[h] = P.b_im[idx * 16 + h]; }
        float pr = 1.f, pi = 0.f;
        for (int m = 0; m <= 64; ++m) { lp[p * 65 + m] = make_float2(pr, pi); if (mr == 0) lampow[(size_t)idx * 65 + m] = make_float2(pr, pi); const float tt = pr * lr - pi * li; pi = pr * li + pi * lr; pr = tt; }
#pragma unroll
        for (int h = 0; h < 16; ++h) { const float2 v = make_float2(cr * brv[h] - ci * biv[h], cr * biv[h] + ci * brv[h]); bb[p * 16 + h] = v; if (mr == 0) bbar[(size_t)idx * 16 + h] = v; }
    }
#pragma unroll
    for (int i = 0; i < 4; ++i) { const int e = tid + 256 * i; cc[(e >> 6) * 65 + (e & 63)] = make_float2(P.c_re[(dir * 32 + g) * 1024 + e], P.c_im[(dir * 32 + g) * 1024 + e]); }
    __syncthreads();
    const int h = tid >> 4, h2 = tid & 15;
    float s[8];
#pragma unroll
    for (int mm = 0; mm < 8; ++mm) s[mm] = 0.f;
    for (int p = 0; p < 64; ++p) {
        const float2 c = cc[h * 65 + p], b = bb[p * 16 + h2];
        const float cbx = c.x * b.x - c.y * b.y, cby = c.x * b.y + c.y * b.x;
#pragma unroll
        for (int mm = 0; mm < 8; ++mm) { const float2 l = lp[p * 65 + mr * 8 + mm]; s[mm] += cbx * l.x - cby * l.y; }
    }
#pragma unroll
    for (int mm = 0; mm < 8; ++mm) ktab[((size_t)((dir * 32 + g) * 64 + mr * 8 + mm)) * 256 + h * 16 + h2] = s[mm];
    __syncthreads();
}
__device__ __forceinline__ void transpose_unit(const float* W, int K, int N, const float* gain, bf16_t* Wt, int item, float* ldsf) {
    const int nblk = N / 64, kb = item / nblk, nbk = item % nblk, k0 = kb * 64, n0 = nbk * 64, tid = threadIdx.x;
#pragma unroll 4
    for (int i = 0; i < 16; ++i) { const int kk = i * 4 + (tid >> 6), nn = tid & 63; float v = W[(size_t)(k0 + kk) * N + n0 + nn]; if (gain) v *= gain[k0 + kk]; ldsf[kk * 65 + nn] = v; }
    __syncthreads();
#pragma unroll 4
    for (int i = 0; i < 8; ++i) { const int nn = i * 8 + (tid >> 5), kk = (tid & 31) * 2; *(unsigned*)(Wt + (size_t)(n0 + nn) * K + k0 + kk) = pk2(ldsf[kk * 65 + nn], ldsf[(kk + 1) * 65 + nn]); }
    __syncthreads();
}
__device__ __forceinline__ float wave_sum(float v) {
#pragma unroll
    for (int o = 1; o < 64; o <<= 1) v += __shfl_xor(v, o);
    return v;
}
__device__ __forceinline__ void phase0(const Params& P, int bid, int nb, unsigned char* lds) {
    float* ldsf = (float*)lds;
    constexpr int U_K = 512, I_IN = 16 * 48, I_GLU = 64, I_OUT = 256, I_PLE = 4 * 16, I_PG = 256, U_T = I_IN + I_GLU + I_OUT + I_PLE + I_PG, U_X = T / 8, U_P = (T * DPLE) / 2048;
    constexpr int NU = U_K + U_T + U_X + U_P;
    const int tid = threadIdx.x, lane = tid & 63, wid = tid >> 6;
    for (int u = bid; u < NU; u += nb) {
        int r = u;
        if (r < U_K) { ktab_unit(P, r, ldsf); continue; } r -= U_K;
        if (r < U_T) {
            if (r < I_IN) { transpose_unit(P.w_in, 1024, 3072, P.norm_pre, (bf16_t*)(P.ws + OFF_WIN), r, ldsf); continue; } r -= I_IN;
            if (r < I_GLU) { transpose_unit(P.w_glu, 512, 512, nullptr, (bf16_t*)(P.ws + OFF_WGLU), r, ldsf); continue; } r -= I_GLU;
            if (r < I_OUT) { transpose_unit(P.w_out, 1024, 1024, nullptr, (bf16_t*)(P.ws + OFF_WOUT), r, ldsf); continue; } r -= I_OUT;
            if (r < I_PLE) { transpose_unit(P.w_ple, 256, 1024, nullptr, (bf16_t*)(P.ws + OFF_WPLE), r, ldsf); continue; } r -= I_PLE;
            transpose_unit(P.w_pg, 1024, 1024, nullptr, (bf16_t*)(P.ws + OFF_WPG), r, ldsf); continue;
        }
        r -= U_T;
        if (r < U_X) {
            const int t = r * 8 + wid * 2; const f32x4* xr = (const f32x4*)(P.x + (size_t)t * 1024) + lane; f32x4 v[8]; float s0 = 0.f, s1 = 0.f;
#pragma unroll
            for (int j = 0; j < 8; ++j) v[j] = xr[64 * j];
#pragma unroll
            for (int j = 0; j < 4; ++j) { s0 += (v[j][0] * v[j][0] + v[j][1] * v[j][1]) + (v[j][2] * v[j][2] + v[j][3] * v[j][3]); s1 += (v[4 + j][0] * v[4 + j][0] + v[4 + j][1] * v[4 + j][1]) + (v[4 + j][2] * v[4 + j][2] + v[4 + j][3] * v[4 + j][3]); }
            const float rs0 = rsqrtf(wave_sum(s0) * (1.f / 1024.f) + EPS), rs1 = rsqrtf(wave_sum(s1) * (1.f / 1024.f) + EPS);
            bf16_t* o = (bf16_t*)(P.ws + OFF_XN) + (size_t)t * 1024 + lane * 4;
#pragma unroll
            for (int j = 0; j < 4; ++j) { store_bf4(o + 256 * j, v[j] * rs0); store_bf4(o + 1024 + 256 * j, v[4 + j] * rs1); }
            continue;
        }
        r -= U_X;
        {
            const size_t e0 = (size_t)r * 2048 + tid * 8; const f32x4 a = *(const f32x4*)(P.p + e0), b = *(const f32x4*)(P.p + e0 + 4);
            u32x4 w; w.x = pk2(a[0], a[1]); w.y = pk2(a[2], a[3]); w.z = pk2(b[0], b[1]); w.w = pk2(b[2], b[3]);
            *(u32x4*)((bf16_t*)(P.ws + OFF_PB) + e0) = w;
        }
    }
}

__device__ __forceinline__ void tq_unit(const Params& P, int u) {
    static_assert(LC == 64, "tq_unit / pm_unit thread maps assume 64-token chunks");
    const int g = u / LC, i = u % LC, tid = threadIdx.x;
    const float* ktab = (const float*)(P.ws + OFF_KTAB); const float2* lampow = (const float2*)(P.ws + OFF_LAM); bf16_t* tq = (bf16_t*)(P.ws + OFF_TQ);
    const int h2 = (tid & 7) * 2;
#pragma unroll
    for (int half = 0; half < 2; ++half) {
        const int j = (tid >> 3) + 32 * half;
        const int ma = i > j ? i - j : 0, mb = j > i ? j - i : 0;
        const float wa = i >= j ? 1.f : 0.f, wb = j >= i ? 1.f : 0.f;
        const float* kf = ktab + ((size_t)((0 * 32 + g) * 64 + ma)) * 256 + h2; const float* kb = ktab + ((size_t)((1 * 32 + g) * 64 + mb)) * 256 + h2;
        float2 a[16], b[16];
#pragma unroll
        for (int h = 0; h < 16; ++h) { a[h] = *(const float2*)(kf + h * 16); b[h] = *(const float2*)(kb + h * 16); }
#pragma unroll
        for (int h = 0; h < 16; ++h) {
            float v0 = wa * a[h].x + wb * b[h].x, v1 = wa * a[h].y + wb * b[h].y;
            if (i == j) { const float dd = P.ssm_d[g * 16 + h]; v0 += (h == h2 ? dd : 0.f); v1 += (h == h2 + 1 ? dd : 0.f); }
            *(unsigned*)(tq + ((size_t)(g * KU + i * 16 + h)) * KA + j * 16 + h2) = pk2(v0, v1);
        }
    }
    {
        const int pn = tid & 127, dir = pn >> 6, p = pn & 63, m = dir == 0 ? i + 1 : LC - i;
        const float2 l = lampow[((size_t)((dir * 32 + g) * 64 + p)) * 65 + m];
        float cr[8], ci[8];
#pragma unroll
        for (int it = 0; it < 8; ++it) { const int h = it * 2 + (tid >> 7); cr[it] = P.c_re[((dir * 32 + g) * 16 + h) * 64 + p]; ci[it] = P.c_im[((dir * 32 + g) * 16 + h) * 64 + p]; }
#pragma unroll
        for (int it = 0; it < 8; ++it) { const int h = it * 2 + (tid >> 7);
            *(unsigned*)(tq + ((size_t)(g * KU + i * 16 + h)) * KA + KU + dir * 128 + p * 2) = pk2(cr[it] * l.x - ci[it] * l.y, -(cr[it] * l.y + ci[it] * l.x)); }
    }
}
__device__ __forceinline__ void pm_unit(const Params& P, int u) {
    const int g = u >> 4, rg = u & 15, tid = threadIdx.x;
    const float2* lampow = (const float2*)(P.ws + OFF_LAM); const float2* bbar = (const float2*)(P.ws + OFF_BBAR); bf16_t* pm = (bf16_t*)(P.ws + OFF_PM);
    const int h2 = (tid & 7) * 2;
#pragma unroll 4
    for (int q = 0; q < 8; ++q) {
        const int pidx = rg * 8 + q, dir = pidx >> 6, p = pidx & 63;
        const f32x4 bq = *(const f32x4*)(bbar + ((size_t)((dir * 32 + g) * 64 + p)) * 16 + h2);
#pragma unroll
        for (int half = 0; half < 2; ++half) {
            const int j = (tid >> 3) + 32 * half, m = dir == 0 ? LC - 1 - j : j;
            const float2 l = lampow[((size_t)((dir * 32 + g) * 64 + p)) * 65 + m];
            bf16_t* dst = pm + ((size_t)(g * NS + 2 * pidx)) * KU + j * 16 + h2;
            *(unsigned*)dst = pk2(l.x * bq[0] - l.y * bq[1], l.x * bq[2] - l.y * bq[3]);
            *(unsigned*)(dst + KU) = pk2(l.x * bq[1] + l.y * bq[0], l.x * bq[3] + l.y * bq[2]);
        }
    }
}
__device__ __forceinline__ void phase1(const Params& P, int bid, int nb, unsigned char* lds) {
    constexpr int U_TQ = 32 * LC, U_PM = 32 * 16;
    const int xcd = bid & 7, rank = bid >> 3, R = nb >> 3;
    for (int l = rank; l < 768; l += R) {
        const int nt = (xcd & 1) * 12 + l % 12, mt = (xcd >> 1) * 64 + l / 12; EpiInProj epi{P.ws, mt * 128, nt * 128};
        gemm_tile((const bf16_t*)(P.ws + OFF_XN) + (size_t)mt * 128 * 1024, 1024, (const bf16_t*)(P.ws + OFF_WIN) + (size_t)nt * 128 * 1024, 1024, 1024, (bf16_t*)lds, epi);
    }
    for (int u = bid; u < U_TQ + U_PM; u += nb) {
        if (u < U_TQ) tq_unit(P, u);
        else pm_unit(P, u - U_TQ);
    }
}

__device__ __forceinline__ void na_unit(const Params& P, int u, float* ldsf) {
    const int tid = threadIdx.x, lane = tid & 63, cb = tid >> 6, fr = lane & 15, fq = lane >> 4;
    const int r = u & 127, head = (u >> 7) & 7, b = u >> 10;
    const bf16_t* q = (const bf16_t*)(P.ws + OFF_Q); const bf16_t* k = (const bf16_t*)(P.ws + OFF_K); const bf16_t* vt = (const bf16_t*)(P.ws + OFF_VT); const bf16_t* zn = (const bf16_t*)(P.ws + OFF_ZN);
    bf16_t* mixin = (bf16_t*)(P.ws + OFF_MIXIN);
    for (int i = tid; i < 15 * 31; i += 256) ldsf[i] = P.rpb[head * 15 * 31 + i];
    const int rs = min(max(r - 4, 0), 120);
    const int cw0 = cb == 0 ? 0 : (cb == 1 ? 8 : (cb == 2 ? 24 : 32));
    const int c = cb * 16 + fr, cs = min(max(c - 8, 0), 48);
    const size_t tq = (size_t)b * SEQ + r * 64 + c;
    const bf16x8 qf0 = *(const bf16x8*)(q + tq * 512 + head * 64 + fq * 8), qf1 = *(const bf16x8*)(q + tq * 512 + head * 64 + 32 + fq * 8);
    f32x4 s[16];
    const int kcol = cw0 + (fr >> 2) * 8 + (fr & 3);
    const bf16_t* kbase = k + ((size_t)b * SEQ + rs * 64 + kcol) * 512 + head * 64 + fq * 8;
#pragma unroll
    for (int hf = 0; hf < 2; ++hf) {
        bf16x8 k0[8], k1[8];
#pragma unroll
        for (int t = 0; t < 8; ++t) { const int tt = hf * 8 + t; const bf16_t* kp = kbase + ((size_t)(tt >> 1) * 64 + (tt & 1) * 4) * 512; k0[t] = *(const bf16x8*)kp; k1[t] = *(const bf16x8*)(kp + 32); }
#pragma unroll
        for (int t = 0; t < 8; ++t) {
            f32x4 z = (f32x4){0.f, 0.f, 0.f, 0.f};
            z = __builtin_amdgcn_mfma_f32_16x16x32_bf16(k0[t], qf0, z, 0, 0, 0);
            z = __builtin_amdgcn_mfma_f32_16x16x32_bf16(k1[t], qf1, z, 0, 0, 0);
            s[hf * 8 + t] = z;
        }
    }
    __syncthreads();
    float mx = -3.0e38f;
#pragma unroll
    for (int t = 0; t < 16; ++t) {
        const int i = t >> 1, odd = t & 1, dr = rs + i - r + 7;
#pragma unroll
        for (int e = 0; e < 4; ++e) {
            const int ck = cw0 + fq * 8 + odd * 4 + e; const bool valid = (ck >= cs) && (ck < cs + 16);
            const int dc = min(max(ck - c + 15, 0), 30);
            const float bv = ldsf[dr * 31 + dc];
            const float sv = valid ? s[t][e] + bv : -3.0e38f;
            s[t][e] = sv; mx = fmaxf(mx, sv);
        }
    }
    mx = fmaxf(mx, __shfl_xor(mx, 16)); mx = fmaxf(mx, __shfl_xor(mx, 32));
    float l = 0.f;
#pragma unroll
    for (int t = 0; t < 16; ++t)
#pragma unroll
        for (int e = 0; e < 4; ++e) { const float pv = __expf(s[t][e] - mx); s[t][e] = pv; l += pv; }
    l += __shfl_xor(l, 16); l += __shfl_xor(l, 32);
    f32x4 o[4];
#pragma unroll
    for (int dt = 0; dt < 4; ++dt) o[dt] = (f32x4){0.f, 0.f, 0.f, 0.f};
    const bf16_t* vbase = vt + ((size_t)(b * 512 + head * 64 + fr)) * SEQ + rs * 64 + cw0 + fq * 8;
#pragma unroll
    for (int k2 = 0; k2 < 4; ++k2) {
        bf16x8 vf[2][4];
#pragma unroll
        for (int kk = 0; kk < 2; ++kk)
#pragma unroll
            for (int dt = 0; dt < 4; ++dt) vf[kk][dt] = *(const bf16x8*)(vbase + (size_t)dt * 16 * SEQ + (k2 * 2 + kk) * 64);
#pragma unroll
        for (int kk = 0; kk < 2; ++kk) {
            const int kq = k2 * 2 + kk;
            u32x4 pw; pw.x = pk2(s[2 * kq][0], s[2 * kq][1]); pw.y = pk2(s[2 * kq][2], s[2 * kq][3]); pw.z = pk2(s[2 * kq + 1][0], s[2 * kq + 1][1]); pw.w = pk2(s[2 * kq + 1][2], s[2 * kq + 1][3]);
            const bf16x8 pf = __builtin_bit_cast(bf16x8, pw);
#pragma unroll
            for (int dt = 0; dt < 4; ++dt) o[dt] = __builtin_amdgcn_mfma_f32_16x16x32_bf16(vf[kk][dt], pf, o[dt], 0, 0, 0);
        }
    }
    const float inv = 1.f / l;
#pragma unroll
    for (int dt = 0; dt < 4; ++dt) {
        const int d0 = head * 64 + dt * 16 + fq * 4; const f32x4 z = load_bf4(zn + tq * 512 + d0); f32x4 ov;
#pragma unroll
        for (int e = 0; e < 4; ++e) ov[e] = o[dt][e] * inv * z[e] * sigmoidf_(z[e]);
        store_bf4(mixin + tq * 1024 + 512 + d0, ov);
    }
    __syncthreads();
}
__device__ __forceinline__ void phase2(const Params& P, int bid, int nb, unsigned char* lds) {
    constexpr int MT = NCH / 128;
    const int xcd = bid & 7, rank = bid >> 3, R = nb >> 3;
    for (int l = rank; l < 4 * MT * 2; l += R) {
        const int mt = l % MT, nt = (l / MT) & 1, g = xcd + 8 * (l / (MT * 2)); EpiS epi{(float*)(P.ws + OFF_S) + (size_t)g * NCH * NS, mt * 128, nt * 128};
        gemm_tile((const bf16_t*)(P.ws + OFF_UA) + ((size_t)g * NCH + mt * 128) * KA, KA, (const bf16_t*)(P.ws + OFF_PM) + ((size_t)g * NS + nt * 128) * KU, KU, KU, (bf16_t*)lds, epi);
    }
    for (int l = rank; l < 512; l += R) na_unit(P, xcd * 512 + l, (float*)lds);
}

__device__ __forceinline__ void phase3(const Params& P, int bid, int nb) {
    const float2* lampow = (const float2*)(P.ws + OFF_LAM); const float2* S = (const float2*)(P.ws + OFF_S); bf16_t* ua = (bf16_t*)(P.ws + OFF_UA);
    for (int sidx = bid * 256 + threadIdx.x; sidx < 4 * 2 * 32 * 64; sidx += nb * 256) {
        const int p = sidx & 63, g = (sidx >> 6) & 31, dir = (sidx >> 11) & 1, b = sidx >> 12;
        const float2 L = lampow[((size_t)((dir * 32 + g) * 64 + p)) * 65 + LC];
        float hr = 0.f, hi = 0.f;
        const float2* Sp = S + ((size_t)(g * NCH + b * CPB)) * (NS / 2) + dir * 64 + p;
        bf16_t* up = ua + ((size_t)(g * NCH + b * CPB)) * KA + KU + dir * 128 + p * 2;
        for (int cb0 = 0; cb0 < CPB; cb0 += 16) {
            float2 sv[16];
#pragma unroll
            for (int uu = 0; uu < 16; ++uu) { const int c = dir == 0 ? cb0 + uu : CPB - 1 - (cb0 + uu); sv[uu] = Sp[(size_t)c * (NS / 2)]; }
#pragma unroll
            for (int uu = 0; uu < 16; ++uu) {
                const int c = dir == 0 ? cb0 + uu : CPB - 1 - (cb0 + uu);
                *(unsigned*)(up + (size_t)c * KA) = pk2(hr, hi);
                const float tr = L.x * hr - L.y * hi + sv[uu].x; hi = L.x * hi + L.y * hr + sv[uu].y; hr = tr;
            }
        }
    }
}

__device__ __forceinline__ void phase4(const Params& P, int bid, int nb, unsigned char* lds) {
    constexpr int MT = NCH / 128, NT = KU / 128;
    const int xcd = bid & 7, rank = bid >> 3, R = nb >> 3;
    for (int l = rank; l < 4 * MT * NT; l += R) {
        const int mt = l % MT, nt = (l / MT) % NT, g = xcd + 8 * (l / (MT * NT)); EpiY epi{(bf16_t*)(P.ws + OFF_YS), g, mt * 128, nt * 128};
        gemm_tile((const bf16_t*)(P.ws + OFF_UA) + ((size_t)g * NCH + mt * 128) * KA, KA, (const bf16_t*)(P.ws + OFF_TQ) + ((size_t)g * KU + nt * 128) * KA, KA, KA, (bf16_t*)lds, epi);
    }
}
__device__ __forceinline__ void phase5(const Params& P, int bid, int nb, unsigned char* lds) {
    const int xcd = bid & 7, rank = bid >> 3, R = nb >> 3;
    for (int l = rank; l < 128; l += R) {
        const int nt = l & 3, mt = xcd * 32 + (l >> 2); EpiGlu epi{(const bf16_t*)(P.ws + OFF_YS), (const bf16_t*)(P.ws + OFF_ZS), P.b_glu, (bf16_t*)(P.ws + OFF_MIXIN), mt * 128, nt * 128};
        gemm_tile((const bf16_t*)(P.ws + OFF_YS) + (size_t)mt * 128 * 512, 512, (const bf16_t*)(P.ws + OFF_WGLU) + (size_t)nt * 128 * 512, 512, 512, (bf16_t*)lds, epi);
    }
}
__device__ __forceinline__ void phase6(const Params& P, int bid, int nb, unsigned char* lds) {
    const int xcd = bid & 7, rank = bid >> 3, R = nb >> 3;
    for (int l = rank; l < 512; l += R) {
        const int v = l & 255, nt = v & 7, mt = xcd * 32 + (v >> 3);
        if (l < 256) {
            EpiStoreSS epi{(bf16_t*)(P.ws + OFF_MIX), (float*)(P.ws + OFF_SS), mt * 128, nt * 128};
            gemm_tile((const bf16_t*)(P.ws + OFF_MIXIN) + (size_t)mt * 128 * 1024, 1024, (const bf16_t*)(P.ws + OFF_WOUT) + (size_t)nt * 128 * 1024, 1024, 1024, (bf16_t*)lds, epi);
        } else {
            EpiStoreSS epi{(bf16_t*)(P.ws + OFF_ERAW), (float*)(P.ws + OFF_ESS), mt * 128, nt * 128};
            gemm_tile((const bf16_t*)(P.ws + OFF_PB) + (size_t)mt * 128 * 256, 256, (const bf16_t*)(P.ws + OFF_WPLE) + (size_t)nt * 128 * 256, 256, 256, (bf16_t*)lds, epi);
        }
    }
}
__device__ __forceinline__ void phase7(const Params& P, int bid, int nb) {
    const int tid = threadIdx.x, lane = tid & 63, wid = tid >> 6;
    const float* ss = (const float*)(P.ws + OFF_SS); const float* ess = (const float*)(P.ws + OFF_ESS); float* rstd = (float*)(P.ws + OFF_RSTD);
    const bf16_t* mix = (const bf16_t*)(P.ws + OFF_MIX); bf16_t* hb = (bf16_t*)(P.ws + OFF_HB);
    for (int u = bid; u < T / 8; u += nb) {
        const int t = u * 8 + wid * 2;
        const int tl = t + (lane >> 5), l5 = lane & 31;
        f32x4 xv[8], mv[8];
#pragma unroll
        for (int j = 0; j < 8; ++j) { const size_t off = (size_t)(t + (j >> 2)) * 1024 + lane * 4 + 256 * (j & 3); xv[j] = *(const f32x4*)(P.x + off); mv[j] = load_bf4(mix + off); }
        float v = l5 < 16 ? ss[(size_t)tl * 16 + l5] : ess[(size_t)tl * 16 + l5 - 16];
        v += __shfl_xor(v, 1); v += __shfl_xor(v, 2); v += __shfl_xor(v, 4); v += __shfl_xor(v, 8);
        const float rp0 = rsqrtf(__shfl(v, 0) * (1.f / 1024.f) + EPS), re0 = rsqrtf(__shfl(v, 16) * (1.f / 1024.f) + EPS);
        const float rp1 = rsqrtf(__shfl(v, 32) * (1.f / 1024.f) + EPS), re1 = rsqrtf(__shfl(v, 48) * (1.f / 1024.f) + EPS);
        if (lane == 0) { rstd[t] = rp0; rstd[T + t] = re0; rstd[t + 1] = rp1; rstd[T + t + 1] = re1; }
#pragma unroll
        for (int j = 0; j < 8; ++j) {
            const int n = lane * 4 + 256 * (j & 3); const size_t off = (size_t)(t + (j >> 2)) * 1024 + n; const float rp = (j >> 2) ? rp1 : rp0;
            const f32x4 gp = *(const f32x4*)(P.norm_post + n); f32x4 h;
#pragma unroll
            for (int e = 0; e < 4; ++e) h[e] = xv[j][e] + mv[j][e] * rp * gp[e];
            store_bf4(hb + off, h);
        }
    }
}
__device__ __forceinline__ void phase8(const Params& P, int bid, int nb, unsigned char* lds) {
    const int xcd = bid & 7, rank = bid >> 3, R = nb >> 3;
    for (int l = rank; l < 256; l += R) {
        const int nt = l & 7, mt = xcd * 32 + (l >> 3);
        EpiFinal epi{(const bf16_t*)(P.ws + OFF_HB), (const bf16_t*)(P.ws + OFF_ERAW), (const float*)(P.ws + OFF_RSTD), P.ple_norm, P.out, mt * 128, nt * 128};
        gemm_tile((const bf16_t*)(P.ws + OFF_HB) + (size_t)mt * 128 * 1024, 1024, (const bf16_t*)(P.ws + OFF_WPG) + (size_t)nt * 128 * 1024, 1024, 1024, (bf16_t*)lds, epi);
    }
}

#ifndef XMODE
#define XMODE -1
#endif
struct EpiDummy { float* out;
    __device__ __forceinline__ void operator()(f32x4 (&acc)[4][4], int r0, int c0) const {
        float s = 0.f;
#pragma unroll
        for (int mi = 0; mi < 4; ++mi)
#pragma unroll
            for (int ni = 0; ni < 4; ++ni) s += acc[mi][ni][0] + acc[mi][ni][1] + acc[mi][ni][2] + acc[mi][ni][3];
        if (s == 123456.789f) out[r0 + c0] = s;
    }
};
template <int MODE>
__device__ __forceinline__ void phaseX(const Params& P, int bid, int nb, unsigned char* lds) {
    const int xcd = bid & 7, rank = bid >> 3, R = nb >> 3;
    for (int l = rank; l < 256; l += R) {
        const int nt = l & 7, mt = xcd * 32 + (l >> 3); EpiDummy epi{(float*)(P.ws + OFF_S)};
        gemm_tile<EpiDummy, MODE>((const bf16_t*)(P.ws + OFF_HB) + (size_t)mt * 128 * 1024, 1024, (const bf16_t*)(P.ws + OFF_WPG) + (size_t)nt * 128 * 1024, 1024, 1024, (bf16_t*)lds, epi);
    }
}

#define XB_TMO      128
#define XB_XCNT(j)  (256  + 64 * (j))
#define XB_XSUB(j)  (1280 + 64 * (j))
#define XB_XGEN(j)  (2304 + 64 * (j))
#define XB_TOP      3328
#define XB_TOPGEN   3392
#define XCD_BAR_WORDS 3456
#define XB_SPIN_CAP (1u << 20)
#define LAS __attribute__((address_space(3)))
__device__ __forceinline__ unsigned xb_ld(unsigned* p)              { return __hip_atomic_load(p, __ATOMIC_RELAXED, __HIP_MEMORY_SCOPE_AGENT); }
__device__ __forceinline__ unsigned xb_add(unsigned* p, unsigned v) { return __hip_atomic_fetch_add(p, v, __ATOMIC_RELAXED, __HIP_MEMORY_SCOPE_AGENT); }
__device__ __forceinline__ unsigned xb_xcc_id() { return (unsigned)__builtin_amdgcn_s_getreg((3 << 11) | 20) & 0xFu; }
#define XB_SPIN(cond, bar) do { unsigned _sp = 0; while (cond) { __builtin_amdgcn_s_sleep(1); \
    if ((++_sp & 255u) == 0u) { if (xb_ld(&(bar)[XB_TMO])) break; if (_sp > XB_SPIN_CAP) { atomicAdd(&(bar)[XB_TMO], 1u); break; } } } } while (0)
struct XcdBarrier { unsigned* bar; unsigned x; volatile LAS unsigned* st; };
__device__ __forceinline__ XcdBarrier xcd_barrier_post(unsigned* bar, volatile LAS unsigned* st) {
    XcdBarrier b; b.bar = bar; b.x = xb_xcc_id(); b.st = st;
    if (threadIdx.x == 0) (void)xb_add(&bar[XB_XCNT(b.x)], 1u);
    return b;
}
__device__ __forceinline__ void xcd_barrier_complete(unsigned* bar, unsigned x, unsigned& nloc, unsigned& nx) {
    const unsigned G = gridDim.x * gridDim.y * gridDim.z;
    unsigned sum, cnt, mine, sp = 0u;
    for (;;) {
        sum = 0u; cnt = 0u; mine = 0u;
#pragma unroll
        for (unsigned j = 0; j < 16; ++j) { const unsigned c = xb_ld(&bar[XB_XCNT(j)]); sum += c; cnt += (c > 0u) ? 1u : 0u; mine = (j == x) ? c : mine; }
        if (sum == G) break;
        __builtin_amdgcn_s_sleep(1);
        if ((++sp & 255u) == 0u) { if (xb_ld(&bar[XB_TMO])) break; if (sp > XB_SPIN_CAP) { atomicAdd(&bar[XB_TMO], 1u); break; } }
    }
    nloc = mine > 0u ? mine : 1u; nx = cnt > 0u ? cnt : 1u;
}
__device__ __forceinline__ void xcd_barrier(const XcdBarrier& b) {
    asm volatile("s_waitcnt vmcnt(0)" ::: "memory");
    __syncthreads();
    if (threadIdx.x == 0) {
        unsigned* bar = b.bar;
        __builtin_amdgcn_s_waitcnt(0);
        unsigned nloc = b.st[0], nx = b.st[1];
        if (nloc == 0u) { xcd_barrier_complete(bar, b.x, nloc, nx); b.st[0] = nloc; b.st[1] = nx; }
        const unsigned old = xb_add(&bar[XB_XSUB(b.x)], 1u);
        const unsigned gen = old / nloc;
        if (old + 1u == (gen + 1u) * nloc) {
            __builtin_amdgcn_fence(__ATOMIC_RELEASE, "agent");
            asm volatile("s_waitcnt vmcnt(0)" ::: "memory");
            const unsigned og = xb_add(&bar[XB_TOP], 1u);
            const unsigned tg = og / nx;
            if (og + 1u == (tg + 1u) * nx) xb_add(&bar[XB_TOPGEN], 1u);
            else XB_SPIN(xb_ld(&bar[XB_TOPGEN]) == tg, bar);
            __builtin_amdgcn_fence(__ATOMIC_ACQUIRE, "agent");
            xb_add(&bar[XB_XGEN(b.x)], 1u);
            asm volatile("s_waitcnt vmcnt(0)" ::: "memory");
        } else {
            XB_SPIN(xb_ld(&bar[XB_XGEN(b.x)]) == gen, bar);
            __builtin_amdgcn_fence(__ATOMIC_ACQUIRE, "agent");
            asm volatile("s_waitcnt vmcnt(0)" ::: "memory");
        }
    }
    __syncthreads();
}

extern __shared__ __attribute__((aligned(16))) unsigned char dyn_lds[];

#if MK_MULTI
__global__ void __launch_bounds__(256, 2) k_phase(Params P, int ph) {
    const int bid = blockIdx.x, nb = gridDim.x;
    switch (ph) {
        case 0: phase0(P, bid, nb, dyn_lds); break;
        case 1: phase1(P, bid, nb, dyn_lds); break;
        case 2: phase2(P, bid, nb, dyn_lds); break;
        case 3: phase3(P, bid, nb); break;
        case 4: phase4(P, bid, nb, dyn_lds); break;
        case 5: phase5(P, bid, nb, dyn_lds); break;
        case 6: phase6(P, bid, nb, dyn_lds); break;
        case 7: phase7(P, bid, nb); break;
        default: phase8(P, bid, nb, dyn_lds); break;
    }
}
#else
__global__ void __launch_bounds__(256, 2) k_mega(Params P) {
    __shared__ uint4 xb_words;
    if (threadIdx.x == 0) xb_words = make_uint4(0u, 0u, 0u, 0u);
    __syncthreads();
    const XcdBarrier xb = xcd_barrier_post((unsigned*)(P.ws + OFF_BAR), (volatile LAS unsigned*)&xb_words);
    const int bid = blockIdx.x, nb = gridDim.x;
#ifndef REP
#define REP -1
#endif
#define PH(n, call) do { call; xcd_barrier(xb); if (REP == n) { call; xcd_barrier(xb); } } while (0)
    PH(0, phase0(P, bid, nb, dyn_lds));
    PH(1, phase1(P, bid, nb, dyn_lds));
    PH(2, phase2(P, bid, nb, dyn_lds));
    PH(3, phase3(P, bid, nb));
    PH(4, phase4(P, bid, nb, dyn_lds));
    PH(5, phase5(P, bid, nb, dyn_lds));
    PH(6, phase6(P, bid, nb, dyn_lds));
    PH(7, phase7(P, bid, nb));
    phase8(P, bid, nb, dyn_lds);
    if (REP == 8) { xcd_barrier(xb); phase8(P, bid, nb, dyn_lds); }
#if XMODE >= 0
    xcd_barrier(xb); phaseX<XMODE>(P, bid, nb, dyn_lds);
#endif
}
#endif

extern "C" void kernel_launch(void* const* d_in, const int* in_sizes, int n_in, void* d_out, int out_size, void* d_ws, size_t ws_size, hipStream_t stream) {
    static int grid = 0;
    if (grid == 0) {
        if (n_in != 20 || ws_size < WS_END) { fprintf(stderr, "kernel_launch: unexpected n_in %d or ws_size %zu (< %zu)\n", n_in, ws_size, (size_t)WS_END); grid = -1; return; }
        int dev = 0, cus = 0, per_cu = 0;
        hipGetDevice(&dev); hipDeviceGetAttribute(&cus, hipDeviceAttributeMultiprocessorCount, dev);
#if MK_MULTI
        hipFuncSetAttribute((const void*)k_phase, hipFuncAttributeMaxDynamicSharedMemorySize, LDS_BYTES);
        hipOccupancyMaxActiveBlocksPerMultiprocessor(&per_cu, (const void*)k_phase, 256, LDS_BYTES);
#else
        hipFuncSetAttribute((const void*)k_mega, hipFuncAttributeMaxDynamicSharedMemorySize, LDS_BYTES);
        hipOccupancyMaxActiveBlocksPerMultiprocessor(&per_cu, (const void*)k_mega, 256, LDS_BYTES);
#endif
        if (per_cu < 1) per_cu = 1;
        if (per_cu > 2) per_cu = 2;
        grid = (cus * per_cu) & ~7;
        (void)hipGetLastError();
    }
    if (grid < 0) return;
    Params P{};
    const float** pp = (const float**)&P;
    for (int i = 0; i < 20; ++i) pp[i] = (const float*)d_in[i];
    P.out = (float*)d_out; P.ws = (unsigned char*)d_ws;
#if MK_MULTI
    for (int ph = 0; ph < 9; ++ph) hipLaunchKernelGGL(k_phase, dim3(grid), dim3(256), LDS_BYTES, stream, P, ph);
#else
    (void)hipMemsetAsync((unsigned char*)d_ws + OFF_BAR, 0, XCD_BAR_WORDS * 4, stream);
    void* args[] = {&P};
    hipError_t e = hipLaunchCooperativeKernel((const void*)k_mega, dim3(grid), dim3(256), args, LDS_BYTES, stream);
    if (e != hipSuccess) fprintf(stderr, "cooperative launch failed: %s (grid %d)\n", hipGetErrorString(e), grid);
#endif
}
```

```cpp
#include <hip/hip_runtime.h>
#include <hip/hip_cooperative_groups.h>
#include <stdint.h>
#include <stdio.h>
namespace cg = cooperative_groups;

#ifndef MK_MULTI
#define MK_MULTI 0
#endif

typedef unsigned short bf16_t;
typedef short bf16x8 __attribute__((ext_vector_type(8)));
typedef float f32x4 __attribute__((ext_vector_type(4)));
typedef unsigned u32x4 __attribute__((ext_vector_type(4)));
typedef unsigned u32x2 __attribute__((ext_vector_type(2)));

constexpr int T = 32768, DM = 1024, SEQ = 8192, DPLE = 256, DIN = 3072;
constexpr int LC = 64;
constexpr int NCH = T / LC;
constexpr int CPB = SEQ / LC;
constexpr int KU = LC * 16;
constexpr int NS = 256;
constexpr int KA = KU + NS;
constexpr float EPS = 1e-6f;

constexpr size_t MB = 1ull << 20;
constexpr size_t OFF_XN = 0;
constexpr size_t OFF_MIXIN = OFF_XN;
constexpr size_t OFF_PB = OFF_XN + 64 * MB;
constexpr size_t OFF_WIN = OFF_PB + 16 * MB;
constexpr size_t OFF_WGLU = OFF_WIN + 6 * MB;
constexpr size_t OFF_WOUT = OFF_WGLU + 1 * MB;
constexpr size_t OFF_WPLE = OFF_WOUT + 2 * MB;
constexpr size_t OFF_WPG = OFF_WPLE + 1 * MB;
constexpr size_t OFF_UA = OFF_WPG + 2 * MB;
constexpr size_t OFF_ZS = OFF_UA + 40 * MB;
constexpr size_t OFF_Q = OFF_ZS + 32 * MB;
constexpr size_t OFF_K = OFF_Q + 32 * MB;
constexpr size_t OFF_VT = OFF_K + 32 * MB;
constexpr size_t OFF_ZN = OFF_VT + 32 * MB;
constexpr size_t OFF_MIX = OFF_Q;
constexpr size_t OFF_HB = OFF_VT;
constexpr size_t OFF_LAM = OFF_ZN + 32 * MB;
constexpr size_t OFF_BBAR = OFF_LAM + 3 * MB;
constexpr size_t OFF_KTAB = OFF_BBAR + 1 * MB;
constexpr size_t OFF_TQ = OFF_KTAB + 4 * MB;
constexpr size_t OFF_ERAW = OFF_TQ;
constexpr size_t OFF_PM = OFF_TQ + 80 * MB;
constexpr size_t OFF_S = OFF_PM + 16 * MB;
constexpr size_t OFF_YS = OFF_S + 16 * MB;
constexpr size_t OFF_SS = OFF_YS + 32 * MB;
constexpr size_t OFF_ESS = OFF_SS + 2 * MB;
constexpr size_t OFF_RSTD = OFF_ESS + 2 * MB;
constexpr size_t OFF_BAR = OFF_RSTD + 1 * MB;
constexpr size_t WS_END = OFF_BAR + 1 * MB;

struct Params {
    const float *x, *p, *norm_pre, *norm_post, *w_in, *a_re, *a_im, *log_dt, *b_re, *b_im, *c_re, *c_im, *ssm_d, *w_glu, *b_glu, *rpb, *w_out, *w_ple, *ple_norm, *w_pg;
    float* out;
    unsigned char* ws;
};

__device__ __forceinline__ unsigned pk2(float lo, float hi) { unsigned r; asm("v_cvt_pk_bf16_f32 %0, %1, %2" : "=v"(r) : "v"(lo), "v"(hi)); return r; }
__device__ __forceinline__ float bflo(unsigned w) { return __uint_as_float(w << 16); }
__device__ __forceinline__ float bfhi(unsigned w) { return __uint_as_float(w & 0xffff0000u); }
__device__ __forceinline__ void store_bf4(bf16_t* p, f32x4 v) { u32x2 w; w.x = pk2(v[0], v[1]); w.y = pk2(v[2], v[3]); *(u32x2*)p = w; }
__device__ __forceinline__ f32x4 load_bf4(const bf16_t* p) { u32x2 w = *(const u32x2*)p; f32x4 v; v[0] = bflo(w.x); v[1] = bfhi(w.x); v[2] = bflo(w.y); v[3] = bfhi(w.y); return v; }
__device__ __forceinline__ float sigmoidf_(float v) { return 1.f / (1.f + __expf(-v)); }
__device__ __forceinline__ float gelu_tanh(float v) { const float u = 0.7978845608028654f * (v + 0.044715f * v * v * v); const float th = 1.f - 2.f / (__expf(2.f * u) + 1.f); return 0.5f * v * (1.f + th); }

constexpr int LDS_TILE = 128 * 64;
constexpr int LDS_BYTES = 4 * LDS_TILE * 2;

template <class Epi, int MODE = 7>
__device__ __forceinline__ void gemm_tile(const bf16_t* __restrict__ A, int lda, const bf16_t* __restrict__ Bt, int ldb, int K, bf16_t* lds, const Epi& epi) {
    const int tid = threadIdx.x, lane = tid & 63, wid = tid >> 6, wm = wid >> 1, wn = wid & 1, fr = lane & 15, fq = lane >> 4;
    const int sr = tid >> 3, sc = (tid & 7) * 8;
    const int sw = sr * 64 + (((tid & 7) ^ (sr & 7)) * 8);
    const bf16_t* ga = A + (size_t)sr * lda + sc;
    const bf16_t* gb = Bt + (size_t)sr * ldb + sc;
    f32x4 acc[4][4];
#pragma unroll
    for (int mi = 0; mi < 4; ++mi)
#pragma unroll
        for (int ni = 0; ni < 4; ++ni) acc[mi][ni] = (f32x4){0.f, 0.f, 0.f, 0.f};
    u32x4 ra[4], rb[4];
    const int nk = K >> 6;
    const int fo0 = ((fq ^ (fr & 7)) * 8), fo1 = (((4 + fq) ^ (fr & 7)) * 8);
    const int arow = (wm * 64 + fr) * 64, brow = 2 * LDS_TILE + (wn * 64 + fr) * 64;
    if (MODE & 1) {
#pragma unroll
        for (int i = 0; i < 4; ++i) { ra[i] = *(const u32x4*)(ga + (size_t)(32 * i) * lda); rb[i] = *(const u32x4*)(gb + (size_t)(32 * i) * ldb); }
#pragma unroll
        for (int i = 0; i < 4; ++i) { *(u32x4*)(lds + sw + 32 * 64 * i) = ra[i]; *(u32x4*)(lds + 2 * LDS_TILE + sw + 32 * 64 * i) = rb[i]; }
    }
    __syncthreads();
    for (int kt = 0; kt < nk; ++kt) {
        const int buf = kt & 1;
        if (MODE & 1) {
            const int kp = kt + 1 < nk ? kt + 1 : kt;
#pragma unroll
            for (int i = 0; i < 4; ++i) { ra[i] = *(const u32x4*)(ga + (size_t)(32 * i) * lda + kp * 64); rb[i] = *(const u32x4*)(gb + (size_t)(32 * i) * ldb + kp * 64); }
        }
        __builtin_amdgcn_sched_barrier(0);
        if (MODE & 2) {
            const bf16_t* as = lds + buf * LDS_TILE + arow;
            const bf16_t* bs = lds + buf * LDS_TILE + brow;
            bf16x8 af[2][4], bfr[2][4];
#pragma unroll
            for (int ks = 0; ks < 2; ++ks) {
                const int fo = ks ? fo1 : fo0;
#pragma unroll
                for (int i = 0; i < 4; ++i) { af[ks][i] = *(const bf16x8*)(as + i * 16 * 64 + fo); bfr[ks][i] = *(const bf16x8*)(bs + i * 16 * 64 + fo); }
            }
            __builtin_amdgcn_sched_barrier(0);
            __builtin_amdgcn_s_setprio(1);
#pragma unroll
            for (int ks = 0; ks < 2; ++ks)
#pragma unroll
                for (int mi = 0; mi < 4; ++mi)
#pragma unroll
                    for (int ni = 0; ni < 4; ++ni) acc[mi][ni] = __builtin_amdgcn_mfma_f32_16x16x32_bf16(bfr[ks][ni], af[ks][mi], acc[mi][ni], 0, 0, 0);
        }
        __builtin_amdgcn_s_setprio(0);
        __builtin_amdgcn_sched_barrier(0);
        if ((MODE & 1) && kt + 1 < nk) {
            const int nb = buf ^ 1;
#pragma unroll
            for (int i = 0; i < 4; ++i) { *(u32x4*)(lds + nb * LDS_TILE + sw + 32 * 64 * i) = ra[i]; *(u32x4*)(lds + (2 + nb) * LDS_TILE + sw + 32 * 64 * i) = rb[i]; }
        }
        if (MODE & 4) __syncthreads();
    }
    epi(acc, wm * 64 + fr, wn * 64 + fq * 4);
}

struct EpiInProj {
    unsigned char* ws; int m0, n0;
    __device__ __forceinline__ void operator()(f32x4 (&acc)[4][4], int r0, int c0) const {
        const int sec = n0 >> 9;
#pragma unroll
        for (int mi = 0; mi < 4; ++mi) {
            const int t = m0 + r0 + mi * 16;
#pragma unroll
            for (int ni = 0; ni < 4; ++ni) {
                const int nn = (n0 + c0 + ni * 16) & 511; f32x4 v = acc[mi][ni];
                if (sec == 0) { const int g = nn >> 4, hh = nn & 15, ch = t / LC, j = t % LC; store_bf4((bf16_t*)(ws + OFF_UA) + ((size_t)(g * NCH + ch)) * KA + j * 16 + hh, v); }
                else if (sec == 1) store_bf4((bf16_t*)(ws + OFF_ZS) + (size_t)t * 512 + nn, v);
                else if (sec == 2) store_bf4((bf16_t*)(ws + OFF_Q) + (size_t)t * 512 + nn, v * 0.125f);
                else if (sec == 3) store_bf4((bf16_t*)(ws + OFF_K) + (size_t)t * 512 + nn, v);
                else if (sec == 4) { const int b = t >> 13, l = t & 8191; bf16_t* vt = (bf16_t*)(ws + OFF_VT) + ((size_t)(b * 512 + nn)) * SEQ + l; const unsigned w0 = pk2(v[0], v[1]), w1 = pk2(v[2], v[3]);
                    vt[0] = (bf16_t)(w0 & 0xffff); vt[SEQ] = (bf16_t)(w0 >> 16); vt[2 * SEQ] = (bf16_t)(w1 & 0xffff); vt[3 * SEQ] = (bf16_t)(w1 >> 16); }
                else store_bf4((bf16_t*)(ws + OFF_ZN) + (size_t)t * 512 + nn, v);
            }
        }
    }
};
struct EpiS {
    float* S; int m0, n0;
    __device__ __forceinline__ void operator()(f32x4 (&acc)[4][4], int r0, int c0) const {
#pragma unroll
        for (int mi = 0; mi < 4; ++mi)
#pragma unroll
            for (int ni = 0; ni < 4; ++ni) *(f32x4*)(S + (size_t)(m0 + r0 + mi * 16) * NS + n0 + c0 + ni * 16) = acc[mi][ni];
    }
};
struct EpiY {
    bf16_t* ys; int g, m0, n0;
    __device__ __forceinline__ void operator()(f32x4 (&acc)[4][4], int r0, int c0) const {
#pragma unroll
        for (int mi = 0; mi < 4; ++mi) {
            const int ch = m0 + r0 + mi * 16;
#pragma unroll
            for (int ni = 0; ni < 4; ++ni) {
                const int n = n0 + c0 + ni * 16, i = n >> 4, h = n & 15; f32x4 v = acc[mi][ni];
#pragma unroll
                for (int e = 0; e < 4; ++e) v[e] = gelu_tanh(v[e]);
                store_bf4(ys + ((size_t)ch * LC + i) * 512 + g * 16 + h, v);
            }
        }
    }
};
struct EpiGlu {
    const bf16_t* ys; const bf16_t* zs; const float* bglu; bf16_t* mixin; int m0, n0;
    __device__ __forceinline__ void operator()(f32x4 (&acc)[4][4], int r0, int c0) const {
#pragma unroll
        for (int mi = 0; mi < 4; ++mi) {
            const int t = m0 + r0 + mi * 16;
#pragma unroll
            for (int ni = 0; ni < 4; ++ni) {
                const int n = n0 + c0 + ni * 16; const f32x4 bv = *(const f32x4*)(bglu + n);
                const f32x4 y = load_bf4(ys + (size_t)t * 512 + n), z = load_bf4(zs + (size_t)t * 512 + n); f32x4 o;
#pragma unroll
                for (int e = 0; e < 4; ++e) o[e] = y[e] * sigmoidf_(acc[mi][ni][e] + bv[e]) * z[e] * sigmoidf_(z[e]);
                store_bf4(mixin + (size_t)t * 1024 + n, o);
            }
        }
    }
};
struct EpiStoreSS {
    bf16_t* dst; float* ss; int m0, n0;
    __device__ __forceinline__ void operator()(f32x4 (&acc)[4][4], int r0, int c0) const {
#pragma unroll
        for (int mi = 0; mi < 4; ++mi) {
            const int t = m0 + r0 + mi * 16; float s = 0.f;
#pragma unroll
            for (int ni = 0; ni < 4; ++ni) { const f32x4 v = acc[mi][ni]; s += (v[0] * v[0] + v[1] * v[1]) + (v[2] * v[2] + v[3] * v[3]); store_bf4(dst + (size_t)t * 1024 + n0 + c0 + ni * 16, v); }
            s += __shfl_xor(s, 16); s += __shfl_xor(s, 32);
            if ((threadIdx.x & 48) == 0) ss[(size_t)t * 16 + (n0 >> 7) * 2 + (c0 >> 6)] = s;
        }
    }
};
struct EpiFinal {
    const bf16_t* hb; const bf16_t* eraw; const float* rstd; const float* gple; float* out; int m0, n0;
    __device__ __forceinline__ void operator()(f32x4 (&acc)[4][4], int r0, int c0) const {
#pragma unroll
        for (int mi = 0; mi < 4; ++mi) {
            const int t = m0 + r0 + mi * 16; const float re = rstd[T + t];
#pragma unroll
            for (int ni = 0; ni < 4; ++ni) {
                const int n = n0 + c0 + ni * 16; const size_t off = (size_t)t * 1024 + n;
                const f32x4 ge = *(const f32x4*)(gple + n), hv = load_bf4(hb + off), ev = load_bf4(eraw + off); f32x4 o;
#pragma unroll
                for (int e = 0; e < 4; ++e) o[e] = hv[e] + sigmoidf_(acc[mi][ni][e]) * (ev[e] * re * ge[e]);
                *(f32x4*)(out + off) = o;
            }
        }
    }
};

__device__ __forceinline__ void ktab_unit(const Params& P, int u, float* ldsf) {
    const int dir = u >> 8, g = (u >> 3) & 31, mr = u & 7, tid = threadIdx.x;
    float2* lp = (float2*)ldsf;
    float2* bb = lp + 64 * 65;
    float2* cc = bb + 64 * 16;
    float2* lampow = (float2*)(P.ws + OFF_LAM); float2* bbar = (float2*)(P.ws + OFF_BBAR); float* ktab = (float*)(P.ws + OFF_KTAB);
    if (tid < 64) {
        const int p = tid, idx = (dir * 32 + g) * 64 + p;
        const float ar = P.a_re[idx], ai = P.a_im[idx], dt = expf(P.log_dt[dir * 32 + g]);
        const float mag = expf(dt * ar), ang = dt * ai; const float lr = mag * cosf(ang), li = mag * sinf(ang);
        const float nr = lr - 1.f, ni = li, den = ar * ar + ai * ai;
        const float cr = (nr * ar + ni * ai) / den, ci = (ni * ar - nr * ai) / den;
        float brv[16], biv[16];
#pragma unroll
        for (int h = 0; h < 16; ++h) { brv[h] = P.b_re[idx * 16 + h]; biv[h] = P.b_im[idx * 16 + h]; }
        float pr = 1.f, pi = 0.f;
        for (int m = 0; m <= 64; ++m) { lp[p * 65 + m] = make_float2(pr, pi); if (mr == 0) lampow[(size_t)idx * 65 + m] = make_float2(pr, pi); const float tt = pr * lr - pi * li; pi = pr * li + pi * lr; pr = tt; }
#pragma unroll
        for (int h = 0; h < 16; ++h) { const float2 v = make_float2(cr * brv[h] - ci * biv[h], cr * biv[h] + ci * brv[h]); bb[p * 16 + h] = v; if (mr == 0) bbar[(size_t)idx * 16 + h] = v; }
    }
#pragma unroll
    for (int i = 0; i < 4; ++i) { const int e = tid + 256 * i; cc[(e >> 6) * 65 + (e & 63)] = make_float2(P.c_re[(dir * 32 + g) * 1024 + e], P.c_im[(dir * 32 + g) * 1024 + e]); }
    __syncthreads();
    const int h = tid >> 4, h2 = tid & 15;
    float s[8];
#pragma unroll
    for (int mm = 0; mm < 8; ++mm) s[mm] = 0.f;
    for (int p = 0; p < 64; ++p) {
        const float2 c = cc[h * 65 + p], b = bb[p * 16 + h2];
        const float cbx = c.x * b.x - c.y * b.y, cby = c.x * b.y + c.y * b.x;
#pragma unroll
        for (int mm = 0; mm < 8; ++mm) { const float2 l = lp[p * 65 + mr * 8 + mm]; s[mm] += cbx * l.x - cby * l.y; }
    }
#pragma unroll
    for (int mm = 0; mm < 8; ++mm) ktab[((size_t)((dir * 32 + g) * 64 + mr * 8 + mm)) * 256 + h * 16 + h2] = s[mm];
    __syncthreads();
}
__device__ __forceinline__ void transpose_unit(const float* W, int K, int N, const float* gain, bf16_t* Wt, int item, float* ldsf) {
    const int nblk = N / 64, kb = item / nblk, nbk = item % nblk, k0 = kb * 64, n0 = nbk * 64, tid = threadIdx.x;
#pragma unroll 4
    for (int i = 0; i < 16; ++i) { const int kk = i * 4 + (tid >> 6), nn = tid & 63; float v = W[(size_t)(k0 + kk) * N + n0 + nn]; if (gain) v *= gain[k0 + kk]; ldsf[kk * 65 + nn] = v; }
    __syncthreads();
#pragma unroll 4
    for (int i = 0; i < 8; ++i) { const int nn = i * 8 + (tid >> 5), kk = (tid & 31) * 2; *(unsigned*)(Wt + (size_t)(n0 + nn) * K + k0 + kk) = pk2(ldsf[kk * 65 + nn], ldsf[(kk + 1) * 65 + nn]); }
    __syncthreads();
}
__device__ __forceinline__ float wave_sum(float v) {
#pragma unroll
    for (int o = 1; o < 64; o <<= 1) v += __shfl_xor(v, o);
    return v;
}
__device__ __forceinline__ void phase0(const Params& P, int bid, int nb, unsigned char* lds) {
    float* ldsf = (float*)lds;
    constexpr int U_K = 512, I_IN = 16 * 48, I_GLU = 64, I_OUT = 256, I_PLE = 4 * 16, I_PG = 256, U_T = I_IN + I_GLU + I_OUT + I_PLE + I_PG, U_X = T / 8, U_P = (T * DPLE) / 2048;
    constexpr int NU = U_K + U_T + U_X + U_P;
    const int tid = threadIdx.x, lane = tid & 63, wid = tid >> 6;
    for (int u = bid; u < NU; u += nb) {
        int r = u;
        if (r < U_K) { ktab_unit(P, r, ldsf); continue; } r -= U_K;
        if (r < U_T) {
            if (r < I_IN) { transpose_unit(P.w_in, 1024, 3072, P.norm_pre, (bf16_t*)(P.ws + OFF_WIN), r, ldsf); continue; } r -= I_IN;
            if (r < I_GLU) { transpose_unit(P.w_glu, 512, 512, nullptr, (bf16_t*)(P.ws + OFF_WGLU), r, ldsf); continue; } r -= I_GLU;
            if (r < I_OUT) { transpose_unit(P.w_out, 1024, 1024, nullptr, (bf16_t*)(P.ws + OFF_WOUT), r, ldsf); continue; } r -= I_OUT;
            if (r < I_PLE) { transpose_unit(P.w_ple, 256, 1024, nullptr, (bf16_t*)(P.ws + OFF_WPLE), r, ldsf); continue; } r -= I_PLE;
            transpose_unit(P.w_pg, 1024, 1024, nullptr, (bf16_t*)(P.ws + OFF_WPG), r, ldsf); continue;
        }
        r -= U_T;
        if (r < U_X) {
            const int t = r * 8 + wid * 2; const f32x4* xr = (const f32x4*)(P.x + (size_t)t * 1024) + lane; f32x4 v[8]; float s0 = 0.f, s1 = 0.f;
#pragma unroll
            for (int j = 0; j < 8; ++j) v[j] = xr[64 * j];
#pragma unroll
            for (int j = 0; j < 4; ++j) { s0 += (v[j][0] * v[j][0] + v[j][1] * v[j][1]) + (v[j][2] * v[j][2] + v[j][3] * v[j][3]); s1 += (v[4 + j][0] * v[4 + j][0] + v[4 + j][1] * v[4 + j][1]) + (v[4 + j][2] * v[4 + j][2] + v[4 + j][3] * v[4 + j][3]); }
            const float rs0 = rsqrtf(wave_sum(s0) * (1.f / 1024.f) + EPS), rs1 = rsqrtf(wave_sum(s1) * (1.f / 1024.f) + EPS);
            bf16_t* o = (bf16_t*)(P.ws + OFF_XN) + (size_t)t * 1024 + lane * 4;
#pragma unroll
            for (int j = 0; j < 4; ++j) { store_bf4(o + 256 * j, v[j] * rs0); store_bf4(o + 1024 + 256 * j, v[4 + j] * rs1); }
            continue;
        }
        r -= U_X;
        {
            const size_t e0 = (size_t)r * 2048 + tid * 8; const f32x4 a = *(const f32x4*)(P.p + e0), b = *(const f32x4*)(P.p + e0 + 4);
            u32x4 w; w.x = pk2(a[0], a[1]); w.y = pk2(a[2], a[3]); w.z = pk2(b[0], b[1]); w.w = pk2(b[2], b[3]);
            *(u32x4*)((bf16_t*)(P.ws + OFF_PB) + e0) = w;
        }
    }
}

__device__ __forceinline__ void tq_unit(const Params& P, int u) {
    static_assert(LC == 64, "tq_unit / pm_unit thread maps assume 64-token chunks");
    const int g = u / LC, i = u % LC, tid = threadIdx.x;
    const float* ktab = (const float*)(P.ws + OFF_KTAB); const float2* lampow = (const float2*)(P.ws + OFF_LAM); bf16_t* tq = (bf16_t*)(P.ws + OFF_TQ);
    const int h2 = (tid & 7) * 2;
#pragma unroll
    for (int half = 0; half < 2; ++half) {
        const int j = (tid >> 3) + 32 * half;
        const int ma = i > j ? i - j : 0, mb = j > i ? j - i : 0;
        const float wa = i >= j ? 1.f : 0.f, wb = j >= i ? 1.f : 0.f;
        const float* kf = ktab + ((size_t)((0 * 32 + g) * 64 + ma)) * 256 + h2; const float* kb = ktab + ((size_t)((1 * 32 + g) * 64 + mb)) * 256 + h2;
        float2 a[16], b[16];
#pragma unroll
        for (int h = 0; h < 16; ++h) { a[h] = *(const float2*)(kf + h * 16); b[h] = *(const float2*)(kb + h * 16); }
#pragma unroll
        for (int h = 0; h < 16; ++h) {
            float v0 = wa * a[h].x + wb * b[h].x, v1 = wa * a[h].y + wb * b[h].y;
            if (i == j) { const float dd = P.ssm_d[g * 16 + h]; v0 += (h == h2 ? dd : 0.f); v1 += (h == h2 + 1 ? dd : 0.f); }
            *(unsigned*)(tq + ((size_t)(g * KU + i * 16 + h)) * KA + j * 16 + h2) = pk2(v0, v1);
        }
    }
    {
        const int pn = tid & 127, dir = pn >> 6, p = pn & 63, m = dir == 0 ? i + 1 : LC - i;
        const float2 l = lampow[((size_t)((dir * 32 + g) * 64 + p)) * 65 + m];
        float cr[8], ci[8];
#pragma unroll
        for (int it = 0; it < 8; ++it) { const int h = it * 2 + (tid >> 7); cr[it] = P.c_re[((dir * 32 + g) * 16 + h) * 64 + p]; ci[it] = P.c_im[((dir * 32 + g) * 16 + h) * 64 + p]; }
#pragma unroll
        for (int it = 0; it < 8; ++it) { const int h = it * 2 + (tid >> 7);
            *(unsigned*)(tq + ((size_t)(g * KU + i * 16 + h)) * KA + KU + dir * 128 + p * 2) = pk2(cr[it] * l.x - ci[it] * l.y, -(cr[it] * l.y + ci[it] * l.x)); }
    }
}
__device__ __forceinline__ void pm_unit(const Params& P, int u) {
    const int g = u >> 4, rg = u & 15, tid = threadIdx.x;
    const float2* lampow = (const float2*)(P.ws + OFF_LAM); const float2* bbar = (const float2*)(P.ws + OFF_BBAR); bf16_t* pm = (bf16_t*)(P.ws + OFF_PM);
    const int h2 = (tid & 7) * 2;
#pragma unroll 4
    for (int q = 0; q < 8; ++q) {
        const int pidx = rg * 8 + q, dir = pidx >> 6, p = pidx & 63;
        const f32x4 bq = *(const f32x4*)(bbar + ((size_t)((dir * 32 + g) * 64 + p)) * 16 + h2);
#pragma unroll
        for (int half = 0; half < 2; ++half) {
            const int j = (tid >> 3) + 32 * half, m = dir == 0 ? LC - 1 - j : j;
            const float2 l = lampow[((size_t)((dir * 32 + g) * 64 + p)) * 65 + m];
            bf16_t* dst = pm + ((size_t)(g * NS + 2 * pidx)) * KU + j * 16 + h2;
            *(unsigned*)dst = pk2(l.x * bq[0] - l.y * bq[1], l.x * bq[2] - l.y * bq[3]);
            *(unsigned*)(dst + KU) = pk2(l.x * bq[1] + l.y * bq[0], l.x * bq[3] + l.y * bq[2]);
        }
    }
}
__device__ __forceinline__ void phase1(const Params& P, int bid, int nb, unsigned char* lds) {
    constexpr int U_TQ = 32 * LC, U_PM = 32 * 16;
    const int xcd = bid & 7, rank = bid >> 3, R = nb >> 3;
    for (int l = rank; l < 768; l += R) {
        const int nt = (xcd & 1) * 12 + l % 12, mt = (xcd >> 1) * 64 + l / 12; EpiInProj epi{P.ws, mt * 128, nt * 128};
        gemm_tile((const bf16_t*)(P.ws + OFF_XN) + (size_t)mt * 128 * 1024, 1024, (const bf16_t*)(P.ws + OFF_WIN) + (size_t)nt * 128 * 1024, 1024, 1024, (bf16_t*)lds, epi);
    }
    for (int u = bid; u < U_TQ + U_PM; u += nb) {
        if (u < U_TQ) tq_unit(P, u);
        else pm_unit(P, u - U_TQ);
    }
}

__device__ __forceinline__ void na_unit(const Params& P, int u, float* ldsf) {
    const int tid = threadIdx.x, lane = tid & 63, cb = tid >> 6, fr = lane & 15, fq = lane >> 4;
    const int r = u & 127, head = (u >> 7) & 7, b = u >> 10;
    const bf16_t* q = (const bf16_t*)(P.ws + OFF_Q); const bf16_t* k = (const bf16_t*)(P.ws + OFF_K); const bf16_t* vt = (const bf16_t*)(P.ws + OFF_VT); const bf16_t* zn = (const bf16_t*)(P.ws + OFF_ZN);
    bf16_t* mixin = (bf16_t*)(P.ws + OFF_MIXIN);
    for (int i = tid; i < 15 * 31; i += 256) ldsf[i] = P.rpb[head * 15 * 31 + i];
    const int rs = min(max(r - 4, 0), 120);
    const int cw0 = cb == 0 ? 0 : (cb == 1 ? 8 : (cb == 2 ? 24 : 32));
    const int c = cb * 16 + fr, cs = min(max(c - 8, 0), 48);
    const size_t tq = (size_t)b * SEQ + r * 64 + c;
    const bf16x8 qf0 = *(const bf16x8*)(q + tq * 512 + head * 64 + fq * 8), qf1 = *(const bf16x8*)(q + tq * 512 + head * 64 + 32 + fq * 8);
    f32x4 s[16];
    const int kcol = cw0 + (fr >> 2) * 8 + (fr & 3);
    const bf16_t* kbase = k + ((size_t)b * SEQ + rs * 64 + kcol) * 512 + head * 64 + fq * 8;
#pragma unroll
    for (int hf = 0; hf < 2; ++hf) {
        bf16x8 k0[8], k1[8];
#pragma unroll
        for (int t = 0; t < 8; ++t) { const int tt = hf * 8 + t; const bf16_t* kp = kbase + ((size_t)(tt >> 1) * 64 + (tt & 1) * 4) * 512; k0[t] = *(const bf16x8*)kp; k1[t] = *(const bf16x8*)(kp + 32); }
#pragma unroll
        for (int t = 0; t < 8; ++t) {
            f32x4 z = (f32x4){0.f, 0.f, 0.f, 0.f};
            z = __builtin_amdgcn_mfma_f32_16x16x32_bf16(k0[t], qf0, z, 0, 0, 0);
            z = __builtin_amdgcn_mfma_f32_16x16x32_bf16(k1[t], qf1, z, 0, 0, 0);
            s[hf * 8 + t] = z;
        }
    }
    __syncthreads();
    float mx = -3.0e38f;
#pragma unroll
    for (int t = 0; t < 16; ++t) {
        const int i = t >> 1, odd = t & 1, dr = rs + i - r + 7;
#pragma unroll
        for (int e = 0; e < 4; ++e) {
            const int ck = cw0 + fq * 8 + odd * 4 + e; const bool valid = (ck >= cs) && (ck < cs + 16);
            const int dc = min(max(ck - c + 15, 0), 30);
            const float bv = ldsf[dr * 31 + dc];
            const float sv = valid ? s[t][e] + bv : -3.0e38f;
            s[t][e] = sv; mx = fmaxf(mx, sv);
        }
    }
    mx = fmaxf(mx, __shfl_xor(mx, 16)); mx = fmaxf(mx, __shfl_xor(mx, 32));
    float l = 0.f;
#pragma unroll
    for (int t = 0; t < 16; ++t)
#pragma unroll
        for (int e = 0; e < 4; ++e) { const float pv = __expf(s[t][e] - mx); s[t][e] = pv; l += pv; }
    l += __shfl_xor(l, 16); l += __shfl_xor(l, 32);
    f32x4 o[4];
#pragma unroll
    for (int dt = 0; dt < 4; ++dt) o[dt] = (f32x4){0.f, 0.f, 0.f, 0.f};
    const bf16_t* vbase = vt + ((size_t)(b * 512 + head * 64 + fr)) * SEQ + rs * 64 + cw0 + fq * 8;
#pragma unroll
    for (int k2 = 0; k2 < 4; ++k2) {
        bf16x8 vf[2][4];
#pragma unroll
        for (int kk = 0; kk < 2; ++kk)
#pragma unroll
            for (int dt = 0; dt < 4; ++dt) vf[kk][dt] = *(const bf16x8*)(vbase + (size_t)dt * 16 * SEQ + (k2 * 2 + kk) * 64);
#pragma unroll
        for (int kk = 0; kk < 2; ++kk) {
            const int kq = k2 * 2 + kk;
            u32x4 pw; pw.x = pk2(s[2 * kq][0], s[2 * kq][1]); pw.y = pk2(s[2 * kq][2], s[2 * kq][3]); pw.z = pk2(s[2 * kq + 1][0], s[2 * kq + 1][1]); pw.w = pk2(s[2 * kq + 1][2], s[2 * kq + 1][3]);
            const bf16x8 pf = __builtin_bit_cast(bf16x8, pw);
#pragma unroll
            for (int dt = 0; dt < 4; ++dt) o[dt] = __builtin_amdgcn_mfma_f32_16x16x32_bf16(vf[kk][dt], pf, o[dt], 0, 0, 0);
        }
    }
    const float inv = 1.f / l;
#pragma unroll
    for (int dt = 0; dt < 4; ++dt) {
        const int d0 = head * 64 + dt * 16 + fq * 4; const f32x4 z = load_bf4(zn + tq * 512 + d0); f32x4 ov;
#pragma unroll
        for (int e = 0; e < 4; ++e) ov[e] = o[dt][e] * inv * z[e] * sigmoidf_(z[e]);
        store_bf4(mixin + tq * 1024 + 512 + d0, ov);
    }
    __syncthreads();
}
__device__ __forceinline__ void phase2(const Params& P, int bid, int nb, unsigned char* lds) {
    constexpr int MT = NCH / 128;
    const int xcd = bid & 7, rank = bid >> 3, R = nb >> 3;
    for (int l = rank; l < 4 * MT * 2; l += R) {
        const int mt = l % MT, nt = (l / MT) & 1, g = xcd + 8 * (l / (MT * 2)); EpiS epi{(float*)(P.ws + OFF_S) + (size_t)g * NCH * NS, mt * 128, nt * 128};
        gemm_tile((const bf16_t*)(P.ws + OFF_UA) + ((size_t)g * NCH + mt * 128) * KA, KA, (const bf16_t*)(P.ws + OFF_PM) + ((size_t)g * NS + nt * 128) * KU, KU, KU, (bf16_t*)lds, epi);
    }
    for (int l = rank; l < 512; l += R) na_unit(P, xcd * 512 + l, (float*)lds);
}

__device__ __forceinline__ void phase3(const Params& P, int bid, int nb) {
    const float2* lampow = (const float2*)(P.ws + OFF_LAM); const float2* S = (const float2*)(P.ws + OFF_S); bf16_t* ua = (bf16_t*)(P.ws + OFF_UA);
    for (int sidx = bid * 256 + threadIdx.x; sidx < 4 * 2 * 32 * 64; sidx += nb * 256) {
        const int p = sidx & 63, g = (sidx >> 6) & 31, dir = (sidx >> 11) & 1, b = sidx >> 12;
        const float2 L = lampow[((size_t)((dir * 32 + g) * 64 + p)) * 65 + LC];
        float hr = 0.f, hi = 0.f;
        const float2* Sp = S + ((size_t)(g * NCH + b * CPB)) * (NS / 2) + dir * 64 + p;
        bf16_t* up = ua + ((size_t)(g * NCH + b * CPB)) * KA + KU + dir * 128 + p * 2;
        for (int cb0 = 0; cb0 < CPB; cb0 += 16) {
            float2 sv[16];
#pragma unroll
            for (int uu = 0; uu < 16; ++uu) { const int c = dir == 0 ? cb0 + uu : CPB - 1 - (cb0 + uu); sv[uu] = Sp[(size_t)c * (NS / 2)]; }
#pragma unroll
            for (int uu = 0; uu < 16; ++uu) {
                const int c = dir == 0 ? cb0 + uu : CPB - 1 - (cb0 + uu);
                *(unsigned*)(up + (size_t)c * KA) = pk2(hr, hi);
                const float tr = L.x * hr - L.y * hi + sv[uu].x; hi = L.x * hi + L.y * hr + sv[uu].y; hr = tr;
            }
        }
    }
}

__device__ __forceinline__ void phase4(const Params& P, int bid, int nb, unsigned char* lds) {
    constexpr int MT = NCH / 128, NT = KU / 128;
    const int xcd = bid & 7, rank = bid >> 3, R = nb >> 3;
    for (int l = rank; l < 4 * MT * NT; l += R) {
        const int mt = l % MT, nt = (l / MT) % NT, g = xcd + 8 * (l / (MT * NT)); EpiY epi{(bf16_t*)(P.ws + OFF_YS), g, mt * 128, nt * 128};
        gemm_tile((const bf16_t*)(P.ws + OFF_UA) + ((size_t)g * NCH + mt * 128) * KA, KA, (const bf16_t*)(P.ws + OFF_TQ) + ((size_t)g * KU + nt * 128) * KA, KA, KA, (bf16_t*)lds, epi);
    }
}
__device__ __forceinline__ void phase5(const Params& P, int bid, int nb, unsigned char* lds) {
    const int xcd = bid & 7, rank = bid >> 3, R = nb >> 3;
    for (int l = rank; l < 128; l += R) {
        const int nt = l & 3, mt = xcd * 32 + (l >> 2); EpiGlu epi{(const bf16_t*)(P.ws + OFF_YS), (const bf16_t*)(P.ws + OFF_ZS), P.b_glu, (bf16_t*)(P.ws + OFF_MIXIN), mt * 128, nt * 128};
        gemm_tile((const bf16_t*)(P.ws + OFF_YS) + (size_t)mt * 128 * 512, 512, (const bf16_t*)(P.ws + OFF_WGLU) + (size_t)nt * 128 * 512, 512, 512, (bf16_t*)lds, epi);
    }
}
__device__ __forceinline__ void phase6(const Params& P, int bid, int nb, unsigned char* lds) {
    const int xcd = bid & 7, rank = bid >> 3, R = nb >> 3;
    for (int l = rank; l < 512; l += R) {
        const int v = l & 255, nt = v & 7, mt = xcd * 32 + (v >> 3);
        if (l < 256) {
            EpiStoreSS epi{(bf16_t*)(P.ws + OFF_MIX), (float*)(P.ws + OFF_SS), mt * 128, nt * 128};
            gemm_tile((const bf16_t*)(P.ws + OFF_MIXIN) + (size_t)mt * 128 * 1024, 1024, (const bf16_t*)(P.ws + OFF_WOUT) + (size_t)nt * 128 * 1024, 1024, 1024, (bf16_t*)lds, epi);
        } else {
            EpiStoreSS epi{(bf16_t*)(P.ws + OFF_ERAW), (float*)(P.ws + OFF_ESS), mt * 128, nt * 128};
            gemm_tile((const bf16_t*)(P.ws + OFF_PB) + (size_t)mt * 128 * 256, 256, (const bf16_t*)(P.ws + OFF_WPLE) + (size_t)nt * 128 * 256, 256, 256, (bf16_t*)lds, epi);
        }
    }
}
__device__ __forceinline__ void phase7(const Params& P, int bid, int nb) {
    const int tid = threadIdx.x, lane = tid & 63, wid = tid >> 6;
    const float* ss = (const float*)(P.ws + OFF_SS); const float* ess = (const float*)(P.ws + OFF_ESS); float* rstd = (float*)(P.ws + OFF_RSTD);
    const bf16_t* mix = (const bf16_t*)(P.ws + OFF_MIX); bf16_t* hb = (bf16_t*)(P.ws + OFF_HB);
    for (int u = bid; u < T / 8; u += nb) {
        const int t = u * 8 + wid * 2;
        const int tl = t + (lane >> 5), l5 = lane & 31;
        f32x4 xv[8], mv[8];
#pragma unroll
        for (int j = 0; j < 8; ++j) { const size_t off = (size_t)(t + (j >> 2)) * 1024 + lane * 4 + 256 * (j & 3); xv[j] = *(const f32x4*)(P.x + off); mv[j] = load_bf4(mix + off); }
        float v = l5 < 16 ? ss[(size_t)tl * 16 + l5] : ess[(size_t)tl * 16 + l5 - 16];
        v += __shfl_xor(v, 1); v += __shfl_xor(v, 2); v += __shfl_xor(v, 4); v += __shfl_xor(v, 8);
        const float rp0 = rsqrtf(__shfl(v, 0) * (1.f / 1024.f) + EPS), re0 = rsqrtf(__shfl(v, 16) * (1.f / 1024.f) + EPS);
        const float rp1 = rsqrtf(__shfl(v, 32) * (1.f / 1024.f) + EPS), re1 = rsqrtf(__shfl(v, 48) * (1.f / 1024.f) + EPS);
        if (lane == 0) { rstd[t] = rp0; rstd[T + t] = re0; rstd[t + 1] = rp1; rstd[T + t + 1] = re1; }
#pragma unroll
        for (int j = 0; j < 8; ++j) {
            const int n = lane * 4 + 256 * (j & 3); const size_t off = (size_t)(t + (j >> 2)) * 1024 + n; const float rp = (j >> 2) ? rp1 : rp0;
            const f32x4 gp = *(const f32x4*)(P.norm_post + n); f32x4 h;
#pragma unroll
            for (int e = 0; e < 4; ++e) h[e] = xv[j][e] + mv[j][e] * rp * gp[e];
            store_bf4(hb + off, h);
        }
    }
}
__device__ __forceinline__ void phase8(const Params& P, int bid, int nb, unsigned char* lds) {
    const int xcd = bid & 7, rank = bid >> 3, R = nb >> 3;
    for (int l = rank; l < 256; l += R) {
        const int nt = l & 7, mt = xcd * 32 + (l >> 3);
        EpiFinal epi{(const bf16_t*)(P.ws + OFF_HB), (const bf16_t*)(P.ws + OFF_ERAW), (const float*)(P.ws + OFF_RSTD), P.ple_norm, P.out, mt * 128, nt * 128};
        gemm_tile((const bf16_t*)(P.ws + OFF_HB) + (size_t)mt * 128 * 1024, 1024, (const bf16_t*)(P.ws + OFF_WPG) + (size_t)nt * 128 * 1024, 1024, 1024, (bf16_t*)lds, epi);
    }
}

#ifndef XMODE
#define XMODE -1
#endif
struct EpiDummy { float* out;
    __device__ __forceinline__ void operator()(f32x4 (&acc)[4][4], int r0, int c0) const {
        float s = 0.f;
#pragma unroll
        for (int mi = 0; mi < 4; ++mi)
#pragma unroll
            for (int ni = 0; ni < 4; ++ni) s += acc[mi][ni][0] + acc[mi][ni][1] + acc[mi][ni][2] + acc[mi][ni][3];
        if (s == 123456.789f) out[r0 + c0] = s;
    }
};
template <int MODE>
__device__ __forceinline__ void phaseX(const Params& P, int bid, int nb, unsigned char* lds) {
    const int xcd = bid & 7, rank = bid >> 3, R = nb >> 3;
    for (int l = rank; l < 256; l += R) {
        const int nt = l & 7, mt = xcd * 32 + (l >> 3); EpiDummy epi{(float*)(P.ws + OFF_S)};
        gemm_tile<EpiDummy, MODE>((const bf16_t*)(P.ws + OFF_HB) + (size_t)mt * 128 * 1024, 1024, (const bf16_t*)(P.ws + OFF_WPG) + (size_t)nt * 128 * 1024, 1024, 1024, (bf16_t*)lds, epi);
    }
}

#define XB_TMO      128
#define XB_XCNT(j)  (256  + 64 * (j))
#define XB_XSUB(j)  (1280 + 64 * (j))
#define XB_XGEN(j)  (2304 + 64 * (j))
#define XB_TOP      3328
#define XB_TOPGEN   3392
#define XCD_BAR_WORDS 3456
#define XB_SPIN_CAP (1u << 20)
#define LAS __attribute__((address_space(3)))
__device__ __forceinline__ unsigned xb_ld(unsigned* p)              { return __hip_atomic_load(p, __ATOMIC_RELAXED, __HIP_MEMORY_SCOPE_AGENT); }
__device__ __forceinline__ unsigned xb_add(unsigned* p, unsigned v) { return __hip_atomic_fetch_add(p, v, __ATOMIC_RELAXED, __HIP_MEMORY_SCOPE_AGENT); }
__device__ __forceinline__ unsigned xb_xcc_id() { return (unsigned)__builtin_amdgcn_s_getreg((3 << 11) | 20) & 0xFu; }
#define XB_SPIN(cond, bar) do { unsigned _sp = 0; while (cond) { __builtin_amdgcn_s_sleep(1); \
    if ((++_sp & 255u) == 0u) { if (xb_ld(&(bar)[XB_TMO])) break; if (_sp > XB_SPIN_CAP) { atomicAdd(&(bar)[XB_TMO], 1u); break; } } } } while (0)
struct XcdBarrier { unsigned* bar; unsigned x; volatile LAS unsigned* st; };
__device__ __forceinline__ XcdBarrier xcd_barrier_post(unsigned* bar, volatile LAS unsigned* st) {
    XcdBarrier b; b.bar = bar; b.x = xb_xcc_id(); b.st = st;
    if (threadIdx.x == 0) (void)xb_add(&bar[XB_XCNT(b.x)], 1u);
    return b;
}
__device__ __forceinline__ void xcd_barrier_complete(unsigned* bar, unsigned x, unsigned& nloc, unsigned& nx) {
    const unsigned G = gridDim.x * gridDim.y * gridDim.z;
    unsigned sum, cnt, mine, sp = 0u;
    for (;;) {
        sum = 0u; cnt = 0u; mine = 0u;
#pragma unroll
        for (unsigned j = 0; j < 16; ++j) { const unsigned c = xb_ld(&bar[XB_XCNT(j)]); sum += c; cnt += (c > 0u) ? 1u : 0u; mine = (j == x) ? c : mine; }
        if (sum == G) break;
        __builtin_amdgcn_s_sleep(1);
        if ((++sp & 255u) == 0u) { if (xb_ld(&bar[XB_TMO])) break; if (sp > XB_SPIN_CAP) { atomicAdd(&bar[XB_TMO], 1u); break; } }
    }
    nloc = mine > 0u ? mine : 1u; nx = cnt > 0u ? cnt : 1u;
}
__device__ __forceinline__ void xcd_barrier(const XcdBarrier& b) {
    asm volatile("s_waitcnt vmcnt(0)" ::: "memory");
    __syncthreads();
    if (threadIdx.x == 0) {
        unsigned* bar = b.bar;
        __builtin_amdgcn_s_waitcnt(0);
        unsigned nloc = b.st[0], nx = b.st[1];
        if (nloc == 0u) { xcd_barrier_complete(bar, b.x, nloc, nx); b.st[0] = nloc; b.st[1] = nx; }
        const unsigned old = xb_add(&bar[XB_XSUB(b.x)], 1u);
        const unsigned gen = old / nloc;
        if (old + 1u == (gen + 1u) * nloc) {
            __builtin_amdgcn_fence(__ATOMIC_RELEASE, "agent");
            asm volatile("s_waitcnt vmcnt(0)" ::: "memory");
            const unsigned og = xb_add(&bar[XB_TOP], 1u);
            const unsigned tg = og / nx;
            if (og + 1u == (tg + 1u) * nx) xb_add(&bar[XB_TOPGEN], 1u);
            else XB_SPIN(xb_ld(&bar[XB_TOPGEN]) == tg, bar);
            __builtin_amdgcn_fence(__ATOMIC_ACQUIRE, "agent");
            xb_add(&bar[XB_XGEN(b.x)], 1u);
            asm volatile("s_waitcnt vmcnt(0)" ::: "memory");
        } else {
            XB_SPIN(xb_ld(&bar[XB_XGEN(b.x)]) == gen, bar);
            __builtin_amdgcn_fence(__ATOMIC_ACQUIRE, "agent");
            asm volatile("s_waitcnt vmcnt(0)" ::: "memory");
        }
    }
    __syncthreads();
}

extern __shared__ __attribute__((aligned(16))) unsigned char dyn_lds[];

#if MK_MULTI
__global__ void __launch_bounds__(256, 2) k_phase(Params P, int ph) {
    const int bid = blockIdx.x, nb = gridDim.x;
    switch (ph) {
        case 0: phase0(P, bid, nb, dyn_lds); break;
        case 1: phase1(P, bid, nb, dyn_lds); break;
        case 2: phase2(P, bid, nb, dyn_lds); break;
        case 3: phase3(P, bid, nb); break;
        case 4: phase4(P, bid, nb, dyn_lds); break;
        case 5: phase5(P, bid, nb, dyn_lds); break;
        case 6: phase6(P, bid, nb, dyn_lds); break;
        case 7: phase7(P, bid, nb); break;
        default: phase8(P, bid, nb, dyn_lds); break;
    }
}
#else
__global__ void __launch_bounds__(256, 2) k_mega(Params P) {
    __shared__ uint4 xb_words;
    if (threadIdx.x == 0) xb_words = make_uint4(0u, 0u, 0u, 0u);
    __syncthreads();
    const XcdBarrier xb = xcd_barrier_post((unsigned*)(P.ws + OFF_BAR), (volatile LAS unsigned*)&xb_words);
    const int bid = blockIdx.x, nb = gridDim.x;
#ifndef REP
#define REP -1
#endif
#define PH(n, call) do { call; xcd_barrier(xb); if (REP == n) { call; xcd_barrier(xb); } } while (0)
    PH(0, phase0(P, bid, nb, dyn_lds));
    PH(1, phase1(P, bid, nb, dyn_lds));
    PH(2, phase2(P, bid, nb, dyn_lds));
    PH(3, phase3(P, bid, nb));
    PH(4, phase4(P, bid, nb, dyn_lds));
    PH(5, phase5(P, bid, nb, dyn_lds));
    PH(6, phase6(P, bid, nb, dyn_lds));
    PH(7, phase7(P, bid, nb));
    phase8(P, bid, nb, dyn_lds);
    if (REP == 8) { xcd_barrier(xb); phase8(P, bid, nb, dyn_lds); }
#if XMODE >= 0
    xcd_barrier(xb); phaseX<XMODE>(P, bid, nb, dyn_lds);
#endif
}
#endif

extern "C" void kernel_launch(void* const* d_in, const int* in_sizes, int n_in, void* d_out, int out_size, void* d_ws, size_t ws_size, hipStream_t stream) {
    static int grid = 0;
    if (grid == 0) {
        if (n_in != 20 || ws_size < WS_END) { fprintf(stderr, "kernel_launch: unexpected n_in %d or ws_size %zu (< %zu)\n", n_in, ws_size, (size_t)WS_END); grid = -1; return; }
        int dev = 0, cus = 0, per_cu = 0;
        hipGetDevice(&dev); hipDeviceGetAttribute(&cus, hipDeviceAttributeMultiprocessorCount, dev);
#if MK_MULTI
        hipFuncSetAttribute((const void*)k_phase, hipFuncAttributeMaxDynamicSharedMemorySize, LDS_BYTES);
        hipOccupancyMaxActiveBlocksPerMultiprocessor(&per_cu, (const void*)k_phase, 256, LDS_BYTES);
#else
        hipFuncSetAttribute((const void*)k_mega, hipFuncAttributeMaxDynamicSharedMemorySize, LDS_BYTES);
        hipOccupancyMaxActiveBlocksPerMultiprocessor(&per_cu, (const void*)k_mega, 256, LDS_BYTES);
#endif
        if (per_cu < 1) per_cu = 1;
        if (per_cu > 2) per_cu = 2;
        grid = (cus * per_cu) & ~7;
        (void)hipGetLastError();
    }
    if (grid < 0) return;
    Params P{};
    const float** pp = (const float**)&P;
    for (int i = 0; i < 20; ++i) pp[i] = (const float*)d_in[i];
    P.out = (float*)d_out; P.ws = (unsigned char*)d_ws;
#if MK_MULTI
    for (int ph = 0; ph < 9; ++ph) hipLaunchKernelGGL(k_phase, dim3(grid), dim3(256), LDS_BYTES, stream, P, ph);
#else
    (void)hipMemsetAsync((unsigned char*)d_ws + OFF_BAR, 0, XCD_BAR_WORDS * 4, stream);
    void* args[] = {&P};
    hipError_t e = hipLaunchCooperativeKernel((const void*)k_mega, dim3(grid), dim3(256), args, LDS_BYTES, stream);
    if (e != hipSuccess) fprintf(stderr, "cooperative launch failed: %s (grid %d)\n", hipGetErrorString(e), grid);
#endif
}
```

```cpp
#include <hip/hip_runtime.h>
#include <hip/hip_cooperative_groups.h>
#include <stdint.h>
#include <stdio.h>
namespace cg = cooperative_groups;

#ifndef MK_MULTI
#define MK_MULTI 0
#endif

typedef unsigned short bf16_t;
typedef short bf16x8 __attribute__((ext_vector_type(8)));
typedef float f32x4 __attribute__((ext_vector_type(4)));
typedef unsigned u32x4 __attribute__((ext_vector_type(4)));
typedef unsigned u32x2 __attribute__((ext_vector_type(2)));

constexpr int T = 32768, DM = 1024, SEQ = 8192, DPLE = 256, DIN = 3072;
constexpr int LC = 64;
constexpr int NCH = T / LC;
constexpr int CPB = SEQ / LC;
constexpr int KU = LC * 16;
constexpr int NS = 256;
constexpr int KA = KU + NS;
constexpr float EPS = 1e-6f;

constexpr size_t MB = 1ull << 20;
constexpr size_t OFF_XN = 0;
constexpr size_t OFF_MIXIN = OFF_XN;
constexpr size_t OFF_PB = OFF_XN + 64 * MB;
constexpr size_t OFF_WIN = OFF_PB + 16 * MB;
constexpr size_t OFF_WGLU = OFF_WIN + 6 * MB;
constexpr size_t OFF_WOUT = OFF_WGLU + 1 * MB;
constexpr size_t OFF_WPLE = OFF_WOUT + 2 * MB;
constexpr size_t OFF_WPG = OFF_WPLE + 1 * MB;
constexpr size_t OFF_UA = OFF_WPG + 2 * MB;
constexpr size_t OFF_ZS = OFF_UA + 40 * MB;
constexpr size_t OFF_Q = OFF_ZS + 32 * MB;
constexpr size_t OFF_K = OFF_Q + 32 * MB;
constexpr size_t OFF_VT = OFF_K + 32 * MB;
constexpr size_t OFF_ZN = OFF_VT + 32 * MB;
constexpr size_t OFF_MIX = OFF_Q;
constexpr size_t OFF_HB = OFF_VT;
constexpr size_t OFF_LAM = OFF_ZN + 32 * MB;
constexpr size_t OFF_BBAR = OFF_LAM + 3 * MB;
constexpr size_t OFF_KTAB = OFF_BBAR + 1 * MB;
constexpr size_t OFF_TQ = OFF_KTAB + 4 * MB;
constexpr size_t OFF_ERAW = OFF_TQ;
constexpr size_t OFF_PM = OFF_TQ + 80 * MB;
constexpr size_t OFF_S = OFF_PM + 16 * MB;
constexpr size_t OFF_YS = OFF_S + 16 * MB;
constexpr size_t OFF_SS = OFF_YS + 32 * MB;
constexpr size_t OFF_ESS = OFF_SS + 2 * MB;
constexpr size_t OFF_RSTD = OFF_ESS + 2 * MB;
constexpr size_t OFF_BAR = OFF_RSTD + 1 * MB;
constexpr size_t WS_END = OFF_BAR + 1 * MB;

#define TID ((int)(threadIdx.x & 255))
struct Params {
    const float *x, *p, *norm_pre, *norm_post, *w_in, *a_re, *a_im, *log_dt, *b_re, *b_im, *c_re, *c_im, *ssm_d, *w_glu, *b_glu, *rpb, *w_out, *w_ple, *ple_norm, *w_pg;
    float* out;
    unsigned char* ws;
};

__device__ __forceinline__ unsigned pk2(float lo, float hi) { unsigned r; asm("v_cvt_pk_bf16_f32 %0, %1, %2" : "=v"(r) : "v"(lo), "v"(hi)); return r; }
__device__ __forceinline__ float bflo(unsigned w) { return __uint_as_float(w << 16); }
__device__ __forceinline__ float bfhi(unsigned w) { return __uint_as_float(w & 0xffff0000u); }
__device__ __forceinline__ void store_bf4(bf16_t* p, f32x4 v) { u32x2 w; w.x = pk2(v[0], v[1]); w.y = pk2(v[2], v[3]); *(u32x2*)p = w; }
__device__ __forceinline__ f32x4 load_bf4(const bf16_t* p) { u32x2 w = *(const u32x2*)p; f32x4 v; v[0] = bflo(w.x); v[1] = bfhi(w.x); v[2] = bflo(w.y); v[3] = bfhi(w.y); return v; }
__device__ __forceinline__ float sigmoidf_(float v) { return 1.f / (1.f + __expf(-v)); }
__device__ __forceinline__ float gelu_tanh(float v) { const float u = 0.7978845608028654f * (v + 0.044715f * v * v * v); const float th = 1.f - 2.f / (__expf(2.f * u) + 1.f); return 0.5f * v * (1.f + th); }

constexpr int LDS_BYTES = 131072;
namespace pg8 {
#define PG8_LAS __attribute__((address_space(3)))
constexpr int BM = 256, BK = 64, HALF = 128, HTB = HALF * BK * 2  , STAGE_BYTES = 8 * HTB;
__host__ __device__ __forceinline__ int lds_byte(int r, int c) { const int st = (r >> 4) * 2 + (c >> 5), rr = r & 15, cc = c & 31, ob = rr * 64 + cc * 2; return st * 1024 + (ob ^ (((ob >> 9) & 1) << 5)); }
__host__ __device__ __forceinline__ void stage_rc(int b, int& R, int& C) { const int st = b / 1024, sb = b % 1024, swz = sb ^ (((sb >> 9) & 1) << 5); R = (st >> 1) * 16 + swz / 64; C = (st & 1) * 32 + (swz % 64) / 2; }
__host__ __device__ __forceinline__ int perm32(int rho) { const int n = rho >> 4, i = rho & 15; return 8 * (i >> 2) + 4 * n + (i & 3); }
struct Unit { int pm, pn; };
struct Gemm { const bf16_t* A; const bf16_t* Bt; int lda, K; };
struct Order {
    int rank, R, n_x, nn, n0, m0;
    __device__ __forceinline__ bool next(int i, Unit& u) const { const int l = rank + R * i; if (l >= n_x) return false; u.pn = n0 + l % nn; u.pm = m0 + l / nn; return true; }
    __device__ __forceinline__ void a_ready(const Unit&) const {}
    __device__ __forceinline__ void done(const Unit&) const {}
};
template <class Epi, class Sched, bool ALIGN_EPI = false, bool SP2 = false>
__device__ __forceinline__ void gemm_phase(PG8_LAS unsigned char* lds, const Gemm g, const Sched& S, const Epi& E) {
    const int tid = threadIdx.x, wid = __builtin_amdgcn_readfirstlane(tid >> 6), lane = tid & 63, wr = wid >> 2, wc = wid & 3, fr = lane & 15, fq = lane >> 4;
    const int K = g.K, nt = K / BK;
    unsigned voffA[2], voffB[2];
#pragma unroll
    for (int i = 0; i < 2; ++i) { int R, C; stage_rc(tid * 16 + i * 8192, R, C); const int Rb = Epi::PERM ? ((R & ~31) + perm32(R & 31)) : R;
        voffA[i] = (unsigned)(R * g.lda + C) * 2u; voffB[i] = (unsigned)(Rb * K + C) * 2u; }
    const size_t kstep = (size_t)(BK * 2);
    const size_t hstep = (size_t)HALF * K * 2, hstepA = (size_t)HALF * g.lda * 2;
    const size_t tstep = 2 * hstep, tstepA = 2 * hstepA;
    const unsigned ldsw = (unsigned)wid * 1024u;
    const int aoff = lds_byte(wr * 64 + fr, fq * 8), boff = lds_byte(wc * 32 + fr, fq * 8);
#define PG8_SA(b, h) (((b) * 2 + (h)) * HTB)
#define PG8_SB(b, h) ((4 + (b) * 2 + (h)) * HTB)
#define PG8_STAGE(bufoff, gbase, voff) do { _Pragma("unroll") for (int _i = 0; _i < 2; ++_i) \
        __builtin_amdgcn_global_load_lds((const unsigned*)((const char*)(gbase) + (voff)[_i]), (PG8_LAS unsigned*)(lds + (bufoff) + ldsw + _i * 8192), 16, 0, 0); } while (0)
#define PG8_LDA(dst, b, h) do { _Pragma("unroll") for (int m = 0; m < 4; ++m) _Pragma("unroll") for (int k = 0; k < 2; ++k) dst[m][k] = *(const PG8_LAS bf16x8*)(lds + PG8_SA(b, h) + aoff + m * 2048 + k * 1024); } while (0)
#define PG8_LDB(dst, b, h) do { _Pragma("unroll") for (int n = 0; n < 2; ++n) _Pragma("unroll") for (int k = 0; k < 2; ++k) dst[n][k] = *(const PG8_LAS bf16x8*)(lds + PG8_SB(b, h) + boff + n * 2048 + k * 1024); } while (0)
#define PG8_MMA(ai, bj, At, Bt) do { __builtin_amdgcn_s_setprio(1); _Pragma("unroll") for (int m = 0; m < 4; ++m) _Pragma("unroll") for (int n = 0; n < 2; ++n) _Pragma("unroll") for (int k = 0; k < 2; ++k) \
        acc[ai][bj][m][n] = __builtin_amdgcn_mfma_f32_16x16x32_bf16(Bt[n][k], At[m][k], acc[ai][bj][m][n], 0, 0, 0); __builtin_amdgcn_s_setprio(0); } while (0)
#define PG8_WAIT_V(n) asm volatile("s_waitcnt vmcnt(" #n ")" ::: "memory")
#define PG8_WAIT_L(n) asm volatile("s_waitcnt lgkmcnt(" #n ")" ::: "memory")
#define PG8_BAR __builtin_amdgcn_s_barrier()
#define PG8_SCHED __builtin_amdgcn_sched_barrier(0)
    Unit cur, nxt; int ui = 0;
    if (!S.next(0, cur)) return;
    f32x4 acc[2][2][4][2];
#pragma unroll
    for (int a = 0; a < 2; ++a)
#pragma unroll
        for (int b = 0; b < 2; ++b)
#pragma unroll
            for (int m = 0; m < 4; ++m)
#pragma unroll
                for (int n = 0; n < 2; ++n) acc[a][b][m][n] = (f32x4){0.f, 0.f, 0.f, 0.f};
    bf16x8 At[4][2], B0[2][2], B1[2][2];
    const char* cA = (const char*)g.A + (size_t)cur.pm * tstepA; const char* cB = (const char*)g.Bt + (size_t)cur.pn * tstep;
    S.a_ready(cur);
    if constexpr (SP2) {
        PG8_STAGE(PG8_SB(0, 0), cB, voffB); PG8_STAGE(PG8_SB(0, 1), cB + hstep, voffB); PG8_STAGE(PG8_SA(0, 0), cA, voffA); PG8_STAGE(PG8_SA(0, 1), cA + hstepA, voffA);
        if (wr == 1) PG8_BAR;
        PG8_WAIT_V(2); PG8_BAR;
        PG8_STAGE(PG8_SB(1, 0), cB + kstep, voffB); PG8_STAGE(PG8_SA(1, 0), cA + kstep, voffA); PG8_STAGE(PG8_SB(1, 1), cB + hstep + kstep, voffB);
        PG8_WAIT_V(6); PG8_BAR;
    } else {
        PG8_STAGE(PG8_SB(0, 0), cB, voffB); PG8_STAGE(PG8_SA(0, 0), cA, voffA); PG8_STAGE(PG8_SB(0, 1), cB + hstep, voffB); PG8_STAGE(PG8_SA(0, 1), cA + hstepA, voffA);
        if (wr == 1) PG8_BAR;
        PG8_WAIT_V(4); PG8_BAR;
        PG8_STAGE(PG8_SB(1, 0), cB + kstep, voffB); PG8_STAGE(PG8_SA(1, 0), cA + kstep, voffA); PG8_STAGE(PG8_SB(1, 1), cB + hstep + kstep, voffB);
        PG8_WAIT_V(6); PG8_BAR;
    }
    for (;;) {
        const bool has_next = S.next(ui + 1, nxt);
        const char* nA = has_next ? (const char*)g.A + (size_t)nxt.pm * tstepA : cA; const char* nB = has_next ? (const char*)g.Bt + (size_t)nxt.pn * tstep : cB;
        for (int t = 0; t < nt; t += 2) {
            const bool last = (t == nt - 2);
            const char* a1 = cA + (size_t)(t + 1) * kstep;
            const char* a2 = last ? nA : cA + (size_t)(t + 2) * kstep; const char* b2 = last ? nB : cB + (size_t)(t + 2) * kstep;
            const char* a3 = a2 + kstep; const char* b3 = b2 + kstep;
            if (last && has_next) S.a_ready(nxt);
            if constexpr (SP2) {
            PG8_LDB(B0, 0, 0); PG8_LDB(B1, 0, 1); PG8_SCHED; PG8_LDA(At, 0, 0); PG8_STAGE(PG8_SA(1, 1), a1 + hstepA, voffA);
            PG8_WAIT_V(8); PG8_WAIT_L(0); PG8_BAR; PG8_MMA(0, 0, At, B0); PG8_MMA(0, 1, At, B1); PG8_BAR; PG8_SCHED;
            PG8_LDA(At, 0, 1); PG8_STAGE(PG8_SB(0, 0), b2, voffB); PG8_STAGE(PG8_SB(0, 1), b2 + hstep, voffB); PG8_STAGE(PG8_SA(0, 0), a2, voffA);
            PG8_WAIT_V(8); PG8_WAIT_L(0); PG8_BAR; PG8_MMA(1, 0, At, B0); PG8_MMA(1, 1, At, B1); PG8_BAR; PG8_SCHED;
            PG8_LDB(B0, 1, 0); PG8_LDB(B1, 1, 1); PG8_SCHED; PG8_LDA(At, 1, 0); PG8_STAGE(PG8_SA(0, 1), a2 + hstepA, voffA);
            PG8_WAIT_V(8); PG8_WAIT_L(0); PG8_BAR; PG8_MMA(0, 0, At, B0); PG8_MMA(0, 1, At, B1); PG8_BAR; PG8_SCHED;
            PG8_LDA(At, 1, 1); PG8_STAGE(PG8_SB(1, 0), b3, voffB); PG8_STAGE(PG8_SB(1, 1), b3 + hstep, voffB); PG8_STAGE(PG8_SA(1, 0), a3, voffA);
            PG8_WAIT_V(8); PG8_WAIT_L(0); PG8_BAR; PG8_MMA(1, 0, At, B0); PG8_MMA(1, 1, At, B1); PG8_BAR; PG8_SCHED;
            } else {
            PG8_LDB(B0, 0, 0); PG8_SCHED; PG8_LDA(At, 0, 0); PG8_STAGE(PG8_SA(1, 1), a1 + hstepA, voffA);
            PG8_WAIT_L(8); PG8_BAR; PG8_WAIT_L(0); PG8_MMA(0, 0, At, B0); PG8_BAR; PG8_SCHED;
            PG8_LDB(B1, 0, 1); PG8_STAGE(PG8_SB(0, 0), b2, voffB);
            PG8_BAR; PG8_WAIT_L(0); PG8_MMA(0, 1, At, B1); PG8_BAR;
            PG8_LDA(At, 0, 1); PG8_STAGE(PG8_SA(0, 0), a2, voffA);
            PG8_BAR; PG8_WAIT_L(0); PG8_MMA(1, 0, At, B0); PG8_BAR; PG8_SCHED;
            PG8_STAGE(PG8_SB(0, 1), b2 + hstep, voffB);
            PG8_WAIT_V(6); PG8_BAR; PG8_MMA(1, 1, At, B1); PG8_BAR;
            PG8_LDB(B0, 1, 0); PG8_SCHED; PG8_LDA(At, 1, 0); PG8_STAGE(PG8_SA(0, 1), a2 + hstepA, voffA);
            PG8_WAIT_L(8); PG8_BAR; PG8_WAIT_L(0); PG8_MMA(0, 0, At, B0); PG8_BAR; PG8_SCHED;
            PG8_LDB(B1, 1, 1); PG8_STAGE(PG8_SB(1, 0), b3, voffB);
            PG8_BAR; PG8_WAIT_L(0); PG8_MMA(0, 1, At, B1); PG8_BAR;
            PG8_LDA(At, 1, 1); PG8_STAGE(PG8_SA(1, 0), a3, voffA);
            PG8_BAR; PG8_WAIT_L(0); PG8_MMA(1, 0, At, B0); PG8_BAR; PG8_SCHED;
            PG8_STAGE(PG8_SB(1, 1), b3 + hstep, voffB);
            PG8_WAIT_V(6); PG8_BAR; PG8_MMA(1, 1, At, B1); PG8_BAR;
            }
        }
        if constexpr (ALIGN_EPI) { if (wr == 0) PG8_BAR; }
        if constexpr (!Epi::AFTER_DRAIN) { E(acc, cur, wr, wc, fr, fq); S.done(cur); }
        if (!has_next) break;
#pragma unroll
        for (int a = 0; a < 2; ++a)
#pragma unroll
            for (int b = 0; b < 2; ++b)
#pragma unroll
                for (int m = 0; m < 4; ++m)
#pragma unroll
                    for (int n = 0; n < 2; ++n) acc[a][b][m][n] = (f32x4){0.f, 0.f, 0.f, 0.f};
        cur = nxt; cA = nA; cB = nB; ++ui;
        if constexpr (ALIGN_EPI) { if (wr == 1) PG8_BAR; }
    }
    PG8_WAIT_V(0);
    if constexpr (!ALIGN_EPI) { if (wr == 0) PG8_BAR; }
    PG8_BAR;
    if constexpr (Epi::AFTER_DRAIN) { E.fused(acc, cur, wr, wc, fr, fq, lds, wid, lane); S.done(cur); }
#undef PG8_SA
#undef PG8_SB
#undef PG8_STAGE
#undef PG8_LDA
#undef PG8_LDB
#undef PG8_MMA
#undef PG8_WAIT_V
#undef PG8_WAIT_L
#undef PG8_BAR
#undef PG8_SCHED
}
}

#define EPI_ROWS(...) _Pragma("unroll") for (int ai = 0; ai < 2; ++ai) _Pragma("unroll") for (int m = 0; m < 4; ++m) { const int row = u.pm * 256 + ai * 128 + wr * 64 + m * 16 + fr; __VA_ARGS__ asm volatile("" ::: "memory"); }
#define EPI_COLS(...) _Pragma("unroll") for (int bj = 0; bj < 2; ++bj) _Pragma("unroll") for (int n = 0; n < 2; ++n) { const int col = u.pn * 256 + bj * 128 + wc * 32 + n * 16 + fq * 4; const f32x4 v = acc[ai][bj][m][n]; __VA_ARGS__ }
typedef f32x4 acc_t[2][2][4][2];
struct EpiInProj {
    static constexpr bool PERM = false, AFTER_DRAIN = false;
    unsigned char* ws;
    __device__ __forceinline__ void operator()(const acc_t& acc, const pg8::Unit& u, int wr, int wc, int fr, int fq) const {
        const int sec = (u.pn * 256) >> 9;
        EPI_ROWS( const int t = row; EPI_COLS( const int nn = col & 511;
            if (sec == 0) { const int g = nn >> 4, hh = nn & 15, ch = t / LC, j = t % LC; store_bf4((bf16_t*)(ws + OFF_UA) + ((size_t)(g * NCH + ch)) * KA + j * 16 + hh, v); }
            else if (sec == 1) store_bf4((bf16_t*)(ws + OFF_ZS) + (size_t)t * 512 + nn, v);
            else if (sec == 2) store_bf4((bf16_t*)(ws + OFF_Q) + (size_t)t * 512 + nn, v * 0.125f);
            else if (sec == 3) store_bf4((bf16_t*)(ws + OFF_K) + (size_t)t * 512 + nn, v);
            else if (sec == 4) { const int b = t >> 13, l = t & 8191; bf16_t* vt = (bf16_t*)(ws + OFF_VT) + ((size_t)(b * 512 + nn)) * SEQ + l; const unsigned w0 = pk2(v[0], v[1]), w1 = pk2(v[2], v[3]);
                vt[0] = (bf16_t)(w0 & 0xffff); vt[SEQ] = (bf16_t)(w0 >> 16); vt[2 * SEQ] = (bf16_t)(w1 & 0xffff); vt[3 * SEQ] = (bf16_t)(w1 >> 16); }
            else store_bf4((bf16_t*)(ws + OFF_ZN) + (size_t)t * 512 + nn, v); ) )
    }
};
struct EpiS {
    static constexpr bool PERM = false, AFTER_DRAIN = false;
    float* S;
    __device__ __forceinline__ void operator()(const acc_t& acc, const pg8::Unit& u, int wr, int wc, int fr, int fq) const {
        EPI_ROWS( EPI_COLS( *(f32x4*)(S + (size_t)row * NS + col) = v; ) )
    }
};
struct EpiY {
    static constexpr bool PERM = false, AFTER_DRAIN = false;
    bf16_t* ys; int g;
    __device__ __forceinline__ void operator()(const acc_t& acc, const pg8::Unit& u, int wr, int wc, int fr, int fq) const {
        EPI_ROWS( EPI_COLS( const int i = col >> 4, h = col & 15; f32x4 o;
            _Pragma("unroll") for (int e = 0; e < 4; ++e) o[e] = gelu_tanh(v[e]);
            store_bf4(ys + ((size_t)row * LC + i) * 512 + g * 16 + h, o); ) )
    }
};
struct EpiGlu {
    static constexpr bool PERM = false, AFTER_DRAIN = false;
    const bf16_t* ys; const bf16_t* zs; const float* bglu; bf16_t* mixin;
    __device__ __forceinline__ void operator()(const acc_t& acc, const pg8::Unit& u, int wr, int wc, int fr, int fq) const {
        EPI_ROWS( EPI_COLS( const f32x4 bv = *(const f32x4*)(bglu + col);
            const f32x4 y = load_bf4(ys + (size_t)row * 512 + col), z = load_bf4(zs + (size_t)row * 512 + col); f32x4 o;
            _Pragma("unroll") for (int e = 0; e < 4; ++e) o[e] = y[e] * sigmoidf_(v[e] + bv[e]) * z[e] * sigmoidf_(z[e]);
            store_bf4(mixin + (size_t)row * 1024 + col, o); ) )
    }
};
struct EpiStoreSS {
    static constexpr bool PERM = false, AFTER_DRAIN = false;
    bf16_t* dst; float* ss;
    __device__ __forceinline__ void operator()(const acc_t& acc, const pg8::Unit& u, int wr, int wc, int fr, int fq) const {
        EPI_ROWS( float s = 0.f;
            EPI_COLS( s += (v[0] * v[0] + v[1] * v[1]) + (v[2] * v[2] + v[3] * v[3]); store_bf4(dst + (size_t)row * 1024 + col, v); )
            s += __shfl_xor(s, 16); s += __shfl_xor(s, 32);
            if (fq == 0) ss[(size_t)row * 16 + u.pn * 4 + wc] = s; )
    }
};
struct EpiFinal {
    static constexpr bool PERM = false, AFTER_DRAIN = false;
    const bf16_t* hb; const bf16_t* eraw; const float* rstd; const float* gple; float* out;
    __device__ __forceinline__ void operator()(const acc_t& acc, const pg8::Unit& u, int wr, int wc, int fr, int fq) const {
        EPI_ROWS( const float re = rstd[T + row];
            EPI_COLS( const size_t off = (size_t)row * 1024 + col;
                const f32x4 ge = *(const f32x4*)(gple + col), hv = load_bf4(hb + off), ev = load_bf4(eraw + off); f32x4 o;
                _Pragma("unroll") for (int e = 0; e < 4; ++e) o[e] = hv[e] + sigmoidf_(v[e]) * (ev[e] * re * ge[e]);
                *(f32x4*)(out + off) = o; ) )
    }
};

__device__ __forceinline__ void ktab_unit(const Params& P, int u, float* ldsf) {
    const int dir = u >> 8, g = (u >> 3) & 31, mr = u & 7, tid = TID;
    float2* lp = (float2*)ldsf;
    float2* bb = lp + 64 * 65;
    float2* cc = bb + 64 * 16;
    float2* lampow = (float2*)(P.ws + OFF_LAM); float2* bbar = (float2*)(P.ws + OFF_BBAR); float* ktab = (float*)(P.ws + OFF_KTAB);
    if (tid < 64) {
        const int p = tid, idx = (dir * 32 + g) * 64 + p;
        const float ar = P.a_re[idx], ai = P.a_im[idx], dt = expf(P.log_dt[dir * 32 + g]);
        const float mag = expf(dt * ar), ang = dt * ai; const float lr = mag * cosf(ang), li = mag * sinf(ang);
        const float nr = lr - 1.f, ni = li, den = ar * ar + ai * ai;
        const float cr = (nr * ar + ni * ai) / den, ci = (ni * ar - nr * ai) / den;
        float brv[16], biv[16];
#pragma unroll
        for (int h = 0; h < 16; ++h) { brv[h] = P.b_re[idx * 16 + h]; biv[h] = P.b_im[idx * 16 + h]; }
        float pr = 1.f, pi = 0.f;
        for (int m = 0; m <= 64; ++m) { lp[p * 65 + m] = make_float2(pr, pi); if (mr == 0) lampow[(size_t)idx * 65 + m] = make_float2(pr, pi); const float tt = pr * lr - pi * li; pi = pr * li + pi * lr; pr = tt; }
#pragma unroll
        for (int h = 0; h < 16; ++h) { const float2 v = make_float2(cr * brv[h] - ci * biv[h], cr * biv[h] + ci * brv[h]); bb[p * 16 + h] = v; if (mr == 0) bbar[(size_t)idx * 16 + h] = v; }
    }
#pragma unroll
    for (int i = 0; i < 4; ++i) { const int e = tid + 256 * i; cc[(e >> 6) * 65 + (e & 63)] = make_float2(P.c_re[(dir * 32 + g) * 1024 + e], P.c_im[(dir * 32 + g) * 1024 + e]); }
    __syncthreads();
    const int h = tid >> 4, h2 = tid & 15;
    float s[8];
#pragma unroll
    for (int mm = 0; mm < 8; ++mm) s[mm] = 0.f;
    for (int p = 0; p < 64; ++p) {
        const float2 c = cc[h * 65 + p], b = bb[p * 16 + h2];
        const float cbx = c.x * b.x - c.y * b.y, cby = c.x * b.y + c.y * b.x;
#pragma unroll
        for (int mm = 0; mm < 8; ++mm) { const float2 l = lp[p * 65 + mr * 8 + mm]; s[mm] += cbx * l.x - cby * l.y; }
    }
#pragma unroll
    for (int mm = 0; mm < 8; ++mm) ktab[((size_t)((dir * 32 + g) * 64 + mr * 8 + mm)) * 256 + h * 16 + h2] = s[mm];
    __syncthreads();
}
__device__ __forceinline__ void transpose_unit(const float* W, int K, int N, const float* gain, bf16_t* Wt, int item, float* ldsf) {
    const int nblk = N / 64, kb = item / nblk, nbk = item % nblk, k0 = kb * 64, n0 = nbk * 64, tid = TID;
#pragma unroll 4
    for (int i = 0; i < 16; ++i) { const int kk = i * 4 + (tid >> 6), nn = tid & 63; float v = W[(size_t)(k0 + kk) * N + n0 + nn]; if (gain) v *= gain[k0 + kk]; ldsf[kk * 65 + nn] = v; }
    __syncthreads();
#pragma unroll 4
    for (int i = 0; i < 8; ++i) { const int nn = i * 8 + (tid >> 5), kk = (tid & 31) * 2; *(unsigned*)(Wt + (size_t)(n0 + nn) * K + k0 + kk) = pk2(ldsf[kk * 65 + nn], ldsf[(kk + 1) * 65 + nn]); }
    __syncthreads();
}
__device__ __forceinline__ float wave_sum(float v) {
#pragma unroll
    for (int o = 1; o < 64; o <<= 1) v += __shfl_xor(v, o);
    return v;
}
__device__ __forceinline__ void phase0(const Params& P, int bid, int nb, unsigned char* lds) {
    float* ldsf = (float*)(lds + (threadIdx.x >> 8) * 65536);
    const int vb = bid * 2 + (threadIdx.x >> 8), nvb = nb * 2;
    constexpr int U_K = 512, I_IN = 16 * 48, I_GLU = 64, I_OUT = 256, I_PLE = 4 * 16, I_PG = 256, U_T = I_IN + I_GLU + I_OUT + I_PLE + I_PG, U_X = T / 8, U_P = (T * DPLE) / 2048;
    constexpr int NU = U_K + U_T + U_X + U_P;
    const int tid = TID, lane = tid & 63, wid = tid >> 6;
    for (int u = vb; u < NU; u += nvb) {
        int r = u;
        if (r < U_K) { ktab_unit(P, r, ldsf); continue; } r -= U_K;
        if (r < U_T) {
            if (r < I_IN) { transpose_unit(P.w_in, 1024, 3072, P.norm_pre, (bf16_t*)(P.ws + OFF_WIN), r, ldsf); continue; } r -= I_IN;
            if (r < I_GLU) { transpose_unit(P.w_glu, 512, 512, nullptr, (bf16_t*)(P.ws + OFF_WGLU), r, ldsf); continue; } r -= I_GLU;
            if (r < I_OUT) { transpose_unit(P.w_out, 1024, 1024, nullptr, (bf16_t*)(P.ws + OFF_WOUT), r, ldsf); continue; } r -= I_OUT;
            if (r < I_PLE) { transpose_unit(P.w_ple, 256, 1024, nullptr, (bf16_t*)(P.ws + OFF_WPLE), r, ldsf); continue; } r -= I_PLE;
            transpose_unit(P.w_pg, 1024, 1024, nullptr, (bf16_t*)(P.ws + OFF_WPG), r, ldsf); continue;
        }
        r -= U_T;
        if (r < U_X) {
            const int t = r * 8 + wid * 2; const f32x4* xr = (const f32x4*)(P.x + (size_t)t * 1024) + lane; f32x4 v[8]; float s0 = 0.f, s1 = 0.f;
#pragma unroll
            for (int j = 0; j < 8; ++j) v[j] = xr[64 * j];
#pragma unroll
            for (int j = 0; j < 4; ++j) { s0 += (v[j][0] * v[j][0] + v[j][1] * v[j][1]) + (v[j][2] * v[j][2] + v[j][3] * v[j][3]); s1 += (v[4 + j][0] * v[4 + j][0] + v[4 + j][1] * v[4 + j][1]) + (v[4 + j][2] * v[4 + j][2] + v[4 + j][3] * v[4 + j][3]); }
            const float rs0 = rsqrtf(wave_sum(s0) * (1.f / 1024.f) + EPS), rs1 = rsqrtf(wave_sum(s1) * (1.f / 1024.f) + EPS);
            bf16_t* o = (bf16_t*)(P.ws + OFF_XN) + (size_t)t * 1024 + lane * 4;
#pragma unroll
            for (int j = 0; j < 4; ++j) { store_bf4(o + 256 * j, v[j] * rs0); store_bf4(o + 1024 + 256 * j, v[4 + j] * rs1); }
            continue;
        }
        r -= U_X;
        {
            const size_t e0 = (size_t)r * 2048 + tid * 8; const f32x4 a = *(const f32x4*)(P.p + e0), b = *(const f32x4*)(P.p + e0 + 4);
            u32x4 w; w.x = pk2(a[0], a[1]); w.y = pk2(a[2], a[3]); w.z = pk2(b[0], b[1]); w.w = pk2(b[2], b[3]);
            *(u32x4*)((bf16_t*)(P.ws + OFF_PB) + e0) = w;
        }
    }
}

__device__ __forceinline__ void tq_unit(const Params& P, int u) {
    static_assert(LC == 64, "tq_unit / pm_unit thread maps assume 64-token chunks");
    const int g = u / LC, i = u % LC, tid = TID;
    const float* ktab = (const float*)(P.ws + OFF_KTAB); const float2* lampow = (const float2*)(P.ws + OFF_LAM); bf16_t* tq = (bf16_t*)(P.ws + OFF_TQ);
    const int h2 = (tid & 7) * 2;
#pragma unroll
    for (int half = 0; half < 2; ++half) {
        const int j = (tid >> 3) + 32 * half;
        const int ma = i > j ? i - j : 0, mb = j > i ? j - i : 0;
        const float wa = i >= j ? 1.f : 0.f, wb = j >= i ? 1.f : 0.f;
        const float* kf = ktab + ((size_t)((0 * 32 + g) * 64 + ma)) * 256 + h2; const float* kb = ktab + ((size_t)((1 * 32 + g) * 64 + mb)) * 256 + h2;
        float2 a[16], b[16];
#pragma unroll
        for (int h = 0; h < 16; ++h) { a[h] = *(const float2*)(kf + h * 16); b[h] = *(const float2*)(kb + h * 16); }
#pragma unroll
        for (int h = 0; h < 16; ++h) {
            float v0 = wa * a[h].x + wb * b[h].x, v1 = wa * a[h].y + wb * b[h].y;
            if (i == j) { const float dd = P.ssm_d[g * 16 + h]; v0 += (h == h2 ? dd : 0.f); v1 += (h == h2 + 1 ? dd : 0.f); }
            *(unsigned*)(tq + ((size_t)(g * KU + i * 16 + h)) * KA + j * 16 + h2) = pk2(v0, v1);
        }
    }
    {
        const int pn = tid & 127, dir = pn >> 6, p = pn & 63, m = dir == 0 ? i + 1 : LC - i;
        const float2 l = lampow[((size_t)((dir * 32 + g) * 64 + p)) * 65 + m];
        float cr[8], ci[8];
#pragma unroll
        for (int it = 0; it < 8; ++it) { const int h = it * 2 + (tid >> 7); cr[it] = P.c_re[((dir * 32 + g) * 16 + h) * 64 + p]; ci[it] = P.c_im[((dir * 32 + g) * 16 + h) * 64 + p]; }
#pragma unroll
        for (int it = 0; it < 8; ++it) { const int h = it * 2 + (tid >> 7);
            *(unsigned*)(tq + ((size_t)(g * KU + i * 16 + h)) * KA + KU + dir * 128 + p * 2) = pk2(cr[it] * l.x - ci[it] * l.y, -(cr[it] * l.y + ci[it] * l.x)); }
    }
}
__device__ __forceinline__ void pm_unit(const Params& P, int u) {
    const int g = u >> 4, rg = u & 15, tid = TID;
    const float2* lampow = (const float2*)(P.ws + OFF_LAM); const float2* bbar = (const float2*)(P.ws + OFF_BBAR); bf16_t* pm = (bf16_t*)(P.ws + OFF_PM);
    const int h2 = (tid & 7) * 2;
#pragma unroll 4
    for (int q = 0; q < 8; ++q) {
        const int pidx = rg * 8 + q, dir = pidx >> 6, p = pidx & 63;
        const f32x4 bq = *(const f32x4*)(bbar + ((size_t)((dir * 32 + g) * 64 + p)) * 16 + h2);
#pragma unroll
        for (int half = 0; half < 2; ++half) {
            const int j = (tid >> 3) + 32 * half, m = dir == 0 ? LC - 1 - j : j;
            const float2 l = lampow[((size_t)((dir * 32 + g) * 64 + p)) * 65 + m];
            bf16_t* dst = pm + ((size_t)(g * NS + 2 * pidx)) * KU + j * 16 + h2;
            *(unsigned*)dst = pk2(l.x * bq[0] - l.y * bq[1], l.x * bq[2] - l.y * bq[3]);
            *(unsigned*)(dst + KU) = pk2(l.x * bq[1] + l.y * bq[0], l.x * bq[3] + l.y * bq[2]);
        }
    }
}
__device__ __forceinline__ void phase1(const Params& P, int bid, int nb, unsigned char* lds) {
    constexpr int U_TQ = 32 * LC, U_PM = 32 * 16;
    const int xcd = bid & 7, rank = bid >> 3, R = nb >> 3;
    {
        const pg8::Gemm g{(const bf16_t*)(P.ws + OFF_XN), (const bf16_t*)(P.ws + OFF_WIN), 1024, 1024};
        const pg8::Order S{rank, R, 192, 6, (xcd & 1) * 6, (xcd >> 1) * 32}; const EpiInProj E{P.ws};
        pg8::gemm_phase<EpiInProj, pg8::Order, true, true>((PG8_LAS unsigned char*)lds, g, S, E);
    }
    const int vb = bid * 2 + (threadIdx.x >> 8), nvb = nb * 2;
    for (int u = vb; u < U_TQ + U_PM; u += nvb) {
        if (u < U_TQ) tq_unit(P, u);
        else pm_unit(P, u - U_TQ);
    }
}

__device__ __forceinline__ void na_unit(const Params& P, int u, float* ldsf) {
    const int tid = TID, lane = tid & 63, cb = tid >> 6, fr = lane & 15, fq = lane >> 4;
    const int r = u & 127, head = (u >> 7) & 7, b = u >> 10;
    const bf16_t* q = (const bf16_t*)(P.ws + OFF_Q); const bf16_t* k = (const bf16_t*)(P.ws + OFF_K); const bf16_t* vt = (const bf16_t*)(P.ws + OFF_VT); const bf16_t* zn = (const bf16_t*)(P.ws + OFF_ZN);
    bf16_t* mixin = (bf16_t*)(P.ws + OFF_MIXIN);
    for (int i = tid; i < 15 * 31; i += 256) ldsf[i] = P.rpb[head * 15 * 31 + i];
    const int rs = min(max(r - 4, 0), 120);
    const int cw0 = cb == 0 ? 0 : (cb == 1 ? 8 : (cb == 2 ? 24 : 32));
    const int c = cb * 16 + fr, cs = min(max(c - 8, 0), 48);
    const size_t tq = (size_t)b * SEQ + r * 64 + c;
    const bf16x8 qf0 = *(const bf16x8*)(q + tq * 512 + head * 64 + fq * 8), qf1 = *(const bf16x8*)(q + tq * 512 + head * 64 + 32 + fq * 8);
    f32x4 s[16];
    const int kcol = cw0 + (fr >> 2) * 8 + (fr & 3);
    const bf16_t* kbase = k + ((size_t)b * SEQ + rs * 64 + kcol) * 512 + head * 64 + fq * 8;
#pragma unroll
    for (int hf = 0; hf < 2; ++hf) {
        bf16x8 k0[8], k1[8];
#pragma unroll
        for (int t = 0; t < 8; ++t) { const int tt = hf * 8 + t; const bf16_t* kp = kbase + ((size_t)(tt >> 1) * 64 + (tt & 1) * 4) * 512; k0[t] = *(const bf16x8*)kp; k1[t] = *(const bf16x8*)(kp + 32); }
#pragma unroll
        for (int t = 0; t < 8; ++t) {
            f32x4 z = (f32x4){0.f, 0.f, 0.f, 0.f};
            z = __builtin_amdgcn_mfma_f32_16x16x32_bf16(k0[t], qf0, z, 0, 0, 0);
            z = __builtin_amdgcn_mfma_f32_16x16x32_bf16(k1[t], qf1, z, 0, 0, 0);
            s[hf * 8 + t] = z;
        }
    }
    __syncthreads();
    float mx = -3.0e38f;
#pragma unroll
    for (int t = 0; t < 16; ++t) {
        const int i = t >> 1, odd = t & 1, dr = rs + i - r + 7;
#pragma unroll
        for (int e = 0; e < 4; ++e) {
            const int ck = cw0 + fq * 8 + odd * 4 + e; const bool valid = (ck >= cs) && (ck < cs + 16);
            const int dc = min(max(ck - c + 15, 0), 30);
            const float bv = ldsf[dr * 31 + dc];
            const float sv = valid ? s[t][e] + bv : -3.0e38f;
            s[t][e] = sv; mx = fmaxf(mx, sv);
        }
    }
    mx = fmaxf(mx, __shfl_xor(mx, 16)); mx = fmaxf(mx, __shfl_xor(mx, 32));
    float l = 0.f;
#pragma unroll
    for (int t = 0; t < 16; ++t)
#pragma unroll
        for (int e = 0; e < 4; ++e) { const float pv = __expf(s[t][e] - mx); s[t][e] = pv; l += pv; }
    l += __shfl_xor(l, 16); l += __shfl_xor(l, 32);
    f32x4 o[4];
#pragma unroll
    for (int dt = 0; dt < 4; ++dt) o[dt] = (f32x4){0.f, 0.f, 0.f, 0.f};
    const bf16_t* vbase = vt + ((size_t)(b * 512 + head * 64 + fr)) * SEQ + rs * 64 + cw0 + fq * 8;
#pragma unroll
    for (int k2 = 0; k2 < 4; ++k2) {
        bf16x8 vf[2][4];
#pragma unroll
        for (int kk = 0; kk < 2; ++kk)
#pragma unroll
            for (int dt = 0; dt < 4; ++dt) vf[kk][dt] = *(const bf16x8*)(vbase + (size_t)dt * 16 * SEQ + (k2 * 2 + kk) * 64);
#pragma unroll
        for (int kk = 0; kk < 2; ++kk) {
            const int kq = k2 * 2 + kk;
            u32x4 pw; pw.x = pk2(s[2 * kq][0], s[2 * kq][1]); pw.y = pk2(s[2 * kq][2], s[2 * kq][3]); pw.z = pk2(s[2 * kq + 1][0], s[2 * kq + 1][1]); pw.w = pk2(s[2 * kq + 1][2], s[2 * kq + 1][3]);
            const bf16x8 pf = __builtin_bit_cast(bf16x8, pw);
#pragma unroll
            for (int dt = 0; dt < 4; ++dt) o[dt] = __builtin_amdgcn_mfma_f32_16x16x32_bf16(vf[kk][dt], pf, o[dt], 0, 0, 0);
        }
    }
    const float inv = 1.f / l;
#pragma unroll
    for (int dt = 0; dt < 4; ++dt) {
        const int d0 = head * 64 + dt * 16 + fq * 4; const f32x4 z = load_bf4(zn + tq * 512 + d0); f32x4 ov;
#pragma unroll
        for (int e = 0; e < 4; ++e) ov[e] = o[dt][e] * inv * z[e] * sigmoidf_(z[e]);
        store_bf4(mixin + tq * 1024 + 512 + d0, ov);
    }
    __syncthreads();
}
__device__ __forceinline__ void phase2(const Params& P, int bid, int nb, unsigned char* lds) {
    const int xcd = bid & 7, rank = bid >> 3, R = nb >> 3;
    for (int l = rank; l < 8; l += R) {
        const int mt = l & 1, g = xcd + 8 * (l >> 1);
        const pg8::Gemm gm{(const bf16_t*)(P.ws + OFF_UA) + (size_t)g * NCH * KA, (const bf16_t*)(P.ws + OFF_PM) + (size_t)g * NS * KU, KA, KU};
        const pg8::Order S{0, 1, 1, 1, 0, mt}; const EpiS E{(float*)(P.ws + OFF_S) + (size_t)g * NCH * NS};
        pg8::gemm_phase<EpiS, pg8::Order, true, true>((PG8_LAS unsigned char*)lds, gm, S, E);
    }
    const int half = threadIdx.x >> 8, vrank = rank * 2 + half, VR = R * 2;
    for (int l = vrank; l < 512; l += VR) na_unit(P, xcd * 512 + l, (float*)(lds + half * 65536));
}

__device__ __forceinline__ void phase3(const Params& P, int bid, int nb) {
    const float2* lampow = (const float2*)(P.ws + OFF_LAM); const float2* S = (const float2*)(P.ws + OFF_S); bf16_t* ua = (bf16_t*)(P.ws + OFF_UA);
    const int vb = bid * 2 + (threadIdx.x >> 8), nvb = nb * 2;
    for (int sidx = vb * 256 + TID; sidx < 4 * 2 * 32 * 64; sidx += nvb * 256) {
        const int p = sidx & 63, g = (sidx >> 6) & 31, dir = (sidx >> 11) & 1, b = sidx >> 12;
        const float2 L = lampow[((size_t)((dir * 32 + g) * 64 + p)) * 65 + LC];
        float hr = 0.f, hi = 0.f;
        const float2* Sp = S + ((size_t)(g * NCH + b * CPB)) * (NS / 2) + dir * 64 + p;
        bf16_t* up = ua + ((size_t)(g * NCH + b * CPB)) * KA + KU + dir * 128 + p * 2;
        for (int cb0 = 0; cb0 < CPB; cb0 += 16) {
            float2 sv[16];
#pragma unroll
            for (int uu = 0; uu < 16; ++uu) { const int c = dir == 0 ? cb0 + uu : CPB - 1 - (cb0 + uu); sv[uu] = Sp[(size_t)c * (NS / 2)]; }
#pragma unroll
            for (int uu = 0; uu < 16; ++uu) {
                const int c = dir == 0 ? cb0 + uu : CPB - 1 - (cb0 + uu);
                *(unsigned*)(up + (size_t)c * KA) = pk2(hr, hi);
                const float tr = L.x * hr - L.y * hi + sv[uu].x; hi = L.x * hi + L.y * hr + sv[uu].y; hr = tr;
            }
        }
    }
}

__device__ __forceinline__ void phase4(const Params& P, int bid, int nb, unsigned char* lds) {
    const int xcd = bid & 7, rank = bid >> 3, R = nb >> 3;
    for (int l = rank; l < 32; l += R) {
        const int mt = l & 1, nt = (l >> 1) & 3, g = xcd + 8 * (l >> 3);
        const pg8::Gemm gm{(const bf16_t*)(P.ws + OFF_UA) + (size_t)g * NCH * KA, (const bf16_t*)(P.ws + OFF_TQ) + (size_t)g * KU * KA, KA, KA};
        const pg8::Order S{0, 1, 1, 1, nt, mt}; const EpiY E{(bf16_t*)(P.ws + OFF_YS), g};
        pg8::gemm_phase<EpiY, pg8::Order, true, true>((PG8_LAS unsigned char*)lds, gm, S, E);
    }
}
__device__ __forceinline__ void phase5(const Params& P, int bid, int nb, unsigned char* lds) {
    const int xcd = bid & 7, rank = bid >> 3, R = nb >> 3;
    const pg8::Gemm g{(const bf16_t*)(P.ws + OFF_YS), (const bf16_t*)(P.ws + OFF_WGLU), 512, 512};
    const pg8::Order S{rank, R, 32, 2, 0, xcd * 16};
    const EpiGlu E{(const bf16_t*)(P.ws + OFF_YS), (const bf16_t*)(P.ws + OFF_ZS), P.b_glu, (bf16_t*)(P.ws + OFF_MIXIN)};
    pg8::gemm_phase<EpiGlu, pg8::Order, true, true>((PG8_LAS unsigned char*)lds, g, S, E);
}
__device__ __forceinline__ void phase6(const Params& P, int bid, int nb, unsigned char* lds) {
    const int xcd = bid & 7, rank = bid >> 3, R = nb >> 3;
    const pg8::Order S{rank, R, 64, 4, 0, xcd * 16};
    {
        const pg8::Gemm g{(const bf16_t*)(P.ws + OFF_MIXIN), (const bf16_t*)(P.ws + OFF_WOUT), 1024, 1024};
        const EpiStoreSS E{(bf16_t*)(P.ws + OFF_MIX), (float*)(P.ws + OFF_SS)};
        pg8::gemm_phase<EpiStoreSS, pg8::Order, true, true>((PG8_LAS unsigned char*)lds, g, S, E);
    }
    {
        const pg8::Gemm g{(const bf16_t*)(P.ws + OFF_PB), (const bf16_t*)(P.ws + OFF_WPLE), 256, 256};
        const EpiStoreSS E{(bf16_t*)(P.ws + OFF_ERAW), (float*)(P.ws + OFF_ESS)};
        pg8::gemm_phase<EpiStoreSS, pg8::Order, true, true>((PG8_LAS unsigned char*)lds, g, S, E);
    }
}
__device__ __forceinline__ void phase7(const Params& P, int bid, int nb) {
    const int tid = TID, lane = tid & 63, wid = tid >> 6;
    const float* ss = (const float*)(P.ws + OFF_SS); const float* ess = (const float*)(P.ws + OFF_ESS); float* rstd = (float*)(P.ws + OFF_RSTD);
    const bf16_t* mix = (const bf16_t*)(P.ws + OFF_MIX); bf16_t* hb = (bf16_t*)(P.ws + OFF_HB);
    const int vb = bid * 2 + (threadIdx.x >> 8), nvb = nb * 2;
    for (int u = vb; u < T / 8; u += nvb) {
        const int t = u * 8 + wid * 2;
        const int tl = t + (lane >> 5), l5 = lane & 31;
        f32x4 xv[8], mv[8];
#pragma unroll
        for (int j = 0; j < 8; ++j) { const size_t off = (size_t)(t + (j >> 2)) * 1024 + lane * 4 + 256 * (j & 3); xv[j] = *(const f32x4*)(P.x + off); mv[j] = load_bf4(mix + off); }
        float v = l5 < 16 ? ss[(size_t)tl * 16 + l5] : ess[(size_t)tl * 16 + l5 - 16];
        v += __shfl_xor(v, 1); v += __shfl_xor(v, 2); v += __shfl_xor(v, 4); v += __shfl_xor(v, 8);
        const float rp0 = rsqrtf(__shfl(v, 0) * (1.f / 1024.f) + EPS), re0 = rsqrtf(__shfl(v, 16) * (1.f / 1024.f) + EPS);
        const float rp1 = rsqrtf(__shfl(v, 32) * (1.f / 1024.f) + EPS), re1 = rsqrtf(__shfl(v, 48) * (1.f / 1024.f) + EPS);
        if (lane == 0) { rstd[t] = rp0; rstd[T + t] = re0; rstd[t + 1] = rp1; rstd[T + t + 1] = re1; }
#pragma unroll
        for (int j = 0; j < 8; ++j) {
            const int n = lane * 4 + 256 * (j & 3); const size_t off = (size_t)(t + (j >> 2)) * 1024 + n; const float rp = (j >> 2) ? rp1 : rp0;
            const f32x4 gp = *(const f32x4*)(P.norm_post + n); f32x4 h;
#pragma unroll
            for (int e = 0; e < 4; ++e) h[e] = xv[j][e] + mv[j][e] * rp * gp[e];
            store_bf4(hb + off, h);
        }
    }
}
__device__ __forceinline__ void phase8(const Params& P, int bid, int nb, unsigned char* lds) {
    const int xcd = bid & 7, rank = bid >> 3, R = nb >> 3;
    const pg8::Gemm g{(const bf16_t*)(P.ws + OFF_HB), (const bf16_t*)(P.ws + OFF_WPG), 1024, 1024};
    const pg8::Order S{rank, R, 64, 4, 0, xcd * 16};
    const EpiFinal E{(const bf16_t*)(P.ws + OFF_HB), (const bf16_t*)(P.ws + OFF_ERAW), (const float*)(P.ws + OFF_RSTD), P.ple_norm, P.out};
    pg8::gemm_phase<EpiFinal, pg8::Order, true, true>((PG8_LAS unsigned char*)lds, g, S, E);
}

#define XB_TMO      128
#define XB_XCNT(j)  (256  + 64 * (j))
#define XB_XSUB(j)  (1280 + 64 * (j))
#define XB_XGEN(j)  (2304 + 64 * (j))
#define XB_TOP      3328
#define XB_TOPGEN   3392
#define XCD_BAR_WORDS 3456
#define XB_SPIN_CAP (1u << 20)
#define LAS __attribute__((address_space(3)))
__device__ __forceinline__ unsigned xb_ld(unsigned* p)              { return __hip_atomic_load(p, __ATOMIC_RELAXED, __HIP_MEMORY_SCOPE_AGENT); }
__device__ __forceinline__ unsigned xb_add(unsigned* p, unsigned v) { return __hip_atomic_fetch_add(p, v, __ATOMIC_RELAXED, __HIP_MEMORY_SCOPE_AGENT); }
__device__ __forceinline__ unsigned xb_xcc_id() { return (unsigned)__builtin_amdgcn_s_getreg((3 << 11) | 20) & 0xFu; }
#define XB_SPIN(cond, bar) do { unsigned _sp = 0; while (cond) { __builtin_amdgcn_s_sleep(1); \
    if ((++_sp & 255u) == 0u) { if (xb_ld(&(bar)[XB_TMO])) break; if (_sp > XB_SPIN_CAP) { atomicAdd(&(bar)[XB_TMO], 1u); break; } } } } while (0)
struct XcdBarrier { unsigned* bar; unsigned x; volatile LAS unsigned* st; };
__device__ __forceinline__ XcdBarrier xcd_barrier_post(unsigned* bar, volatile LAS unsigned* st) {
    XcdBarrier b; b.bar = bar; b.x = xb_xcc_id(); b.st = st;
    if (threadIdx.x == 0) (void)xb_add(&bar[XB_XCNT(b.x)], 1u);
    return b;
}
__device__ __forceinline__ void xcd_barrier_complete(unsigned* bar, unsigned x, unsigned& nloc, unsigned& nx) {
    const unsigned G = gridDim.x * gridDim.y * gridDim.z;
    unsigned sum, cnt, mine, sp = 0u;
    for (;;) {
        sum = 0u; cnt = 0u; mine = 0u;
#pragma unroll
        for (unsigned j = 0; j < 16; ++j) { const unsigned c = xb_ld(&bar[XB_XCNT(j)]); sum += c; cnt += (c > 0u) ? 1u : 0u; mine = (j == x) ? c : mine; }
        if (sum == G) break;
        __builtin_amdgcn_s_sleep(1);
        if ((++sp & 255u) == 0u) { if (xb_ld(&bar[XB_TMO])) break; if (sp > XB_SPIN_CAP) { atomicAdd(&bar[XB_TMO], 1u); break; } }
    }
    nloc = mine > 0u ? mine : 1u; nx = cnt > 0u ? cnt : 1u;
}
__device__ __forceinline__ void xcd_barrier(const XcdBarrier& b) {
    asm volatile("s_waitcnt vmcnt(0)" ::: "memory");
    __syncthreads();
    if (threadIdx.x == 0) {
        unsigned* bar = b.bar;
        __builtin_amdgcn_s_waitcnt(0);
        unsigned nloc = b.st[0], nx = b.st[1];
        if (nloc == 0u) { xcd_barrier_complete(bar, b.x, nloc, nx); b.st[0] = nloc; b.st[1] = nx; }
        const unsigned old = xb_add(&bar[XB_XSUB(b.x)], 1u);
        const unsigned gen = old / nloc;
        if (old + 1u == (gen + 1u) * nloc) {
            __builtin_amdgcn_fence(__ATOMIC_RELEASE, "agent");
            asm volatile("s_waitcnt vmcnt(0)" ::: "memory");
            const unsigned og = xb_add(&bar[XB_TOP], 1u);
            const unsigned tg = og / nx;
            if (og + 1u == (tg + 1u) * nx) xb_add(&bar[XB_TOPGEN], 1u);
            else XB_SPIN(xb_ld(&bar[XB_TOPGEN]) == tg, bar);
            __builtin_amdgcn_fence(__ATOMIC_ACQUIRE, "agent");
            xb_add(&bar[XB_XGEN(b.x)], 1u);
            asm volatile("s_waitcnt vmcnt(0)" ::: "memory");
        } else {
            XB_SPIN(xb_ld(&bar[XB_XGEN(b.x)]) == gen, bar);
            __builtin_amdgcn_fence(__ATOMIC_ACQUIRE, "agent");
            asm volatile("s_waitcnt vmcnt(0)" ::: "memory");
        }
    }
    __syncthreads();
}

extern __shared__ __attribute__((aligned(16))) unsigned char dyn_lds[];

#if MK_MULTI
__global__ void __launch_bounds__(512, 2) k_phase(Params P, int ph) {
    const int bid = blockIdx.x, nb = gridDim.x;
    switch (ph) {
        case 0: phase0(P, bid, nb, dyn_lds); break;
        case 1: phase1(P, bid, nb, dyn_lds); break;
        case 2: phase2(P, bid, nb, dyn_lds); break;
        case 3: phase3(P, bid, nb); break;
        case 4: phase4(P, bid, nb, dyn_lds); break;
        case 5: phase5(P, bid, nb, dyn_lds); break;
        case 6: phase6(P, bid, nb, dyn_lds); break;
        case 7: phase7(P, bid, nb); break;
        default: phase8(P, bid, nb, dyn_lds); break;
    }
}
#else
__global__ void __launch_bounds__(512, 2) k_mega(Params P) {
    __shared__ uint4 xb_words;
    if (threadIdx.x == 0) xb_words = make_uint4(0u, 0u, 0u, 0u);
    __syncthreads();
    const XcdBarrier xb = xcd_barrier_post((unsigned*)(P.ws + OFF_BAR), (volatile LAS unsigned*)&xb_words);
    const int bid = blockIdx.x, nb = gridDim.x;
#ifndef REP
#define REP -1
#endif
#define PH(n, call) do { call; xcd_barrier(xb); if (REP == n) { call; xcd_barrier(xb); } } while (0)
    PH(0, phase0(P, bid, nb, dyn_lds));
    PH(1, phase1(P, bid, nb, dyn_lds));
    PH(2, phase2(P, bid, nb, dyn_lds));
    PH(3, phase3(P, bid, nb));
    PH(4, phase4(P, bid, nb, dyn_lds));
    PH(5, phase5(P, bid, nb, dyn_lds));
    PH(6, phase6(P, bid, nb, dyn_lds));
    PH(7, phase7(P, bid, nb));
    phase8(P, bid, nb, dyn_lds);
    if (REP == 8) { xcd_barrier(xb); phase8(P, bid, nb, dyn_lds); }
}
#endif

extern "C" void kernel_launch(void* const* d_in, const int* in_sizes, int n_in, void* d_out, int out_size, void* d_ws, size_t ws_size, hipStream_t stream) {
    static int grid = 0;
    if (grid == 0) {
        if (n_in != 20 || ws_size < WS_END) { fprintf(stderr, "kernel_launch: unexpected n_in %d or ws_size %zu (< %zu)\n", n_in, ws_size, (size_t)WS_END); grid = -1; return; }
        int dev = 0, cus = 0, per_cu = 0;
        hipGetDevice(&dev); hipDeviceGetAttribute(&cus, hipDeviceAttributeMultiprocessorCount, dev);
#if MK_MULTI
        hipFuncSetAttribute((const void*)k_phase, hipFuncAttributeMaxDynamicSharedMemorySize, LDS_BYTES);
        hipOccupancyMaxActiveBlocksPerMultiprocessor(&per_cu, (const void*)k_phase, 512, LDS_BYTES);
#else
        hipFuncSetAttribute((const void*)k_mega, hipFuncAttributeMaxDynamicSharedMemorySize, LDS_BYTES);
        hipOccupancyMaxActiveBlocksPerMultiprocessor(&per_cu, (const void*)k_mega, 512, LDS_BYTES);
#endif
        if (per_cu < 1) per_cu = 1;
        if (per_cu > 1) per_cu = 1;
        grid = (cus * per_cu) & ~7;
        (void)hipGetLastError();
    }
    if (grid < 0) return;
    Params P{};
    const float** pp = (const float**)&P;
    for (int i = 0; i < 20; ++i) pp[i] = (const float*)d_in[i];
    P.out = (float*)d_out; P.ws = (unsigned char*)d_ws;
#if MK_MULTI
    for (int ph = 0; ph < 9; ++ph) hipLaunchKernelGGL(k_phase, dim3(grid), dim3(512), LDS_BYTES, stream, P, ph);
#else
    (void)hipMemsetAsync((unsigned char*)d_ws + OFF_BAR, 0, XCD_BAR_WORDS * 4, stream);
    void* args[] = {&P};
    hipError_t e = hipLaunchCooperativeKernel((const void*)k_mega, dim3(grid), dim3(512), args, LDS_BYTES, stream);
    if (e != hipSuccess) fprintf(stderr, "cooperative launch failed: %s (grid %d)\n", hipGetErrorString(e), grid);
#endif
}
```

```cpp
#include <hip/hip_runtime.h>
#include <hip/hip_cooperative_groups.h>
#include <stdint.h>
#include <stdio.h>
namespace cg = cooperative_groups;

#ifndef MK_MULTI
#define MK_MULTI 0
#endif

typedef unsigned short bf16_t;
typedef short bf16x8 __attribute__((ext_vector_type(8)));
typedef float f32x4 __attribute__((ext_vector_type(4)));
typedef unsigned u32x4 __attribute__((ext_vector_type(4)));
typedef unsigned u32x2 __attribute__((ext_vector_type(2)));

constexpr int T = 32768, DM = 1024, SEQ = 8192, DPLE = 256, DIN = 3072;
constexpr int LC = 64;
constexpr int NCH = T / LC;
constexpr int CPB = SEQ / LC;
constexpr int KU = LC * 16;
constexpr int NS = 256;
constexpr int KA = KU + NS;
constexpr float EPS = 1e-6f;

constexpr size_t MB = 1ull << 20;
constexpr size_t OFF_XN = 0;
constexpr size_t OFF_MIXIN = OFF_XN;
constexpr size_t OFF_PB = OFF_XN + 64 * MB;
constexpr size_t OFF_WIN = OFF_PB + 16 * MB;
constexpr size_t OFF_WGLU = OFF_WIN + 6 * MB;
constexpr size_t OFF_WOUT = OFF_WGLU + 1 * MB;
constexpr size_t OFF_WPLE = OFF_WOUT + 2 * MB;
constexpr size_t OFF_WPG = OFF_WPLE + 1 * MB;
constexpr size_t OFF_UA = OFF_WPG + 2 * MB;
constexpr size_t OFF_ZS = OFF_UA + 40 * MB;
constexpr size_t OFF_Q = OFF_ZS + 32 * MB;
constexpr size_t OFF_K = OFF_Q + 32 * MB;
constexpr size_t OFF_VT = OFF_K + 32 * MB;
constexpr size_t OFF_ZN = OFF_VT + 32 * MB;
constexpr size_t OFF_MIX = OFF_Q;
constexpr size_t OFF_HB = OFF_VT;
constexpr size_t OFF_LAM = OFF_ZN + 32 * MB;
constexpr size_t OFF_BBAR = OFF_LAM + 3 * MB;
constexpr size_t OFF_KTAB = OFF_BBAR + 1 * MB;
constexpr size_t OFF_TQ = OFF_KTAB + 4 * MB;
constexpr size_t OFF_ERAW = OFF_TQ;
constexpr size_t OFF_PM = OFF_TQ + 80 * MB;
constexpr size_t OFF_S = OFF_PM + 16 * MB;
constexpr size_t OFF_YS = OFF_S + 16 * MB;
constexpr size_t OFF_SS = OFF_YS + 32 * MB;
constexpr size_t OFF_ESS = OFF_SS + 2 * MB;
constexpr size_t OFF_RSTD = OFF_ESS + 2 * MB;
constexpr size_t OFF_BAR = OFF_RSTD + 1 * MB;
constexpr size_t WS_END = OFF_BAR + 1 * MB;

#define TID ((int)(threadIdx.x & 255))
struct Params {
    const float *x, *p, *norm_pre, *norm_post, *w_in, *a_re, *a_im, *log_dt, *b_re, *b_im, *c_re, *c_im, *ssm_d, *w_glu, *b_glu, *rpb, *w_out, *w_ple, *ple_norm, *w_pg;
    float* out;
    unsigned char* ws;
};

__device__ __forceinline__ unsigned pk2(float lo, float hi) { unsigned r; asm("v_cvt_pk_bf16_f32 %0, %1, %2" : "=v"(r) : "v"(lo), "v"(hi)); return r; }
__device__ __forceinline__ float bflo(unsigned w) { return __uint_as_float(w << 16); }
__device__ __forceinline__ float bfhi(unsigned w) { return __uint_as_float(w & 0xffff0000u); }
__device__ __forceinline__ void store_bf4(bf16_t* p, f32x4 v) { u32x2 w; w.x = pk2(v[0], v[1]); w.y = pk2(v[2], v[3]); *(u32x2*)p = w; }
__device__ __forceinline__ f32x4 load_bf4(const bf16_t* p) { u32x2 w = *(const u32x2*)p; f32x4 v; v[0] = bflo(w.x); v[1] = bfhi(w.x); v[2] = bflo(w.y); v[3] = bfhi(w.y); return v; }
__device__ __forceinline__ float sigmoidf_(float v) { return 1.f / (1.f + __expf(-v)); }
__device__ __forceinline__ float gelu_tanh(float v) { const float u = 0.7978845608028654f * (v + 0.044715f * v * v * v); const float th = 1.f - 2.f / (__expf(2.f * u) + 1.f); return 0.5f * v * (1.f + th); }

constexpr int LDS_BYTES = 18 * 8192 + 2048;
namespace pg8 {
#define PG8_LAS __attribute__((address_space(3)))
constexpr int BM = 256, BK = 64, HALF = 128, HTB = HALF * BK * 2  , STAGE_BYTES = 8 * HTB;
__host__ __device__ __forceinline__ int lds_byte(int r, int c) { const int st = (r >> 4) * 2 + (c >> 5), rr = r & 15, cc = c & 31, ob = rr * 64 + cc * 2; return st * 1024 + (ob ^ (((ob >> 9) & 1) << 5)); }
__host__ __device__ __forceinline__ void stage_rc(int b, int& R, int& C) { const int st = b / 1024, sb = b % 1024, swz = sb ^ (((sb >> 9) & 1) << 5); R = (st >> 1) * 16 + swz / 64; C = (st & 1) * 32 + (swz % 64) / 2; }
__host__ __device__ __forceinline__ int perm32(int rho) { const int n = rho >> 4, i = rho & 15; return 8 * (i >> 2) + 4 * n + (i & 3); }
struct Unit { int pm, pn; };
struct Gemm { const bf16_t* A; const bf16_t* Bt; int lda, K; };
struct Order {
    int rank, R, n_x, nn, n0, m0;
    __device__ __forceinline__ bool next(int i, Unit& u) const { const int l = rank + R * i; if (l >= n_x) return false; u.pn = n0 + l % nn; u.pm = m0 + l / nn; return true; }
    __device__ __forceinline__ void a_ready(const Unit&) const {}
    __device__ __forceinline__ void done(const Unit&) const {}
};
template <class Epi, class Sched, bool ALIGN_EPI = false, bool SP2 = false>
__device__ __forceinline__ void gemm_phase(PG8_LAS unsigned char* lds, const Gemm g, const Sched& S, const Epi& E) {
    const int tid = threadIdx.x, wid = __builtin_amdgcn_readfirstlane(tid >> 6), lane = tid & 63, wr = wid >> 2, wc = wid & 3, fr = lane & 15, fq = lane >> 4;
    const int K = g.K, nt = K / BK;
    unsigned voffA[2], voffB[2];
#pragma unroll
    for (int i = 0; i < 2; ++i) { int R, C; stage_rc(tid * 16 + i * 8192, R, C); const int Rb = Epi::PERM ? ((R & ~31) + perm32(R & 31)) : R;
        voffA[i] = (unsigned)(R * g.lda + C) * 2u; voffB[i] = (unsigned)(Rb * K + C) * 2u; }
    const size_t kstep = (size_t)(BK * 2);
    const size_t hstep = (size_t)HALF * K * 2, hstepA = (size_t)HALF * g.lda * 2;
    const size_t tstep = 2 * hstep, tstepA = 2 * hstepA;
    const unsigned ldsw = (unsigned)wid * 1024u;
    const int aoff = lds_byte(wr * 64 + fr, fq * 8), boff = lds_byte(wc * 32 + fr, fq * 8);
#define PG8_SA(b, h) (((b) * 2 + (h)) * HTB)
#define PG8_SB(b, h) ((4 + (b) * 2 + (h)) * HTB)
#define PG8_STAGE(bufoff, gbase, voff) do { _Pragma("unroll") for (int _i = 0; _i < 2; ++_i) \
        __builtin_amdgcn_global_load_lds((const unsigned*)((const char*)(gbase) + (voff)[_i]), (PG8_LAS unsigned*)(lds + (bufoff) + ldsw + _i * 8192), 16, 0, 0); } while (0)
#define PG8_LDA(dst, b, h) do { _Pragma("unroll") for (int m = 0; m < 4; ++m) _Pragma("unroll") for (int k = 0; k < 2; ++k) dst[m][k] = *(const PG8_LAS bf16x8*)(lds + PG8_SA(b, h) + aoff + m * 2048 + k * 1024); } while (0)
#define PG8_LDB(dst, b, h) do { _Pragma("unroll") for (int n = 0; n < 2; ++n) _Pragma("unroll") for (int k = 0; k < 2; ++k) dst[n][k] = *(const PG8_LAS bf16x8*)(lds + PG8_SB(b, h) + boff + n * 2048 + k * 1024); } while (0)
#define PG8_MMA(ai, bj, At, Bt) do { __builtin_amdgcn_s_setprio(1); _Pragma("unroll") for (int m = 0; m < 4; ++m) _Pragma("unroll") for (int n = 0; n < 2; ++n) _Pragma("unroll") for (int k = 0; k < 2; ++k) \
        acc[ai][bj][m][n] = __builtin_amdgcn_mfma_f32_16x16x32_bf16(Bt[n][k], At[m][k], acc[ai][bj][m][n], 0, 0, 0); __builtin_amdgcn_s_setprio(0); } while (0)
#define PG8_WAIT_V(n) asm volatile("s_waitcnt vmcnt(" #n ")" ::: "memory")
#define PG8_WAIT_L(n) asm volatile("s_waitcnt lgkmcnt(" #n ")" ::: "memory")
#define PG8_BAR __builtin_amdgcn_s_barrier()
#define PG8_SCHED __builtin_amdgcn_sched_barrier(0)
    Unit cur, nxt; int ui = 0;
    if (!S.next(0, cur)) return;
    f32x4 acc[2][2][4][2];
#pragma unroll
    for (int a = 0; a < 2; ++a)
#pragma unroll
        for (int b = 0; b < 2; ++b)
#pragma unroll
            for (int m = 0; m < 4; ++m)
#pragma unroll
                for (int n = 0; n < 2; ++n) acc[a][b][m][n] = (f32x4){0.f, 0.f, 0.f, 0.f};
    bf16x8 At[4][2], B0[2][2], B1[2][2];
    const char* cA = (const char*)g.A + (size_t)cur.pm * tstepA; const char* cB = (const char*)g.Bt + (size_t)cur.pn * tstep;
    S.a_ready(cur);
    if constexpr (SP2) {
        PG8_STAGE(PG8_SB(0, 0), cB, voffB); PG8_STAGE(PG8_SB(0, 1), cB + hstep, voffB); PG8_STAGE(PG8_SA(0, 0), cA, voffA); PG8_STAGE(PG8_SA(0, 1), cA + hstepA, voffA);
        if (wr == 1) PG8_BAR;
        PG8_WAIT_V(2); PG8_BAR;
        PG8_STAGE(PG8_SB(1, 0), cB + kstep, voffB); PG8_STAGE(PG8_SA(1, 0), cA + kstep, voffA); PG8_STAGE(PG8_SB(1, 1), cB + hstep + kstep, voffB);
        PG8_WAIT_V(6); PG8_BAR;
    } else {
        PG8_STAGE(PG8_SB(0, 0), cB, voffB); PG8_STAGE(PG8_SA(0, 0), cA, voffA); PG8_STAGE(PG8_SB(0, 1), cB + hstep, voffB); PG8_STAGE(PG8_SA(0, 1), cA + hstepA, voffA);
        if (wr == 1) PG8_BAR;
        PG8_WAIT_V(4); PG8_BAR;
        PG8_STAGE(PG8_SB(1, 0), cB + kstep, voffB); PG8_STAGE(PG8_SA(1, 0), cA + kstep, voffA); PG8_STAGE(PG8_SB(1, 1), cB + hstep + kstep, voffB);
        PG8_WAIT_V(6); PG8_BAR;
    }
    for (;;) {
        const bool has_next = S.next(ui + 1, nxt);
        const char* nA = has_next ? (const char*)g.A + (size_t)nxt.pm * tstepA : cA; const char* nB = has_next ? (const char*)g.Bt + (size_t)nxt.pn * tstep : cB;
        for (int t = 0; t < nt; t += 2) {
            const bool last = (t == nt - 2);
            const char* a1 = cA + (size_t)(t + 1) * kstep;
            const char* a2 = last ? nA : cA + (size_t)(t + 2) * kstep; const char* b2 = last ? nB : cB + (size_t)(t + 2) * kstep;
            const char* a3 = a2 + kstep; const char* b3 = b2 + kstep;
            if (last && has_next) S.a_ready(nxt);
            if constexpr (SP2) {
            PG8_LDB(B0, 0, 0); PG8_LDB(B1, 0, 1); PG8_SCHED; PG8_LDA(At, 0, 0); PG8_STAGE(PG8_SA(1, 1), a1 + hstepA, voffA);
            PG8_WAIT_V(8); PG8_WAIT_L(0); PG8_BAR; PG8_MMA(0, 0, At, B0); PG8_MMA(0, 1, At, B1); PG8_BAR; PG8_SCHED;
            PG8_LDA(At, 0, 1); PG8_STAGE(PG8_SB(0, 0), b2, voffB); PG8_STAGE(PG8_SB(0, 1), b2 + hstep, voffB); PG8_STAGE(PG8_SA(0, 0), a2, voffA);
            PG8_WAIT_V(8); PG8_WAIT_L(0); PG8_BAR; PG8_MMA(1, 0, At, B0); PG8_MMA(1, 1, At, B1); PG8_BAR; PG8_SCHED;
            PG8_LDB(B0, 1, 0); PG8_LDB(B1, 1, 1); PG8_SCHED; PG8_LDA(At, 1, 0); PG8_STAGE(PG8_SA(0, 1), a2 + hstepA, voffA);
            PG8_WAIT_V(8); PG8_WAIT_L(0); PG8_BAR; PG8_MMA(0, 0, At, B0); PG8_MMA(0, 1, At, B1); PG8_BAR; PG8_SCHED;
            PG8_LDA(At, 1, 1); PG8_STAGE(PG8_SB(1, 0), b3, voffB); PG8_STAGE(PG8_SB(1, 1), b3 + hstep, voffB); PG8_STAGE(PG8_SA(1, 0), a3, voffA);
            PG8_WAIT_V(8); PG8_WAIT_L(0); PG8_BAR; PG8_MMA(1, 0, At, B0); PG8_MMA(1, 1, At, B1); PG8_BAR; PG8_SCHED;
            } else {
            PG8_LDB(B0, 0, 0); PG8_SCHED; PG8_LDA(At, 0, 0); PG8_STAGE(PG8_SA(1, 1), a1 + hstepA, voffA);
            PG8_WAIT_L(8); PG8_BAR; PG8_WAIT_L(0); PG8_MMA(0, 0, At, B0); PG8_BAR; PG8_SCHED;
            PG8_LDB(B1, 0, 1); PG8_STAGE(PG8_SB(0, 0), b2, voffB);
            PG8_BAR; PG8_WAIT_L(0); PG8_MMA(0, 1, At, B1); PG8_BAR;
            PG8_LDA(At, 0, 1); PG8_STAGE(PG8_SA(0, 0), a2, voffA);
            PG8_BAR; PG8_WAIT_L(0); PG8_MMA(1, 0, At, B0); PG8_BAR; PG8_SCHED;
            PG8_STAGE(PG8_SB(0, 1), b2 + hstep, voffB);
            PG8_WAIT_V(6); PG8_BAR; PG8_MMA(1, 1, At, B1); PG8_BAR;
            PG8_LDB(B0, 1, 0); PG8_SCHED; PG8_LDA(At, 1, 0); PG8_STAGE(PG8_SA(0, 1), a2 + hstepA, voffA);
            PG8_WAIT_L(8); PG8_BAR; PG8_WAIT_L(0); PG8_MMA(0, 0, At, B0); PG8_BAR; PG8_SCHED;
            PG8_LDB(B1, 1, 1); PG8_STAGE(PG8_SB(1, 0), b3, voffB);
            PG8_BAR; PG8_WAIT_L(0); PG8_MMA(0, 1, At, B1); PG8_BAR;
            PG8_LDA(At, 1, 1); PG8_STAGE(PG8_SA(1, 0), a3, voffA);
            PG8_BAR; PG8_WAIT_L(0); PG8_MMA(1, 0, At, B0); PG8_BAR; PG8_SCHED;
            PG8_STAGE(PG8_SB(1, 1), b3 + hstep, voffB);
            PG8_WAIT_V(6); PG8_BAR; PG8_MMA(1, 1, At, B1); PG8_BAR;
            }
        }
        if constexpr (ALIGN_EPI) { if (wr == 0) PG8_BAR; }
        if constexpr (!Epi::AFTER_DRAIN) { E(acc, cur, wr, wc, fr, fq); S.done(cur); }
        if (!has_next) break;
#pragma unroll
        for (int a = 0; a < 2; ++a)
#pragma unroll
            for (int b = 0; b < 2; ++b)
#pragma unroll
                for (int m = 0; m < 4; ++m)
#pragma unroll
                    for (int n = 0; n < 2; ++n) acc[a][b][m][n] = (f32x4){0.f, 0.f, 0.f, 0.f};
        cur = nxt; cA = nA; cB = nB; ++ui;
        if constexpr (ALIGN_EPI) { if (wr == 1) PG8_BAR; }
    }
    PG8_WAIT_V(0);
    if constexpr (!ALIGN_EPI) { if (wr == 0) PG8_BAR; }
    PG8_BAR;
    if constexpr (Epi::AFTER_DRAIN) { E.fused(acc, cur, wr, wc, fr, fq, lds, wid, lane); S.done(cur); }
#undef PG8_SA
#undef PG8_SB
#undef PG8_STAGE
#undef PG8_LDA
#undef PG8_LDB
#undef PG8_MMA
#undef PG8_WAIT_V
#undef PG8_WAIT_L
#undef PG8_BAR
#undef PG8_SCHED
}
}

#define EPI_ROWS(...) _Pragma("unroll") for (int ai = 0; ai < 2; ++ai) _Pragma("unroll") for (int m = 0; m < 4; ++m) { const int row = u.pm * 256 + ai * 128 + wr * 64 + m * 16 + fr; __VA_ARGS__ asm volatile("" ::: "memory"); }
#define EPI_COLS(...) _Pragma("unroll") for (int bj = 0; bj < 2; ++bj) _Pragma("unroll") for (int n = 0; n < 2; ++n) { const int col = u.pn * 256 + bj * 128 + wc * 32 + n * 16 + fq * 4; const f32x4 v = acc[ai][bj][m][n]; __VA_ARGS__ }
typedef f32x4 acc_t[2][2][4][2];
struct EpiInProj {
    static constexpr bool PERM = false, AFTER_DRAIN = false;
    unsigned char* ws;
    __device__ __forceinline__ void operator()(const acc_t& acc, const pg8::Unit& u, int wr, int wc, int fr, int fq) const {
        const int sec = (u.pn * 256) >> 9;
        EPI_ROWS( const int t = row; EPI_COLS( const int nn = col & 511;
            if (sec == 0) { const int g = nn >> 4, hh = nn & 15, ch = t / LC, j = t % LC; store_bf4((bf16_t*)(ws + OFF_UA) + ((size_t)(g * NCH + ch)) * KA + j * 16 + hh, v); }
            else if (sec == 1) store_bf4((bf16_t*)(ws + OFF_ZS) + (size_t)t * 512 + nn, v);
            else if (sec == 2) store_bf4((bf16_t*)(ws + OFF_Q) + (size_t)t * 512 + nn, v * 0.125f);
            else if (sec == 3) store_bf4((bf16_t*)(ws + OFF_K) + (size_t)t * 512 + nn, v);
            else if (sec == 4) { const int b = t >> 13, l = t & 8191; bf16_t* vt = (bf16_t*)(ws + OFF_VT) + ((size_t)(b * 512 + nn)) * SEQ + l; const unsigned w0 = pk2(v[0], v[1]), w1 = pk2(v[2], v[3]);
                vt[0] = (bf16_t)(w0 & 0xffff); vt[SEQ] = (bf16_t)(w0 >> 16); vt[2 * SEQ] = (bf16_t)(w1 & 0xffff); vt[3 * SEQ] = (bf16_t)(w1 >> 16); }
            else store_bf4((bf16_t*)(ws + OFF_ZN) + (size_t)t * 512 + nn, v); ) )
    }
};
struct EpiS {
    static constexpr bool PERM = false, AFTER_DRAIN = false;
    float* S;
    __device__ __forceinline__ void operator()(const acc_t& acc, const pg8::Unit& u, int wr, int wc, int fr, int fq) const {
        EPI_ROWS( EPI_COLS( *(f32x4*)(S + (size_t)row * NS + col) = v; ) )
    }
};
struct EpiY {
    static constexpr bool PERM = false, AFTER_DRAIN = false;
    bf16_t* ys; int g;
    __device__ __forceinline__ void operator()(const acc_t& acc, const pg8::Unit& u, int wr, int wc, int fr, int fq) const {
        EPI_ROWS( EPI_COLS( const int i = col >> 4, h = col & 15; f32x4 o;
            _Pragma("unroll") for (int e = 0; e < 4; ++e) o[e] = gelu_tanh(v[e]);
            store_bf4(ys + ((size_t)row * LC + i) * 512 + g * 16 + h, o); ) )
    }
};
struct EpiGlu {
    static constexpr bool PERM = false, AFTER_DRAIN = false;
    const bf16_t* ys; const bf16_t* zs; const float* bglu; bf16_t* mixin;
    __device__ __forceinline__ void operator()(const acc_t& acc, const pg8::Unit& u, int wr, int wc, int fr, int fq) const {
        EPI_ROWS( EPI_COLS( const f32x4 bv = *(const f32x4*)(bglu + col);
            const f32x4 y = load_bf4(ys + (size_t)row * 512 + col), z = load_bf4(zs + (size_t)row * 512 + col); f32x4 o;
            _Pragma("unroll") for (int e = 0; e < 4; ++e) o[e] = y[e] * sigmoidf_(v[e] + bv[e]) * z[e] * sigmoidf_(z[e]);
            store_bf4(mixin + (size_t)row * 1024 + col, o); ) )
    }
};
struct EpiStoreSS {
    static constexpr bool PERM = false, AFTER_DRAIN = false;
    bf16_t* dst; float* ss;
    __device__ __forceinline__ void operator()(const acc_t& acc, const pg8::Unit& u, int wr, int wc, int fr, int fq) const {
        EPI_ROWS( float s = 0.f;
            EPI_COLS( s += (v[0] * v[0] + v[1] * v[1]) + (v[2] * v[2] + v[3] * v[3]); store_bf4(dst + (size_t)row * 1024 + col, v); )
            s += __shfl_xor(s, 16); s += __shfl_xor(s, 32);
            if (fq == 0) ss[(size_t)row * 16 + u.pn * 4 + wc] = s; )
    }
};
struct EpiFinal {
    static constexpr bool PERM = false, AFTER_DRAIN = false;
    const bf16_t* hb; const bf16_t* eraw; const float* rstd; const float* gple; float* out;
    __device__ __forceinline__ void operator()(const acc_t& acc, const pg8::Unit& u, int wr, int wc, int fr, int fq) const {
        EPI_ROWS( const float re = rstd[T + row];
            EPI_COLS( const size_t off = (size_t)row * 1024 + col;
                const f32x4 ge = *(const f32x4*)(gple + col), hv = load_bf4(hb + off), ev = load_bf4(eraw + off); f32x4 o;
                _Pragma("unroll") for (int e = 0; e < 4; ++e) o[e] = hv[e] + sigmoidf_(v[e]) * (ev[e] * re * ge[e]);
                *(f32x4*)(out + off) = o; ) )
    }
};

__device__ __forceinline__ void ktab_unit(const Params& P, int u, float* ldsf) {
    const int dir = u >> 8, g = (u >> 3) & 31, mr = u & 7, tid = TID;
    float2* lp = (float2*)ldsf;
    float2* bb = lp + 64 * 65;
    float2* cc = bb + 64 * 16;
    float2* lampow = (float2*)(P.ws + OFF_LAM); float2* bbar = (float2*)(P.ws + OFF_BBAR); float* ktab = (float*)(P.ws + OFF_KTAB);
    if (tid < 64) {
        const int p = tid, idx = (dir * 32 + g) * 64 + p;
        const float ar = P.a_re[idx], ai = P.a_im[idx], dt = expf(P.log_dt[dir * 32 + g]);
        const float mag = expf(dt * ar), ang = dt * ai; const float lr = mag * cosf(ang), li = mag * sinf(ang);
        const float nr = lr - 1.f, ni = li, den = ar * ar + ai * ai;
        const float cr = (nr * ar + ni * ai) / den, ci = (ni * ar - nr * ai) / den;
        float brv[16], biv[16];
#pragma unroll
        for (int h = 0; h < 16; ++h) { brv[h] = P.b_re[idx * 16 + h]; biv[h] = P.b_im[idx * 16 + h]; }
        float pr = 1.f, pi = 0.f;
        for (int m = 0; m <= 64; ++m) { lp[p * 65 + m] = make_float2(pr, pi); if (mr == 0) lampow[(size_t)idx * 65 + m] = make_float2(pr, pi); const float tt = pr * lr - pi * li; pi = pr * li + pi * lr; pr = tt; }
#pragma unroll
        for (int h = 0; h < 16; ++h) { const float2 v = make_float2(cr * brv[h] - ci * biv[h], cr * biv[h] + ci * brv[h]); bb[p * 16 + h] = v; if (mr == 0) bbar[(size_t)idx * 16 + h] = v; }
    }
#pragma unroll
    for (int i = 0; i < 4; ++i) { const int e = tid + 256 * i; cc[(e >> 6) * 65 + (e & 63)] = make_float2(P.c_re[(dir * 32 + g) * 1024 + e], P.c_im[(dir * 32 + g) * 1024 + e]); }
    __syncthreads();
    const int h = tid >> 4, h2 = tid & 15;
    float s[8];
#pragma unroll
    for (int mm = 0; mm < 8; ++mm) s[mm] = 0.f;
    for (int p = 0; p < 64; ++p) {
        const float2 c = cc[h * 65 + p], b = bb[p * 16 + h2];
        const float cbx = c.x * b.x - c.y * b.y, cby = c.x * b.y + c.y * b.x;
#pragma unroll
        for (int mm = 0; mm < 8; ++mm) { const float2 l = lp[p * 65 + mr * 8 + mm]; s[mm] += cbx * l.x - cby * l.y; }
    }
#pragma unroll
    for (int mm = 0; mm < 8; ++mm) ktab[((size_t)((dir * 32 + g) * 64 + mr * 8 + mm)) * 256 + h * 16 + h2] = s[mm];
    __syncthreads();
}
__device__ __forceinline__ void transpose_unit(const float* W, int K, int N, const float* gain, bf16_t* Wt, int item, float* ldsf) {
    const int nblk = N / 64, kb = item / nblk, nbk = item % nblk, k0 = kb * 64, n0 = nbk * 64, tid = TID;
#pragma unroll 4
    for (int i = 0; i < 16; ++i) { const int kk = i * 4 + (tid >> 6), nn = tid & 63; float v = W[(size_t)(k0 + kk) * N + n0 + nn]; if (gain) v *= gain[k0 + kk]; ldsf[kk * 65 + nn] = v; }
    __syncthreads();
#pragma unroll 4
    for (int i = 0; i < 8; ++i) { const int nn = i * 8 + (tid >> 5), kk = (tid & 31) * 2; *(unsigned*)(Wt + (size_t)(n0 + nn) * K + k0 + kk) = pk2(ldsf[kk * 65 + nn], ldsf[(kk + 1) * 65 + nn]); }
    __syncthreads();
}
__device__ __forceinline__ float wave_sum(float v) {
#pragma unroll
    for (int o = 1; o < 64; o <<= 1) v += __shfl_xor(v, o);
    return v;
}
__device__ __forceinline__ void phase0(const Params& P, int bid, int nb, unsigned char* lds) {
    float* ldsf = (float*)(lds + (threadIdx.x >> 8) * 65536);
    const int vb = bid * 2 + (threadIdx.x >> 8), nvb = nb * 2;
    constexpr int U_K = 512, I_IN = 16 * 48, I_GLU = 64, I_OUT = 256, I_PLE = 4 * 16, I_PG = 256, U_T = I_IN + I_GLU + I_OUT + I_PLE + I_PG, U_X = T / 8, U_P = (T * DPLE) / 2048;
    constexpr int NU = U_K + U_T + U_X + U_P;
    const int tid = TID, lane = tid & 63, wid = tid >> 6;
    for (int u = vb; u < NU; u += nvb) {
        int r = u;
        if (r < U_K) { ktab_unit(P, r, ldsf); continue; } r -= U_K;
        if (r < U_T) {
            if (r < I_IN) { transpose_unit(P.w_in, 1024, 3072, P.norm_pre, (bf16_t*)(P.ws + OFF_WIN), r, ldsf); continue; } r -= I_IN;
            if (r < I_GLU) { transpose_unit(P.w_glu, 512, 512, nullptr, (bf16_t*)(P.ws + OFF_WGLU), r, ldsf); continue; } r -= I_GLU;
            if (r < I_OUT) { transpose_unit(P.w_out, 1024, 1024, nullptr, (bf16_t*)(P.ws + OFF_WOUT), r, ldsf); continue; } r -= I_OUT;
            if (r < I_PLE) { transpose_unit(P.w_ple, 256, 1024, nullptr, (bf16_t*)(P.ws + OFF_WPLE), r, ldsf); continue; } r -= I_PLE;
            transpose_unit(P.w_pg, 1024, 1024, nullptr, (bf16_t*)(P.ws + OFF_WPG), r, ldsf); continue;
        }
        r -= U_T;
        if (r < U_X) {
            const int t = r * 8 + wid * 2; const f32x4* xr = (const f32x4*)(P.x + (size_t)t * 1024) + lane; f32x4 v[8]; float s0 = 0.f, s1 = 0.f;
#pragma unroll
            for (int j = 0; j < 8; ++j) v[j] = xr[64 * j];
#pragma unroll
            for (int j = 0; j < 4; ++j) { s0 += (v[j][0] * v[j][0] + v[j][1] * v[j][1]) + (v[j][2] * v[j][2] + v[j][3] * v[j][3]); s1 += (v[4 + j][0] * v[4 + j][0] + v[4 + j][1] * v[4 + j][1]) + (v[4 + j][2] * v[4 + j][2] + v[4 + j][3] * v[4 + j][3]); }
            const float rs0 = rsqrtf(wave_sum(s0) * (1.f / 1024.f) + EPS), rs1 = rsqrtf(wave_sum(s1) * (1.f / 1024.f) + EPS);
            bf16_t* o = (bf16_t*)(P.ws + OFF_XN) + (size_t)t * 1024 + lane * 4;
#pragma unroll
            for (int j = 0; j < 4; ++j) { store_bf4(o + 256 * j, v[j] * rs0); store_bf4(o + 1024 + 256 * j, v[4 + j] * rs1); }
            continue;
        }
        r -= U_X;
        {
            const size_t e0 = (size_t)r * 2048 + tid * 8; const f32x4 a = *(const f32x4*)(P.p + e0), b = *(const f32x4*)(P.p + e0 + 4);
            u32x4 w; w.x = pk2(a[0], a[1]); w.y = pk2(a[2], a[3]); w.z = pk2(b[0], b[1]); w.w = pk2(b[2], b[3]);
            *(u32x4*)((bf16_t*)(P.ws + OFF_PB) + e0) = w;
        }
    }
}

__device__ __forceinline__ void tq_unit(const Params& P, int u) {
    static_assert(LC == 64, "tq_unit / pm_unit thread maps assume 64-token chunks");
    const int g = u / LC, i = u % LC, tid = TID;
    const float* ktab = (const float*)(P.ws + OFF_KTAB); const float2* lampow = (const float2*)(P.ws + OFF_LAM); bf16_t* tq = (bf16_t*)(P.ws + OFF_TQ);
    const int h2 = (tid & 7) * 2;
#pragma unroll
    for (int half = 0; half < 2; ++half) {
        const int j = (tid >> 3) + 32 * half;
        const int ma = i > j ? i - j : 0, mb = j > i ? j - i : 0;
        const float wa = i >= j ? 1.f : 0.f, wb = j >= i ? 1.f : 0.f;
        const float* kf = ktab + ((size_t)((0 * 32 + g) * 64 + ma)) * 256 + h2; const float* kb = ktab + ((size_t)((1 * 32 + g) * 64 + mb)) * 256 + h2;
        float2 a[16], b[16];
#pragma unroll
        for (int h = 0; h < 16; ++h) { a[h] = *(const float2*)(kf + h * 16); b[h] = *(const float2*)(kb + h * 16); }
#pragma unroll
        for (int h = 0; h < 16; ++h) {
            float v0 = wa * a[h].x + wb * b[h].x, v1 = wa * a[h].y + wb * b[h].y;
            if (i == j) { const float dd = P.ssm_d[g * 16 + h]; v0 += (h == h2 ? dd : 0.f); v1 += (h == h2 + 1 ? dd : 0.f); }
            *(unsigned*)(tq + ((size_t)(g * KU + i * 16 + h)) * KA + j * 16 + h2) = pk2(v0, v1);
        }
    }
    {
        const int pn = tid & 127, dir = pn >> 6, p = pn & 63, m = dir == 0 ? i + 1 : LC - i;
        const float2 l = lampow[((size_t)((dir * 32 + g) * 64 + p)) * 65 + m];
        float cr[8], ci[8];
#pragma unroll
        for (int it = 0; it < 8; ++it) { const int h = it * 2 + (tid >> 7); cr[it] = P.c_re[((dir * 32 + g) * 16 + h) * 64 + p]; ci[it] = P.c_im[((dir * 32 + g) * 16 + h) * 64 + p]; }
#pragma unroll
        for (int it = 0; it < 8; ++it) { const int h = it * 2 + (tid >> 7);
            *(unsigned*)(tq + ((size_t)(g * KU + i * 16 + h)) * KA + KU + dir * 128 + p * 2) = pk2(cr[it] * l.x - ci[it] * l.y, -(cr[it] * l.y + ci[it] * l.x)); }
    }
}
__device__ __forceinline__ void pm_unit(const Params& P, int u) {
    const int g = u >> 4, rg = u & 15, tid = TID;
    const float2* lampow = (const float2*)(P.ws + OFF_LAM); const float2* bbar = (const float2*)(P.ws + OFF_BBAR); bf16_t* pm = (bf16_t*)(P.ws + OFF_PM);
    const int h2 = (tid & 7) * 2;
#pragma unroll 4
    for (int q = 0; q < 8; ++q) {
        const int pidx = rg * 8 + q, dir = pidx >> 6, p = pidx & 63;
        const f32x4 bq = *(const f32x4*)(bbar + ((size_t)((dir * 32 + g) * 64 + p)) * 16 + h2);
#pragma unroll
        for (int half = 0; half < 2; ++half) {
            const int j = (tid >> 3) + 32 * half, m = dir == 0 ? LC - 1 - j : j;
            const float2 l = lampow[((size_t)((dir * 32 + g) * 64 + p)) * 65 + m];
            bf16_t* dst = pm + ((size_t)(g * NS + 2 * pidx)) * KU + j * 16 + h2;
            *(unsigned*)dst = pk2(l.x * bq[0] - l.y * bq[1], l.x * bq[2] - l.y * bq[3]);
            *(unsigned*)(dst + KU) = pk2(l.x * bq[1] + l.y * bq[0], l.x * bq[3] + l.y * bq[2]);
        }
    }
}
__device__ __forceinline__ void phase1(const Params& P, int bid, int nb, unsigned char* lds) {
    constexpr int U_TQ = 32 * LC, U_PM = 32 * 16;
    const int xcd = bid & 7, rank = bid >> 3, R = nb >> 3;
    {
        const pg8::Gemm g{(const bf16_t*)(P.ws + OFF_XN), (const bf16_t*)(P.ws + OFF_WIN), 1024, 1024};
        const pg8::Order S{rank, R, 192, 6, (xcd & 1) * 6, (xcd >> 1) * 32}; const EpiInProj E{P.ws};
        pg8::gemm_phase<EpiInProj, pg8::Order, true, true>((PG8_LAS unsigned char*)lds, g, S, E);
    }
    const int vb = bid * 2 + (threadIdx.x >> 8), nvb = nb * 2;
    for (int u = vb; u < U_TQ + U_PM; u += nvb) {
        if (u < U_TQ) tq_unit(P, u);
        else pm_unit(P, u - U_TQ);
    }
}

__device__ __forceinline__ void na_unit(const Params& P, int u, float* ldsf) {
    const int tid = TID, lane = tid & 63, cb = tid >> 6, fr = lane & 15, fq = lane >> 4;
    const int r = u & 127, head = (u >> 7) & 7, b = u >> 10;
    const bf16_t* q = (const bf16_t*)(P.ws + OFF_Q); const bf16_t* k = (const bf16_t*)(P.ws + OFF_K); const bf16_t* vt = (const bf16_t*)(P.ws + OFF_VT); const bf16_t* zn = (const bf16_t*)(P.ws + OFF_ZN);
    bf16_t* mixin = (bf16_t*)(P.ws + OFF_MIXIN);
    for (int i = tid; i < 15 * 31; i += 256) ldsf[i] = P.rpb[head * 15 * 31 + i];
    const int rs = min(max(r - 4, 0), 120);
    const int cw0 = cb == 0 ? 0 : (cb == 1 ? 8 : (cb == 2 ? 24 : 32));
    const int c = cb * 16 + fr, cs = min(max(c - 8, 0), 48);
    const size_t tq = (size_t)b * SEQ + r * 64 + c;
    const bf16x8 qf0 = *(const bf16x8*)(q + tq * 512 + head * 64 + fq * 8), qf1 = *(const bf16x8*)(q + tq * 512 + head * 64 + 32 + fq * 8);
    f32x4 s[16];
    const int kcol = cw0 + (fr >> 2) * 8 + (fr & 3);
    const bf16_t* kbase = k + ((size_t)b * SEQ + rs * 64 + kcol) * 512 + head * 64 + fq * 8;
#pragma unroll
    for (int hf = 0; hf < 2; ++hf) {
        bf16x8 k0[8], k1[8];
#pragma unroll
        for (int t = 0; t < 8; ++t) { const int tt = hf * 8 + t; const bf16_t* kp = kbase + ((size_t)(tt >> 1) * 64 + (tt & 1) * 4) * 512; k0[t] = *(const bf16x8*)kp; k1[t] = *(const bf16x8*)(kp + 32); }
#pragma unroll
        for (int t = 0; t < 8; ++t) {
            f32x4 z = (f32x4){0.f, 0.f, 0.f, 0.f};
            z = __builtin_amdgcn_mfma_f32_16x16x32_bf16(k0[t], qf0, z, 0, 0, 0);
            z = __builtin_amdgcn_mfma_f32_16x16x32_bf16(k1[t], qf1, z, 0, 0, 0);
            s[hf * 8 + t] = z;
        }
    }
    __syncthreads();
    float mx = -3.0e38f;
#pragma unroll
    for (int t = 0; t < 16; ++t) {
        const int i = t >> 1, odd = t & 1, dr = rs + i - r + 7;
#pragma unroll
        for (int e = 0; e < 4; ++e) {
            const int ck = cw0 + fq * 8 + odd * 4 + e; const bool valid = (ck >= cs) && (ck < cs + 16);
            const int dc = min(max(ck - c + 15, 0), 30);
            const float bv = ldsf[dr * 31 + dc];
            const float sv = valid ? s[t][e] + bv : -3.0e38f;
            s[t][e] = sv; mx = fmaxf(mx, sv);
        }
    }
    mx = fmaxf(mx, __shfl_xor(mx, 16)); mx = fmaxf(mx, __shfl_xor(mx, 32));
    float l = 0.f;
#pragma unroll
    for (int t = 0; t < 16; ++t)
#pragma unroll
        for (int e = 0; e < 4; ++e) { const float pv = __expf(s[t][e] - mx); s[t][e] = pv; l += pv; }
    l += __shfl_xor(l, 16); l += __shfl_xor(l, 32);
    f32x4 o[4];
#pragma unroll
    for (int dt = 0; dt < 4; ++dt) o[dt] = (f32x4){0.f, 0.f, 0.f, 0.f};
    const bf16_t* vbase = vt + ((size_t)(b * 512 + head * 64 + fr)) * SEQ + rs * 64 + cw0 + fq * 8;
#pragma unroll
    for (int k2 = 0; k2 < 4; ++k2) {
        bf16x8 vf[2][4];
#pragma unroll
        for (int kk = 0; kk < 2; ++kk)
#pragma unroll
            for (int dt = 0; dt < 4; ++dt) vf[kk][dt] = *(const bf16x8*)(vbase + (size_t)dt * 16 * SEQ + (k2 * 2 + kk) * 64);
#pragma unroll
        for (int kk = 0; kk < 2; ++kk) {
            const int kq = k2 * 2 + kk;
            u32x4 pw; pw.x = pk2(s[2 * kq][0], s[2 * kq][1]); pw.y = pk2(s[2 * kq][2], s[2 * kq][3]); pw.z = pk2(s[2 * kq + 1][0], s[2 * kq + 1][1]); pw.w = pk2(s[2 * kq + 1][2], s[2 * kq + 1][3]);
            const bf16x8 pf = __builtin_bit_cast(bf16x8, pw);
#pragma unroll
            for (int dt = 0; dt < 4; ++dt) o[dt] = __builtin_amdgcn_mfma_f32_16x16x32_bf16(vf[kk][dt], pf, o[dt], 0, 0, 0);
        }
    }
    const float inv = 1.f / l;
#pragma unroll
    for (int dt = 0; dt < 4; ++dt) {
        const int d0 = head * 64 + dt * 16 + fq * 4; const f32x4 z = load_bf4(zn + tq * 512 + d0); f32x4 ov;
#pragma unroll
        for (int e = 0; e < 4; ++e) ov[e] = o[dt][e] * inv * z[e] * sigmoidf_(z[e]);
        store_bf4(mixin + tq * 1024 + 512 + d0, ov);
    }
    __syncthreads();
}
constexpr int NA_KOFF = 0, NA_VOFF = 9 * 8192, NA_BOFF = 18 * 8192, NA_LDS = NA_BOFF + 2048;
__device__ __forceinline__ void na_block(const Params& P, int unit, unsigned char* lds) {
    const int tid = threadIdx.x, lane = tid & 63, w = tid >> 6, qrow = w >> 2, cb = w & 3, fr = lane & 15, fq = lane >> 4;
    const int seg = unit & 7, head = (unit >> 3) & 7, b = unit >> 6;
    const bf16_t* q = (const bf16_t*)(P.ws + OFF_Q); const bf16_t* k = (const bf16_t*)(P.ws + OFF_K); const bf16_t* vt = (const bf16_t*)(P.ws + OFF_VT); const bf16_t* zn = (const bf16_t*)(P.ws + OFF_ZN);
    bf16_t* mixin = (bf16_t*)(P.ws + OFF_MIXIN);
    float* bias = (float*)(lds + NA_BOFF);
    do { asm volatile("s_waitcnt vmcnt(0) lgkmcnt(0)" ::: "memory"); __syncthreads(); } while (0);
    for (int i = tid; i < 15 * 31; i += 512) bias[i] = P.rpb[head * 15 * 31 + i];
    const int st_r = tid >> 3, st_c = tid & 7;
    const int ksw = st_r * 128 + ((st_c ^ (((st_r >> 1) & 1) | (((st_r >> 3) & 3) << 1))) * 16);
    const int vsw = st_r * 128 + ((st_c ^ (st_r & 7)) * 16);
    const bf16_t* kst = k + ((size_t)b * SEQ + st_r) * 512 + head * 64 + st_c * 8;
    const bf16_t* vst = vt + ((size_t)(b * 512 + head * 64 + st_r)) * SEQ + st_c * 8;
    const int cw0 = cb == 0 ? 0 : (cb == 1 ? 8 : (cb == 2 ? 24 : 32));
    const int c = cb * 16 + fr, cs = min(max(c - 8, 0), 48);
    const int kcol = cw0 + (fr >> 2) * 8 + (fr & 3);
    const int sK = ((kcol >> 1) & 1) | (((kcol >> 3) & 3) << 1);
    const int kfo0 = kcol * 128 + ((fq ^ sK) * 16), kfo1 = kcol * 128 + (((4 + fq) ^ sK) * 16);
    const int vfo = fr * 128 + ((((cw0 >> 3) + fq) ^ (fr & 7)) * 16);
    int res_hi = -1;
    for (int p = 0; p < 8; ++p) {
        const int r0 = seg * 16 + 2 * p;
        const int lo = min(max(r0 - 4, 0), 120), hi = min(max(r0 - 3, 0), 120) + 7;
        const int first_new = max(lo, res_hi + 1);
        do { asm volatile("s_waitcnt vmcnt(0) lgkmcnt(0)" ::: "memory"); __syncthreads(); } while (0);
        for (int kr0 = first_new; kr0 <= hi; kr0 += 3) {
            u32x4 kv[3], vv[3];
#pragma unroll
            for (int j = 0; j < 3; ++j) { const int kr = min(kr0 + j, hi); kv[j] = *(const u32x4*)(kst + (size_t)kr * 64 * 512); vv[j] = *(const u32x4*)(vst + kr * 64); }
#pragma unroll
            for (int j = 0; j < 3; ++j) { const int slot = min(kr0 + j, hi) % 9; *(u32x4*)(lds + NA_KOFF + slot * 8192 + ksw) = kv[j]; *(u32x4*)(lds + NA_VOFF + slot * 8192 + vsw) = vv[j]; }
        }
        res_hi = hi;
        const int r = r0 + qrow, rs = min(max(r - 4, 0), 120);
        const size_t tq = (size_t)b * SEQ + r * 64 + c;
        const bf16x8 qf0 = *(const bf16x8*)(q + tq * 512 + head * 64 + fq * 8), qf1 = *(const bf16x8*)(q + tq * 512 + head * 64 + 32 + fq * 8);
        f32x4 zg[4];
#pragma unroll
        for (int dt = 0; dt < 4; ++dt) zg[dt] = load_bf4(zn + tq * 512 + head * 64 + dt * 16 + fq * 4);
        do { asm volatile("s_waitcnt vmcnt(0) lgkmcnt(0)" ::: "memory"); __syncthreads(); } while (0);
        f32x4 s[16];
#pragma unroll
        for (int t = 0; t < 16; ++t) {
            const int slot = (rs + (t >> 1)) % 9; const unsigned char* kb = lds + NA_KOFF + slot * 8192 + (t & 1) * 4 * 128;
            const bf16x8 k0 = *(const bf16x8*)(kb + kfo0), k1 = *(const bf16x8*)(kb + kfo1);
            f32x4 z = (f32x4){0.f, 0.f, 0.f, 0.f};
            z = __builtin_amdgcn_mfma_f32_16x16x32_bf16(k0, qf0, z, 0, 0, 0);
            z = __builtin_amdgcn_mfma_f32_16x16x32_bf16(k1, qf1, z, 0, 0, 0);
            s[t] = z;
        }
        float mx = -3.0e38f;
#pragma unroll
        for (int t = 0; t < 16; ++t) {
            const int i = t >> 1, odd = t & 1, dr = rs + i - r + 7;
#pragma unroll
            for (int e = 0; e < 4; ++e) {
                const int ck = cw0 + fq * 8 + odd * 4 + e; const bool valid = (ck >= cs) && (ck < cs + 16);
                const int dc = min(max(ck - c + 15, 0), 30);
                const float bv = bias[dr * 31 + dc];
                const float sv = valid ? s[t][e] + bv : -3.0e38f;
                s[t][e] = sv; mx = fmaxf(mx, sv);
            }
        }
        mx = fmaxf(mx, __shfl_xor(mx, 16)); mx = fmaxf(mx, __shfl_xor(mx, 32));
        float l = 0.f;
#pragma unroll
        for (int t = 0; t < 16; ++t)
#pragma unroll
            for (int e = 0; e < 4; ++e) { const float pv = __expf(s[t][e] - mx); s[t][e] = pv; l += pv; }
        l += __shfl_xor(l, 16); l += __shfl_xor(l, 32);
        f32x4 o[4];
#pragma unroll
        for (int dt = 0; dt < 4; ++dt) o[dt] = (f32x4){0.f, 0.f, 0.f, 0.f};
#pragma unroll
        for (int kq = 0; kq < 8; ++kq) {
            u32x4 pw; pw.x = pk2(s[2 * kq][0], s[2 * kq][1]); pw.y = pk2(s[2 * kq][2], s[2 * kq][3]); pw.z = pk2(s[2 * kq + 1][0], s[2 * kq + 1][1]); pw.w = pk2(s[2 * kq + 1][2], s[2 * kq + 1][3]);
            const bf16x8 pf = __builtin_bit_cast(bf16x8, pw);
            const unsigned char* vb = lds + NA_VOFF + ((rs + kq) % 9) * 8192 + vfo;
#pragma unroll
            for (int dt = 0; dt < 4; ++dt) { const bf16x8 vf = *(const bf16x8*)(vb + dt * 16 * 128); o[dt] = __builtin_amdgcn_mfma_f32_16x16x32_bf16(vf, pf, o[dt], 0, 0, 0); }
        }
        const float inv = 1.f / l;
#pragma unroll
        for (int dt = 0; dt < 4; ++dt) {
            const int d0 = head * 64 + dt * 16 + fq * 4; const f32x4 z = zg[dt]; f32x4 ov;
#pragma unroll
            for (int e = 0; e < 4; ++e) ov[e] = o[dt][e] * inv * z[e] * sigmoidf_(z[e]);
            store_bf4(mixin + tq * 1024 + 512 + d0, ov);
        }
        do { asm volatile("s_waitcnt vmcnt(0) lgkmcnt(0)" ::: "memory"); __syncthreads(); } while (0);
    }
    do { asm volatile("s_waitcnt vmcnt(0) lgkmcnt(0)" ::: "memory"); __syncthreads(); } while (0);
}
__device__ __forceinline__ void phase2(const Params& P, int bid, int nb, unsigned char* lds) {
    const int xcd = bid & 7, rank = bid >> 3, R = nb >> 3;
    for (int l = rank; l < 8; l += R) {
        const int mt = l & 1, g = xcd + 8 * (l >> 1);
        const pg8::Gemm gm{(const bf16_t*)(P.ws + OFF_UA) + (size_t)g * NCH * KA, (const bf16_t*)(P.ws + OFF_PM) + (size_t)g * NS * KU, KA, KU};
        const pg8::Order S{0, 1, 1, 1, 0, mt}; const EpiS E{(float*)(P.ws + OFF_S) + (size_t)g * NCH * NS};
        pg8::gemm_phase<EpiS, pg8::Order, true, true>((PG8_LAS unsigned char*)lds, gm, S, E);
    }
    for (int l = rank; l < 32; l += R) na_block(P, xcd * 32 + l, lds);
}

__device__ __forceinline__ void phase3(const Params& P, int bid, int nb) {
    const float2* lampow = (const float2*)(P.ws + OFF_LAM); const float2* S = (const float2*)(P.ws + OFF_S); bf16_t* ua = (bf16_t*)(P.ws + OFF_UA);
    const int vb = bid * 2 + (threadIdx.x >> 8), nvb = nb * 2;
    for (int sidx = vb * 256 + TID; sidx < 4 * 2 * 32 * 64; sidx += nvb * 256) {
        const int p = sidx & 63, g = (sidx >> 6) & 31, dir = (sidx >> 11) & 1, b = sidx >> 12;
        const float2 L = lampow[((size_t)((dir * 32 + g) * 64 + p)) * 65 + LC];
        float hr = 0.f, hi = 0.f;
        const float2* Sp = S + ((size_t)(g * NCH + b * CPB)) * (NS / 2) + dir * 64 + p;
        bf16_t* up = ua + ((size_t)(g * NCH + b * CPB)) * KA + KU + dir * 128 + p * 2;
        for (int cb0 = 0; cb0 < CPB; cb0 += 16) {
            float2 sv[16];
#pragma unroll
            for (int uu = 0; uu < 16; ++uu) { const int c = dir == 0 ? cb0 + uu : CPB - 1 - (cb0 + uu); sv[uu] = Sp[(size_t)c * (NS / 2)]; }
#pragma unroll
            for (int uu = 0; uu < 16; ++uu) {
                const int c = dir == 0 ? cb0 + uu : CPB - 1 - (cb0 + uu);
                *(unsigned*)(up + (size_t)c * KA) = pk2(hr, hi);
                const float tr = L.x * hr - L.y * hi + sv[uu].x; hi = L.x * hi + L.y * hr + sv[uu].y; hr = tr;
            }
        }
    }
}

__device__ __forceinline__ void phase4(const Params& P, int bid, int nb, unsigned char* lds) {
    const int xcd = bid & 7, rank = bid >> 3, R = nb >> 3;
    for (int l = rank; l < 32; l += R) {
        const int mt = l & 1, nt = (l >> 1) & 3, g = xcd + 8 * (l >> 3);
        const pg8::Gemm gm{(const bf16_t*)(P.ws + OFF_UA) + (size_t)g * NCH * KA, (const bf16_t*)(P.ws + OFF_TQ) + (size_t)g * KU * KA, KA, KA};
        const pg8::Order S{0, 1, 1, 1, nt, mt}; const EpiY E{(bf16_t*)(P.ws + OFF_YS), g};
        pg8::gemm_phase<EpiY, pg8::Order, true, true>((PG8_LAS unsigned char*)lds, gm, S, E);
    }
}
__device__ __forceinline__ void phase5(const Params& P, int bid, int nb, unsigned char* lds) {
    const int xcd = bid & 7, rank = bid >> 3, R = nb >> 3;
    const pg8::Gemm g{(const bf16_t*)(P.ws + OFF_YS), (const bf16_t*)(P.ws + OFF_WGLU), 512, 512};
    const pg8::Order S{rank, R, 32, 2, 0, xcd * 16};
    const EpiGlu E{(const bf16_t*)(P.ws + OFF_YS), (const bf16_t*)(P.ws + OFF_ZS), P.b_glu, (bf16_t*)(P.ws + OFF_MIXIN)};
    pg8::gemm_phase<EpiGlu, pg8::Order, true, true>((PG8_LAS unsigned char*)lds, g, S, E);
}
__device__ __forceinline__ void phase6(const Params& P, int bid, int nb, unsigned char* lds) {
    const int xcd = bid & 7, rank = bid >> 3, R = nb >> 3;
    const pg8::Order S{rank, R, 64, 4, 0, xcd * 16};
    {
        const pg8::Gemm g{(const bf16_t*)(P.ws + OFF_MIXIN), (const bf16_t*)(P.ws + OFF_WOUT), 1024, 1024};
        const EpiStoreSS E{(bf16_t*)(P.ws + OFF_MIX), (float*)(P.ws + OFF_SS)};
        pg8::gemm_phase<EpiStoreSS, pg8::Order, true, true>((PG8_LAS unsigned char*)lds, g, S, E);
    }
    {
        const pg8::Gemm g{(const bf16_t*)(P.ws + OFF_PB), (const bf16_t*)(P.ws + OFF_WPLE), 256, 256};
        const EpiStoreSS E{(bf16_t*)(P.ws + OFF_ERAW), (float*)(P.ws + OFF_ESS)};
        pg8::gemm_phase<EpiStoreSS, pg8::Order, true, true>((PG8_LAS unsigned char*)lds, g, S, E);
    }
}
__device__ __forceinline__ void phase7(const Params& P, int bid, int nb) {
    const int tid = TID, lane = tid & 63, wid = tid >> 6;
    const float* ss = (const float*)(P.ws + OFF_SS); const float* ess = (const float*)(P.ws + OFF_ESS); float* rstd = (float*)(P.ws + OFF_RSTD);
    const bf16_t* mix = (const bf16_t*)(P.ws + OFF_MIX); bf16_t* hb = (bf16_t*)(P.ws + OFF_HB);
    const int vb = bid * 2 + (threadIdx.x >> 8), nvb = nb * 2;
    for (int u = vb; u < T / 8; u += nvb) {
        const int t = u * 8 + wid * 2;
        const int tl = t + (lane >> 5), l5 = lane & 31;
        f32x4 xv[8], mv[8];
#pragma unroll
        for (int j = 0; j < 8; ++j) { const size_t off = (size_t)(t + (j >> 2)) * 1024 + lane * 4 + 256 * (j & 3); xv[j] = *(const f32x4*)(P.x + off); mv[j] = load_bf4(mix + off); }
        float v = l5 < 16 ? ss[(size_t)tl * 16 + l5] : ess[(size_t)tl * 16 + l5 - 16];
        v += __shfl_xor(v, 1); v += __shfl_xor(v, 2); v += __shfl_xor(v, 4); v += __shfl_xor(v, 8);
        const float rp0 = rsqrtf(__shfl(v, 0) * (1.f / 1024.f) + EPS), re0 = rsqrtf(__shfl(v, 16) * (1.f / 1024.f) + EPS);
        const float rp1 = rsqrtf(__shfl(v, 32) * (1.f / 1024.f) + EPS), re1 = rsqrtf(__shfl(v, 48) * (1.f / 1024.f) + EPS);
        if (lane == 0) { rstd[t] = rp0; rstd[T + t] = re0; rstd[t + 1] = rp1; rstd[T + t + 1] = re1; }
#pragma unroll
        for (int j = 0; j < 8; ++j) {
            const int n = lane * 4 + 256 * (j & 3); const size_t off = (size_t)(t + (j >> 2)) * 1024 + n; const float rp = (j >> 2) ? rp1 : rp0;
            const f32x4 gp = *(const f32x4*)(P.norm_post + n); f32x4 h;
#pragma unroll
            for (int e = 0; e < 4; ++e) h[e] = xv[j][e] + mv[j][e] * rp * gp[e];
            store_bf4(hb + off, h);
        }
    }
}
__device__ __forceinline__ void phase8(const Params& P, int bid, int nb, unsigned char* lds) {
    const int xcd = bid & 7, rank = bid >> 3, R = nb >> 3;
    const pg8::Gemm g{(const bf16_t*)(P.ws + OFF_HB), (const bf16_t*)(P.ws + OFF_WPG), 1024, 1024};
    const pg8::Order S{rank, R, 64, 4, 0, xcd * 16};
    const EpiFinal E{(const bf16_t*)(P.ws + OFF_HB), (const bf16_t*)(P.ws + OFF_ERAW), (const float*)(P.ws + OFF_RSTD), P.ple_norm, P.out};
    pg8::gemm_phase<EpiFinal, pg8::Order, true, true>((PG8_LAS unsigned char*)lds, g, S, E);
}

#define XB_TMO      128
#define XB_XCNT(j)  (256  + 64 * (j))
#define XB_XSUB(j)  (1280 + 64 * (j))
#define XB_XGEN(j)  (2304 + 64 * (j))
#define XB_TOP      3328
#define XB_TOPGEN   3392
#define XCD_BAR_WORDS 3456
#define XB_SPIN_CAP (1u << 20)
#define LAS __attribute__((address_space(3)))
__device__ __forceinline__ unsigned xb_ld(unsigned* p)              { return __hip_atomic_load(p, __ATOMIC_RELAXED, __HIP_MEMORY_SCOPE_AGENT); }
__device__ __forceinline__ unsigned xb_add(unsigned* p, unsigned v) { return __hip_atomic_fetch_add(p, v, __ATOMIC_RELAXED, __HIP_MEMORY_SCOPE_AGENT); }
__device__ __forceinline__ unsigned xb_xcc_id() { return (unsigned)__builtin_amdgcn_s_getreg((3 << 11) | 20) & 0xFu; }
#define XB_SPIN(cond, bar) do { unsigned _sp = 0; while (cond) { __builtin_amdgcn_s_sleep(1); \
    if ((++_sp & 255u) == 0u) { if (xb_ld(&(bar)[XB_TMO])) break; if (_sp > XB_SPIN_CAP) { atomicAdd(&(bar)[XB_TMO], 1u); break; } } } } while (0)
struct XcdBarrier { unsigned* bar; unsigned x; volatile LAS unsigned* st; };
__device__ __forceinline__ XcdBarrier xcd_barrier_post(unsigned* bar, volatile LAS unsigned* st) {
    XcdBarrier b; b.bar = bar; b.x = xb_xcc_id(); b.st = st;
    if (threadIdx.x == 0) (void)xb_add(&bar[XB_XCNT(b.x)], 1u);
    return b;
}
__device__ __forceinline__ void xcd_barrier_complete(unsigned* bar, unsigned x, unsigned& nloc, unsigned& nx) {
    const unsigned G = gridDim.x * gridDim.y * gridDim.z;
    unsigned sum, cnt, mine, sp = 0u;
    for (;;) {
        sum = 0u; cnt = 0u; mine = 0u;
#pragma unroll
        for (unsigned j = 0; j < 16; ++j) { const unsigned c = xb_ld(&bar[XB_XCNT(j)]); sum += c; cnt += (c > 0u) ? 1u : 0u; mine = (j == x) ? c : mine; }
        if (sum == G) break;
        __builtin_amdgcn_s_sleep(1);
        if ((++sp & 255u) == 0u) { if (xb_ld(&bar[XB_TMO])) break; if (sp > XB_SPIN_CAP) { atomicAdd(&bar[XB_TMO], 1u); break; } }
    }
    nloc = mine > 0u ? mine : 1u; nx = cnt > 0u ? cnt : 1u;
}
__device__ __forceinline__ void xcd_barrier(const XcdBarrier& b) {
    asm volatile("s_waitcnt vmcnt(0)" ::: "memory");
    __syncthreads();
    if (threadIdx.x == 0) {
        unsigned* bar = b.bar;
        __builtin_amdgcn_s_waitcnt(0);
        unsigned nloc = b.st[0], nx = b.st[1];
        if (nloc == 0u) { xcd_barrier_complete(bar, b.x, nloc, nx); b.st[0] = nloc; b.st[1] = nx; }
        const unsigned old = xb_add(&bar[XB_XSUB(b.x)], 1u);
        const unsigned gen = old / nloc;
        if (old + 1u == (gen + 1u) * nloc) {
            __builtin_amdgcn_fence(__ATOMIC_RELEASE, "agent");
            asm volatile("s_waitcnt vmcnt(0)" ::: "memory");
            const unsigned og = xb_add(&bar[XB_TOP], 1u);
            const unsigned tg = og / nx;
            if (og + 1u == (tg + 1u) * nx) xb_add(&bar[XB_TOPGEN], 1u);
            else XB_SPIN(xb_ld(&bar[XB_TOPGEN]) == tg, bar);
            __builtin_amdgcn_fence(__ATOMIC_ACQUIRE, "agent");
            xb_add(&bar[XB_XGEN(b.x)], 1u);
            asm volatile("s_waitcnt vmcnt(0)" ::: "memory");
        } else {
            XB_SPIN(xb_ld(&bar[XB_XGEN(b.x)]) == gen, bar);
            __builtin_amdgcn_fence(__ATOMIC_ACQUIRE, "agent");
            asm volatile("s_waitcnt vmcnt(0)" ::: "memory");
        }
    }
    __syncthreads();
}

extern __shared__ __attribute__((aligned(16))) unsigned char dyn_lds[];

#if MK_MULTI
__global__ void __launch_bounds__(512, 2) k_phase(Params P, int ph) {
    const int bid = blockIdx.x, nb = gridDim.x;
    switch (ph) {
        case 0: phase0(P, bid, nb, dyn_lds); break;
        case 1: phase1(P, bid, nb, dyn_lds); break;
        case 2: phase2(P, bid, nb, dyn_lds); break;
        case 3: phase3(P, bid, nb); break;
        case 4: phase4(P, bid, nb, dyn_lds); break;
        case 5: phase5(P, bid, nb, dyn_lds); break;
        case 6: phase6(P, bid, nb, dyn_lds); break;
        case 7: phase7(P, bid, nb); break;
        default: phase8(P, bid, nb, dyn_lds); break;
    }
}
#else
__global__ void __launch_bounds__(512, 2) k_mega(Params P) {
    __shared__ uint4 xb_words;
    if (threadIdx.x == 0) xb_words = make_uint4(0u, 0u, 0u, 0u);
    __syncthreads();
    const XcdBarrier xb = xcd_barrier_post((unsigned*)(P.ws + OFF_BAR), (volatile LAS unsigned*)&xb_words);
    const int bid = blockIdx.x, nb = gridDim.x;
#ifndef REP
#define REP -1
#endif
#define PH(n, call) do { call; xcd_barrier(xb); if (REP == n) { call; xcd_barrier(xb); } } while (0)
    PH(0, phase0(P, bid, nb, dyn_lds));
    PH(1, phase1(P, bid, nb, dyn_lds));
    PH(2, phase2(P, bid, nb, dyn_lds));
    PH(3, phase3(P, bid, nb));
    PH(4, phase4(P, bid, nb, dyn_lds));
    PH(5, phase5(P, bid, nb, dyn_lds));
    PH(6, phase6(P, bid, nb, dyn_lds));
    PH(7, phase7(P, bid, nb));
    phase8(P, bid, nb, dyn_lds);
    if (REP == 8) { xcd_barrier(xb); phase8(P, bid, nb, dyn_lds); }
}
#endif

extern "C" void kernel_launch(void* const* d_in, const int* in_sizes, int n_in, void* d_out, int out_size, void* d_ws, size_t ws_size, hipStream_t stream) {
    static int grid = 0;
    if (grid == 0) {
        if (n_in != 20 || ws_size < WS_END) { fprintf(stderr, "kernel_launch: unexpected n_in %d or ws_size %zu (< %zu)\n", n_in, ws_size, (size_t)WS_END); grid = -1; return; }
        int dev = 0, cus = 0, per_cu = 0;
        hipGetDevice(&dev); hipDeviceGetAttribute(&cus, hipDeviceAttributeMultiprocessorCount, dev);
#if MK_MULTI
        hipFuncSetAttribute((const void*)k_phase, hipFuncAttributeMaxDynamicSharedMemorySize, LDS_BYTES);
        hipOccupancyMaxActiveBlocksPerMultiprocessor(&per_cu, (const void*)k_phase, 512, LDS_BYTES);
#else
        hipFuncSetAttribute((const void*)k_mega, hipFuncAttributeMaxDynamicSharedMemorySize, LDS_BYTES);
        hipOccupancyMaxActiveBlocksPerMultiprocessor(&per_cu, (const void*)k_mega, 512, LDS_BYTES);
#endif
        if (per_cu < 1) per_cu = 1;
        if (per_cu > 1) per_cu = 1;
        grid = (cus * per_cu) & ~7;
        (void)hipGetLastError();
    }
    if (grid < 0) return;
    Params P{};
    const float** pp = (const float**)&P;
    for (int i = 0; i < 20; ++i) pp[i] = (const float*)d_in[i];
    P.out = (float*)d_out; P.ws = (unsigned char*)d_ws;
#if MK_MULTI
    for (int ph = 0; ph < 9; ++ph) hipLaunchKernelGGL(k_phase, dim3(grid), dim3(512), LDS_BYTES, stream, P, ph);
#else
    (void)hipMemsetAsync((unsigned char*)d_ws + OFF_BAR, 0, XCD_BAR_WORDS * 4, stream);
    void* args[] = {&P};
    hipError_t e = hipLaunchCooperativeKernel((const void*)k_mega, dim3(grid), dim3(512), args, LDS_BYTES, stream);
    if (e != hipSuccess) fprintf(stderr, "cooperative launch failed: %s (grid %d)\n", hipGetErrorString(e), grid);
#endif
}
```

```cpp
#include <hip/hip_runtime.h>
#include <hip/hip_cooperative_groups.h>
#include <stdint.h>
#include <stdio.h>
namespace cg = cooperative_groups;

#ifndef MK_MULTI
#define MK_MULTI 0
#endif

typedef unsigned short bf16_t;
typedef short bf16x8 __attribute__((ext_vector_type(8)));
typedef float f32x4 __attribute__((ext_vector_type(4)));
typedef unsigned u32x4 __attribute__((ext_vector_type(4)));
typedef unsigned u32x2 __attribute__((ext_vector_type(2)));

constexpr int T = 32768, DM = 1024, SEQ = 8192, DPLE = 256, DIN = 3072;
constexpr int LC = 64;
constexpr int NCH = T / LC;
constexpr int CPB = SEQ / LC;
constexpr int KU = LC * 16;
constexpr int NS = 256;
constexpr int KA = KU + NS;
constexpr float EPS = 1e-6f;

constexpr size_t MB = 1ull << 20;
constexpr size_t OFF_XN = 0;
constexpr size_t OFF_MIXIN = OFF_XN;
constexpr size_t OFF_PB = OFF_XN + 64 * MB;
constexpr size_t OFF_WIN = OFF_PB + 16 * MB;
constexpr size_t OFF_WGLU = OFF_WIN + 6 * MB;
constexpr size_t OFF_WOUT = OFF_WGLU + 1 * MB;
constexpr size_t OFF_WPLE = OFF_WOUT + 2 * MB;
constexpr size_t OFF_WPG = OFF_WPLE + 1 * MB;
constexpr size_t OFF_UA = OFF_WPG + 2 * MB;
constexpr size_t OFF_ZS = OFF_UA + 40 * MB;
constexpr size_t OFF_Q = OFF_ZS + 32 * MB;
constexpr size_t OFF_K = OFF_Q + 32 * MB;
constexpr size_t OFF_VT = OFF_K + 32 * MB;
constexpr size_t OFF_ZN = OFF_VT + 32 * MB;
constexpr size_t OFF_MIX = OFF_Q;
constexpr size_t OFF_HB = OFF_VT;
constexpr size_t OFF_LAM = OFF_ZN + 32 * MB;
constexpr size_t OFF_BBAR = OFF_LAM + 3 * MB;
constexpr size_t OFF_KTAB = OFF_BBAR + 1 * MB;
constexpr size_t OFF_TQ = OFF_KTAB + 4 * MB;
constexpr size_t OFF_ERAW = OFF_TQ;
constexpr size_t OFF_PM = OFF_TQ + 80 * MB;
constexpr size_t OFF_S = OFF_PM + 16 * MB;
constexpr size_t OFF_YS = OFF_S + 16 * MB;
constexpr size_t OFF_SS = OFF_YS + 32 * MB;
constexpr size_t OFF_ESS = OFF_SS + 2 * MB;
constexpr size_t OFF_RSTD = OFF_ESS + 2 * MB;
constexpr size_t OFF_BAR = OFF_RSTD + 1 * MB;
constexpr size_t WS_END = OFF_BAR + 1 * MB;

#define TID ((int)(threadIdx.x & 255))
struct Params {
    const float *x, *p, *norm_pre, *norm_post, *w_in, *a_re, *a_im, *log_dt, *b_re, *b_im, *c_re, *c_im, *ssm_d, *w_glu, *b_glu, *rpb, *w_out, *w_ple, *ple_norm, *w_pg;
    float* out;
    unsigned char* ws;
};

__device__ __forceinline__ unsigned pk2(float lo, float hi) { unsigned r; asm("v_cvt_pk_bf16_f32 %0, %1, %2" : "=v"(r) : "v"(lo), "v"(hi)); return r; }
__device__ __forceinline__ float bflo(unsigned w) { return __uint_as_float(w << 16); }
__device__ __forceinline__ float bfhi(unsigned w) { return __uint_as_float(w & 0xffff0000u); }
__device__ __forceinline__ void store_bf4(bf16_t* p, f32x4 v) { u32x2 w; w.x = pk2(v[0], v[1]); w.y = pk2(v[2], v[3]); *(u32x2*)p = w; }
__device__ __forceinline__ f32x4 load_bf4(const bf16_t* p) { u32x2 w = *(const u32x2*)p; f32x4 v; v[0] = bflo(w.x); v[1] = bfhi(w.x); v[2] = bflo(w.y); v[3] = bfhi(w.y); return v; }
__device__ __forceinline__ float sigmoidf_(float v) { return 1.f / (1.f + __expf(-v)); }
__device__ __forceinline__ float gelu_tanh(float v) { const float u = 0.7978845608028654f * (v + 0.044715f * v * v * v); const float th = 1.f - 2.f / (__expf(2.f * u) + 1.f); return 0.5f * v * (1.f + th); }

constexpr int LDS_BYTES = 18 * 8192 + 2048;
namespace pg8 {
#define PG8_LAS __attribute__((address_space(3)))
constexpr int BM = 256, BK = 64, HALF = 128, HTB = HALF * BK * 2  , STAGE_BYTES = 8 * HTB;
__host__ __device__ __forceinline__ int lds_byte(int r, int c) { const int st = (r >> 4) * 2 + (c >> 5), rr = r & 15, cc = c & 31, ob = rr * 64 + cc * 2; return st * 1024 + (ob ^ (((ob >> 9) & 1) << 5)); }
__host__ __device__ __forceinline__ void stage_rc(int b, int& R, int& C) { const int st = b / 1024, sb = b % 1024, swz = sb ^ (((sb >> 9) & 1) << 5); R = (st >> 1) * 16 + swz / 64; C = (st & 1) * 32 + (swz % 64) / 2; }
__host__ __device__ __forceinline__ int perm32(int rho) { const int n = rho >> 4, i = rho & 15; return 8 * (i >> 2) + 4 * n + (i & 3); }
struct Unit { int pm, pn; };
struct Gemm { const bf16_t* A; const bf16_t* Bt; int lda, K; };
struct Order {
    int rank, R, n_x, nn, n0, m0;
    __device__ __forceinline__ bool next(int i, Unit& u) const { const int l = rank + R * i; if (l >= n_x) return false; u.pn = n0 + l % nn; u.pm = m0 + l / nn; return true; }
    __device__ __forceinline__ void a_ready(const Unit&) const {}
    __device__ __forceinline__ void done(const Unit&) const {}
};
template <class Epi, class Sched, bool ALIGN_EPI = false, bool SP2 = false>
__device__ __forceinline__ void gemm_phase(PG8_LAS unsigned char* lds, const Gemm g, const Sched& S, const Epi& E) {
    const int tid = threadIdx.x, wid = __builtin_amdgcn_readfirstlane(tid >> 6), lane = tid & 63, wr = wid >> 2, wc = wid & 3, fr = lane & 15, fq = lane >> 4;
    const int K = g.K, nt = K / BK;
    unsigned voffA[2], voffB[2];
#pragma unroll
    for (int i = 0; i < 2; ++i) { int R, C; stage_rc(tid * 16 + i * 8192, R, C); const int Rb = Epi::PERM ? ((R & ~31) + perm32(R & 31)) : R;
        voffA[i] = (unsigned)(R * g.lda + C) * 2u; voffB[i] = (unsigned)(Rb * K + C) * 2u; }
    const size_t kstep = (size_t)(BK * 2);
    const size_t hstep = (size_t)HALF * K * 2, hstepA = (size_t)HALF * g.lda * 2;
    const size_t tstep = 2 * hstep, tstepA = 2 * hstepA;
    const unsigned ldsw = (unsigned)wid * 1024u;
    const int aoff = lds_byte(wr * 64 + fr, fq * 8), boff = lds_byte(wc * 32 + fr, fq * 8);
#define PG8_SA(b, h) (((b) * 2 + (h)) * HTB)
#define PG8_SB(b, h) ((4 + (b) * 2 + (h)) * HTB)
#define PG8_STAGE(bufoff, gbase, voff) do { _Pragma("unroll") for (int _i = 0; _i < 2; ++_i) \
        __builtin_amdgcn_global_load_lds((const unsigned*)((const char*)(gbase) + (voff)[_i]), (PG8_LAS unsigned*)(lds + (bufoff) + ldsw + _i * 8192), 16, 0, 0); } while (0)
#define PG8_LDA(dst, b, h) do { _Pragma("unroll") for (int m = 0; m < 4; ++m) _Pragma("unroll") for (int k = 0; k < 2; ++k) dst[m][k] = *(const PG8_LAS bf16x8*)(lds + PG8_SA(b, h) + aoff + m * 2048 + k * 1024); } while (0)
#define PG8_LDB(dst, b, h) do { _Pragma("unroll") for (int n = 0; n < 2; ++n) _Pragma("unroll") for (int k = 0; k < 2; ++k) dst[n][k] = *(const PG8_LAS bf16x8*)(lds + PG8_SB(b, h) + boff + n * 2048 + k * 1024); } while (0)
#define PG8_MMA(ai, bj, At, Bt) do { __builtin_amdgcn_s_setprio(1); _Pragma("unroll") for (int m = 0; m < 4; ++m) _Pragma("unroll") for (int n = 0; n < 2; ++n) _Pragma("unroll") for (int k = 0; k < 2; ++k) \
        acc[ai][bj][m][n] = __builtin_amdgcn_mfma_f32_16x16x32_bf16(Bt[n][k], At[m][k], acc[ai][bj][m][n], 0, 0, 0); __builtin_amdgcn_s_setprio(0); } while (0)
#define PG8_WAIT_V(n) asm volatile("s_waitcnt vmcnt(" #n ")" ::: "memory")
#define PG8_WAIT_L(n) asm volatile("s_waitcnt lgkmcnt(" #n ")" ::: "memory")
#define PG8_BAR __builtin_amdgcn_s_barrier()
#define PG8_SCHED __builtin_amdgcn_sched_barrier(0)
    Unit cur, nxt; int ui = 0;
    if (!S.next(0, cur)) return;
    f32x4 acc[2][2][4][2];
#pragma unroll
    for (int a = 0; a < 2; ++a)
#pragma unroll
        for (int b = 0; b < 2; ++b)
#pragma unroll
            for (int m = 0; m < 4; ++m)
#pragma unroll
                for (int n = 0; n < 2; ++n) acc[a][b][m][n] = (f32x4){0.f, 0.f, 0.f, 0.f};
    bf16x8 At[4][2], B0[2][2], B1[2][2];
    const char* cA = (const char*)g.A + (size_t)cur.pm * tstepA; const char* cB = (const char*)g.Bt + (size_t)cur.pn * tstep;
    S.a_ready(cur);
    if constexpr (SP2) {
        PG8_STAGE(PG8_SB(0, 0), cB, voffB); PG8_STAGE(PG8_SB(0, 1), cB + hstep, voffB); PG8_STAGE(PG8_SA(0, 0), cA, voffA); PG8_STAGE(PG8_SA(0, 1), cA + hstepA, voffA);
        if (wr == 1) PG8_BAR;
        PG8_WAIT_V(2); PG8_BAR;
        PG8_STAGE(PG8_SB(1, 0), cB + kstep, voffB); PG8_STAGE(PG8_SA(1, 0), cA + kstep, voffA); PG8_STAGE(PG8_SB(1, 1), cB + hstep + kstep, voffB);
        PG8_WAIT_V(6); PG8_BAR;
    } else {
        PG8_STAGE(PG8_SB(0, 0), cB, voffB); PG8_STAGE(PG8_SA(0, 0), cA, voffA); PG8_STAGE(PG8_SB(0, 1), cB + hstep, voffB); PG8_STAGE(PG8_SA(0, 1), cA + hstepA, voffA);
        if (wr == 1) PG8_BAR;
        PG8_WAIT_V(4); PG8_BAR;
        PG8_STAGE(PG8_SB(1, 0), cB + kstep, voffB); PG8_STAGE(PG8_SA(1, 0), cA + kstep, voffA); PG8_STAGE(PG8_SB(1, 1), cB + hstep + kstep, voffB);
        PG8_WAIT_V(6); PG8_BAR;
    }
    for (;;) {
        const bool has_next = S.next(ui + 1, nxt);
        const char* nA = has_next ? (const char*)g.A + (size_t)nxt.pm * tstepA : cA; const char* nB = has_next ? (const char*)g.Bt + (size_t)nxt.pn * tstep : cB;
        for (int t = 0; t < nt; t += 2) {
            const bool last = (t == nt - 2);
            const char* a1 = cA + (size_t)(t + 1) * kstep;
            const char* a2 = last ? nA : cA + (size_t)(t + 2) * kstep; const char* b2 = last ? nB : cB + (size_t)(t + 2) * kstep;
            const char* a3 = a2 + kstep; const char* b3 = b2 + kstep;
            if (last && has_next) S.a_ready(nxt);
            if constexpr (SP2) {
            PG8_LDB(B0, 0, 0); PG8_LDB(B1, 0, 1); PG8_SCHED; PG8_LDA(At, 0, 0); PG8_STAGE(PG8_SA(1, 1), a1 + hstepA, voffA);
            PG8_WAIT_V(8); PG8_WAIT_L(0); PG8_BAR; PG8_MMA(0, 0, At, B0); PG8_MMA(0, 1, At, B1); PG8_BAR; PG8_SCHED;
            PG8_LDA(At, 0, 1); PG8_STAGE(PG8_SB(0, 0), b2, voffB); PG8_STAGE(PG8_SB(0, 1), b2 + hstep, voffB); PG8_STAGE(PG8_SA(0, 0), a2, voffA);
            PG8_WAIT_V(8); PG8_WAIT_L(0); PG8_BAR; PG8_MMA(1, 0, At, B0); PG8_MMA(1, 1, At, B1); PG8_BAR; PG8_SCHED;
            PG8_LDB(B0, 1, 0); PG8_LDB(B1, 1, 1); PG8_SCHED; PG8_LDA(At, 1, 0); PG8_STAGE(PG8_SA(0, 1), a2 + hstepA, voffA);
            PG8_WAIT_V(8); PG8_WAIT_L(0); PG8_BAR; PG8_MMA(0, 0, At, B0); PG8_MMA(0, 1, At, B1); PG8_BAR; PG8_SCHED;
            PG8_LDA(At, 1, 1); PG8_STAGE(PG8_SB(1, 0), b3, voffB); PG8_STAGE(PG8_SB(1, 1), b3 + hstep, voffB); PG8_STAGE(PG8_SA(1, 0), a3, voffA);
            PG8_WAIT_V(8); PG8_WAIT_L(0); PG8_BAR; PG8_MMA(1, 0, At, B0); PG8_MMA(1, 1, At, B1); PG8_BAR; PG8_SCHED;
            } else {
            PG8_LDB(B0, 0, 0); PG8_SCHED; PG8_LDA(At, 0, 0); PG8_STAGE(PG8_SA(1, 1), a1 + hstepA, voffA);
            PG8_WAIT_L(8); PG8_BAR; PG8_WAIT_L(0); PG8_MMA(0, 0, At, B0); PG8_BAR; PG8_SCHED;
            PG8_LDB(B1, 0, 1); PG8_STAGE(PG8_SB(0, 0), b2, voffB);
            PG8_BAR; PG8_WAIT_L(0); PG8_MMA(0, 1, At, B1); PG8_BAR;
            PG8_LDA(At, 0, 1); PG8_STAGE(PG8_SA(0, 0), a2, voffA);
            PG8_BAR; PG8_WAIT_L(0); PG8_MMA(1, 0, At, B0); PG8_BAR; PG8_SCHED;
            PG8_STAGE(PG8_SB(0, 1), b2 + hstep, voffB);
            PG8_WAIT_V(6); PG8_BAR; PG8_MMA(1, 1, At, B1); PG8_BAR;
            PG8_LDB(B0, 1, 0); PG8_SCHED; PG8_LDA(At, 1, 0); PG8_STAGE(PG8_SA(0, 1), a2 + hstepA, voffA);
            PG8_WAIT_L(8); PG8_BAR; PG8_WAIT_L(0); PG8_MMA(0, 0, At, B0); PG8_BAR; PG8_SCHED;
            PG8_LDB(B1, 1, 1); PG8_STAGE(PG8_SB(1, 0), b3, voffB);
            PG8_BAR; PG8_WAIT_L(0); PG8_MMA(0, 1, At, B1); PG8_BAR;
            PG8_LDA(At, 1, 1); PG8_STAGE(PG8_SA(1, 0), a3, voffA);
            PG8_BAR; PG8_WAIT_L(0); PG8_MMA(1, 0, At, B0); PG8_BAR; PG8_SCHED;
            PG8_STAGE(PG8_SB(1, 1), b3 + hstep, voffB);
            PG8_WAIT_V(6); PG8_BAR; PG8_MMA(1, 1, At, B1); PG8_BAR;
            }
        }
        if constexpr (ALIGN_EPI) { if (wr == 0) PG8_BAR; }
        if constexpr (!Epi::AFTER_DRAIN) { E(acc, cur, wr, wc, fr, fq); S.done(cur); }
        if (!has_next) break;
#pragma unroll
        for (int a = 0; a < 2; ++a)
#pragma unroll
            for (int b = 0; b < 2; ++b)
#pragma unroll
                for (int m = 0; m < 4; ++m)
#pragma unroll
                    for (int n = 0; n < 2; ++n) acc[a][b][m][n] = (f32x4){0.f, 0.f, 0.f, 0.f};
        cur = nxt; cA = nA; cB = nB; ++ui;
        if constexpr (ALIGN_EPI) { if (wr == 1) PG8_BAR; }
    }
    PG8_WAIT_V(0);
    if constexpr (!ALIGN_EPI) { if (wr == 0) PG8_BAR; }
    PG8_BAR;
    if constexpr (Epi::AFTER_DRAIN) { E.fused(acc, cur, wr, wc, fr, fq, lds, wid, lane); S.done(cur); }
#undef PG8_SA
#undef PG8_SB
#undef PG8_STAGE
#undef PG8_LDA
#undef PG8_LDB
#undef PG8_MMA
#undef PG8_WAIT_V
#undef PG8_WAIT_L
#undef PG8_BAR
#undef PG8_SCHED
}
}

#define EPI_ROWS(...) _Pragma("unroll") for (int ai = 0; ai < 2; ++ai) _Pragma("unroll") for (int m = 0; m < 4; ++m) { const int row = u.pm * 256 + ai * 128 + wr * 64 + m * 16 + fr; __VA_ARGS__ asm volatile("" ::: "memory"); }
#define EPI_COLS(...) _Pragma("unroll") for (int bj = 0; bj < 2; ++bj) _Pragma("unroll") for (int n = 0; n < 2; ++n) { const int col = u.pn * 256 + bj * 128 + wc * 32 + n * 16 + fq * 4; const f32x4 v = acc[ai][bj][m][n]; __VA_ARGS__ }
typedef f32x4 acc_t[2][2][4][2];
struct EpiInProj {
    static constexpr bool PERM = false, AFTER_DRAIN = false;
    unsigned char* ws;
    __device__ __forceinline__ void operator()(const acc_t& acc, const pg8::Unit& u, int wr, int wc, int fr, int fq) const {
        const int sec = (u.pn * 256) >> 9;
        EPI_ROWS( const int t = row; EPI_COLS( const int nn = col & 511;
            if (sec == 0) { const int g = nn >> 4, hh = nn & 15, ch = t / LC, j = t % LC; store_bf4((bf16_t*)(ws + OFF_UA) + ((size_t)(g * NCH + ch)) * KA + j * 16 + hh, v); }
            else if (sec == 1) store_bf4((bf16_t*)(ws + OFF_ZS) + (size_t)t * 512 + nn, v);
            else if (sec == 2) store_bf4((bf16_t*)(ws + OFF_Q) + (size_t)t * 512 + nn, v * 0.125f);
            else if (sec == 3) store_bf4((bf16_t*)(ws + OFF_K) + (size_t)t * 512 + nn, v);
            else if (sec == 4) { const int b = t >> 13, l = t & 8191; bf16_t* vt = (bf16_t*)(ws + OFF_VT) + ((size_t)(b * 512 + nn)) * SEQ + l; const unsigned w0 = pk2(v[0], v[1]), w1 = pk2(v[2], v[3]);
                vt[0] = (bf16_t)(w0 & 0xffff); vt[SEQ] = (bf16_t)(w0 >> 16); vt[2 * SEQ] = (bf16_t)(w1 & 0xffff); vt[3 * SEQ] = (bf16_t)(w1 >> 16); }
            else store_bf4((bf16_t*)(ws + OFF_ZN) + (size_t)t * 512 + nn, v); ) )
    }
};
struct EpiS {
    static constexpr bool PERM = false, AFTER_DRAIN = false;
    float* S;
    __device__ __forceinline__ void operator()(const acc_t& acc, const pg8::Unit& u, int wr, int wc, int fr, int fq) const {
        EPI_ROWS( EPI_COLS( *(f32x4*)(S + (size_t)row * NS + col) = v; ) )
    }
};
struct EpiY {
    static constexpr bool PERM = false, AFTER_DRAIN = false;
    bf16_t* ys; int g;
    __device__ __forceinline__ void operator()(const acc_t& acc, const pg8::Unit& u, int wr, int wc, int fr, int fq) const {
        EPI_ROWS( EPI_COLS( const int i = col >> 4, h = col & 15; f32x4 o;
            _Pragma("unroll") for (int e = 0; e < 4; ++e) o[e] = gelu_tanh(v[e]);
            store_bf4(ys + ((size_t)row * LC + i) * 512 + g * 16 + h, o); ) )
    }
};
struct EpiGlu {
    static constexpr bool PERM = false, AFTER_DRAIN = false;
    const bf16_t* ys; const bf16_t* zs; const float* bglu; bf16_t* mixin;
    __device__ __forceinline__ void operator()(const acc_t& acc, const pg8::Unit& u, int wr, int wc, int fr, int fq) const {
        EPI_ROWS( EPI_COLS( const f32x4 bv = *(const f32x4*)(bglu + col);
            const f32x4 y = load_bf4(ys + (size_t)row * 512 + col), z = load_bf4(zs + (size_t)row * 512 + col); f32x4 o;
            _Pragma("unroll") for (int e = 0; e < 4; ++e) o[e] = y[e] * sigmoidf_(v[e] + bv[e]) * z[e] * sigmoidf_(z[e]);
            store_bf4(mixin + (size_t)row * 1024 + col, o); ) )
    }
};
struct EpiStoreSS {
    static constexpr bool PERM = false, AFTER_DRAIN = false;
    bf16_t* dst; float* ss;
    __device__ __forceinline__ void operator()(const acc_t& acc, const pg8::Unit& u, int wr, int wc, int fr, int fq) const {
        EPI_ROWS( float s = 0.f;
            EPI_COLS( s += (v[0] * v[0] + v[1] * v[1]) + (v[2] * v[2] + v[3] * v[3]); store_bf4(dst + (size_t)row * 1024 + col, v); )
            s += __shfl_xor(s, 16); s += __shfl_xor(s, 32);
            if (fq == 0) ss[(size_t)row * 16 + u.pn * 4 + wc] = s; )
    }
};
struct EpiFinal {
    static constexpr bool PERM = false, AFTER_DRAIN = false;
    const bf16_t* hb; const bf16_t* eraw; const float* rstd; const float* gple; float* out;
    __device__ __forceinline__ void operator()(const acc_t& acc, const pg8::Unit& u, int wr, int wc, int fr, int fq) const {
        EPI_ROWS( const float re = rstd[T + row];
            EPI_COLS( const size_t off = (size_t)row * 1024 + col;
                const f32x4 ge = *(const f32x4*)(gple + col), hv = load_bf4(hb + off), ev = load_bf4(eraw + off); f32x4 o;
                _Pragma("unroll") for (int e = 0; e < 4; ++e) o[e] = hv[e] + sigmoidf_(v[e]) * (ev[e] * re * ge[e]);
                *(f32x4*)(out + off) = o; ) )
    }
};

__device__ __forceinline__ void ktab_unit(const Params& P, int u, float* ldsf) {
    const int dir = u >> 8, g = (u >> 3) & 31, mr = u & 7, tid = TID;
    float2* lp = (float2*)ldsf;
    float2* bb = lp + 64 * 65;
    float2* cc = bb + 64 * 16;
    float2* lampow = (float2*)(P.ws + OFF_LAM); float2* bbar = (float2*)(P.ws + OFF_BBAR); float* ktab = (float*)(P.ws + OFF_KTAB);
    if (tid < 64) {
        const int p = tid, idx = (dir * 32 + g) * 64 + p;
        const float ar = P.a_re[idx], ai = P.a_im[idx], dt = expf(P.log_dt[dir * 32 + g]);
        const float mag = expf(dt * ar), ang = dt * ai; const float lr = mag * cosf(ang), li = mag * sinf(ang);
        const float nr = lr - 1.f, ni = li, den = ar * ar + ai * ai;
        const float cr = (nr * ar + ni * ai) / den, ci = (ni * ar - nr * ai) / den;
        float brv[16], biv[16];
#pragma unroll
        for (int h = 0; h < 16; ++h) { brv[h] = P.b_re[idx * 16 + h]; biv[h] = P.b_im[idx * 16 + h]; }
        float pr = 1.f, pi = 0.f;
        for (int m = 0; m <= 64; ++m) { lp[p * 65 + m] = make_float2(pr, pi); if (mr == 0) lampow[(size_t)idx * 65 + m] = make_float2(pr, pi); const float tt = pr * lr - pi * li; pi = pr * li + pi * lr; pr = tt; }
#pragma unroll
        for (int h = 0; h < 16; ++h) { const float2 v = make_float2(cr * brv[h] - ci * biv[h], cr * biv[h] + ci * brv[h]); bb[p * 16 + h] = v; if (mr == 0) bbar[(size_t)idx * 16 + h] = v; }
    }
#pragma unroll
    for (int i = 0; i < 4; ++i) { const int e = tid + 256 * i; cc[(e >> 6) * 65 + (e & 63)] = make_float2(P.c_re[(dir * 32 + g) * 1024 + e], P.c_im[(dir * 32 + g) * 1024 + e]); }
    __syncthreads();
    const int h = tid >> 4, h2 = tid & 15;
    float s[8];
#pragma unroll
    for (int mm = 0; mm < 8; ++mm) s[mm] = 0.f;
    for (int p = 0; p < 64; ++p) {
        const float2 c = cc[h * 65 + p], b = bb[p * 16 + h2];
        const float cbx = c.x * b.x - c.y * b.y, cby = c.x * b.y + c.y * b.x;
#pragma unroll
        for (int mm = 0; mm < 8; ++mm) { const float2 l = lp[p * 65 + mr * 8 + mm]; s[mm] += cbx * l.x - cby * l.y; }
    }
#pragma unroll
    for (int mm = 0; mm < 8; ++mm) ktab[((size_t)((dir * 32 + g) * 64 + mr * 8 + mm)) * 256 + h * 16 + h2] = s[mm];
    __syncthreads();
}
__device__ __forceinline__ void transpose_unit(const float* W, int K, int N, const float* gain, bf16_t* Wt, int item, float* ldsf) {
    const int nblk = N / 64, kb = item / nblk, nbk = item % nblk, k0 = kb * 64, n0 = nbk * 64, tid = TID;
#pragma unroll 4
    for (int i = 0; i < 16; ++i) { const int kk = i * 4 + (tid >> 6), nn = tid & 63; float v = W[(size_t)(k0 + kk) * N + n0 + nn]; if (gain) v *= gain[k0 + kk]; ldsf[kk * 65 + nn] = v; }
    __syncthreads();
#pragma unroll 4
    for (int i = 0; i < 8; ++i) { const int nn = i * 8 + (tid >> 5), kk = (tid & 31) * 2; *(unsigned*)(Wt + (size_t)(n0 + nn) * K + k0 + kk) = pk2(ldsf[kk * 65 + nn], ldsf[(kk + 1) * 65 + nn]); }
    __syncthreads();
}
__device__ __forceinline__ float wave_sum(float v) {
#pragma unroll
    for (int o = 1; o < 64; o <<= 1) v += __shfl_xor(v, o);
    return v;
}
__device__ __forceinline__ void phase0(const Params& P, int bid, int nb, unsigned char* lds) {
    float* ldsf = (float*)(lds + (threadIdx.x >> 8) * 65536);
    const int vb = bid * 2 + (threadIdx.x >> 8), nvb = nb * 2;
    constexpr int U_K = 512, I_IN = 16 * 48, I_GLU = 64, I_OUT = 256, I_PLE = 4 * 16, I_PG = 256, U_T = I_IN + I_GLU + I_OUT + I_PLE + I_PG, U_X = T / 8, U_P = (T * DPLE) / 2048;
    constexpr int NU = U_K + U_T + U_X + U_P;
    const int tid = TID, lane = tid & 63, wid = tid >> 6;
    for (int u = vb; u < NU; u += nvb) {
        int r = u;
        if (r < U_K) { ktab_unit(P, r, ldsf); continue; } r -= U_K;
        if (r < U_T) {
            if (r < I_IN) { transpose_unit(P.w_in, 1024, 3072, P.norm_pre, (bf16_t*)(P.ws + OFF_WIN), r, ldsf); continue; } r -= I_IN;
            if (r < I_GLU) { transpose_unit(P.w_glu, 512, 512, nullptr, (bf16_t*)(P.ws + OFF_WGLU), r, ldsf); continue; } r -= I_GLU;
            if (r < I_OUT) { transpose_unit(P.w_out, 1024, 1024, nullptr, (bf16_t*)(P.ws + OFF_WOUT), r, ldsf); continue; } r -= I_OUT;
            if (r < I_PLE) { transpose_unit(P.w_ple, 256, 1024, nullptr, (bf16_t*)(P.ws + OFF_WPLE), r, ldsf); continue; } r -= I_PLE;
            transpose_unit(P.w_pg, 1024, 1024, nullptr, (bf16_t*)(P.ws + OFF_WPG), r, ldsf); continue;
        }
        r -= U_T;
        if (r < U_X) {
            const int t = r * 8 + wid * 2; const f32x4* xr = (const f32x4*)(P.x + (size_t)t * 1024) + lane; f32x4 v[8]; float s0 = 0.f, s1 = 0.f;
#pragma unroll
            for (int j = 0; j < 8; ++j) v[j] = xr[64 * j];
#pragma unroll
            for (int j = 0; j < 4; ++j) { s0 += (v[j][0] * v[j][0] + v[j][1] * v[j][1]) + (v[j][2] * v[j][2] + v[j][3] * v[j][3]); s1 += (v[4 + j][0] * v[4 + j][0] + v[4 + j][1] * v[4 + j][1]) + (v[4 + j][2] * v[4 + j][2] + v[4 + j][3] * v[4 + j][3]); }
            const float rs0 = rsqrtf(wave_sum(s0) * (1.f / 1024.f) + EPS), rs1 = rsqrtf(wave_sum(s1) * (1.f / 1024.f) + EPS);
            bf16_t* o = (bf16_t*)(P.ws + OFF_XN) + (size_t)t * 1024 + lane * 4;
#pragma unroll
            for (int j = 0; j < 4; ++j) { store_bf4(o + 256 * j, v[j] * rs0); store_bf4(o + 1024 + 256 * j, v[4 + j] * rs1); }
            continue;
        }
        r -= U_X;
        {
            const size_t e0 = (size_t)r * 2048 + tid * 8; const f32x4 a = *(const f32x4*)(P.p + e0), b = *(const f32x4*)(P.p + e0 + 4);
            u32x4 w; w.x = pk2(a[0], a[1]); w.y = pk2(a[2], a[3]); w.z = pk2(b[0], b[1]); w.w = pk2(b[2], b[3]);
            *(u32x4*)((bf16_t*)(P.ws + OFF_PB) + e0) = w;
        }
    }
}

__device__ __forceinline__ void tq_unit(const Params& P, int u) {
    static_assert(LC == 64, "tq_unit / pm_unit thread maps assume 64-token chunks");
    const int g = u / LC, i = u % LC, tid = TID;
    const float* ktab = (const float*)(P.ws + OFF_KTAB); const float2* lampow = (const float2*)(P.ws + OFF_LAM); bf16_t* tq = (bf16_t*)(P.ws + OFF_TQ);
    const int h2 = (tid & 7) * 2;
#pragma unroll
    for (int half = 0; half < 2; ++half) {
        const int j = (tid >> 3) + 32 * half;
        const int ma = i > j ? i - j : 0, mb = j > i ? j - i : 0;
        const float wa = i >= j ? 1.f : 0.f, wb = j >= i ? 1.f : 0.f;
        const float* kf = ktab + ((size_t)((0 * 32 + g) * 64 + ma)) * 256 + h2; const float* kb = ktab + ((size_t)((1 * 32 + g) * 64 + mb)) * 256 + h2;
        float2 a[16], b[16];
#pragma unroll
        for (int h = 0; h < 16; ++h) { a[h] = *(const float2*)(kf + h * 16); b[h] = *(const float2*)(kb + h * 16); }
#pragma unroll
        for (int h = 0; h < 16; ++h) {
            float v0 = wa * a[h].x + wb * b[h].x, v1 = wa * a[h].y + wb * b[h].y;
            if (i == j) { const float dd = P.ssm_d[g * 16 + h]; v0 += (h == h2 ? dd : 0.f); v1 += (h == h2 + 1 ? dd : 0.f); }
            *(unsigned*)(tq + ((size_t)(g * KU + i * 16 + h)) * KA + j * 16 + h2) = pk2(v0, v1);
        }
    }
    {
        const int pn = tid & 127, dir = pn >> 6, p = pn & 63, m = dir == 0 ? i + 1 : LC - i;
        const float2 l = lampow[((size_t)((dir * 32 + g) * 64 + p)) * 65 + m];
        float cr[8], ci[8];
#pragma unroll
        for (int it = 0; it < 8; ++it) { const int h = it * 2 + (tid >> 7); cr[it] = P.c_re[((dir * 32 + g) * 16 + h) * 64 + p]; ci[it] = P.c_im[((dir * 32 + g) * 16 + h) * 64 + p]; }
#pragma unroll
        for (int it = 0; it < 8; ++it) { const int h = it * 2 + (tid >> 7);
            *(unsigned*)(tq + ((size_t)(g * KU + i * 16 + h)) * KA + KU + dir * 128 + p * 2) = pk2(cr[it] * l.x - ci[it] * l.y, -(cr[it] * l.y + ci[it] * l.x)); }
    }
}
__device__ __forceinline__ void pm_unit(const Params& P, int u) {
    const int g = u >> 4, rg = u & 15, tid = TID;
    const float2* lampow = (const float2*)(P.ws + OFF_LAM); const float2* bbar = (const float2*)(P.ws + OFF_BBAR); bf16_t* pm = (bf16_t*)(P.ws + OFF_PM);
    const int h2 = (tid & 7) * 2;
#pragma unroll 4
    for (int q = 0; q < 8; ++q) {
        const int pidx = rg * 8 + q, dir = pidx >> 6, p = pidx & 63;
        const f32x4 bq = *(const f32x4*)(bbar + ((size_t)((dir * 32 + g) * 64 + p)) * 16 + h2);
#pragma unroll
        for (int half = 0; half < 2; ++half) {
            const int j = (tid >> 3) + 32 * half, m = dir == 0 ? LC - 1 - j : j;
            const float2 l = lampow[((size_t)((dir * 32 + g) * 64 + p)) * 65 + m];
            bf16_t* dst = pm + ((size_t)(g * NS + 2 * pidx)) * KU + j * 16 + h2;
            *(unsigned*)dst = pk2(l.x * bq[0] - l.y * bq[1], l.x * bq[2] - l.y * bq[3]);
            *(unsigned*)(dst + KU) = pk2(l.x * bq[1] + l.y * bq[0], l.x * bq[3] + l.y * bq[2]);
        }
    }
}
__device__ __forceinline__ void phase1(const Params& P, int bid, int nb, unsigned char* lds) {
    constexpr int U_TQ = 32 * LC, U_PM = 32 * 16;
    const int xcd = bid & 7, rank = bid >> 3, R = nb >> 3;
    {
        const pg8::Gemm g{(const bf16_t*)(P.ws + OFF_XN), (const bf16_t*)(P.ws + OFF_WIN), 1024, 1024};
        const pg8::Order S{rank, R, 192, 6, (xcd & 1) * 6, (xcd >> 1) * 32}; const EpiInProj E{P.ws};
        pg8::gemm_phase<EpiInProj, pg8::Order, true, true>((PG8_LAS unsigned char*)lds, g, S, E);
    }
    const int vb = bid * 2 + (threadIdx.x >> 8), nvb = nb * 2;
    for (int u = vb; u < U_PM; u += nvb) pm_unit(P, u);
}

__device__ __forceinline__ void na_unit(const Params& P, int u, float* ldsf) {
    const int tid = TID, lane = tid & 63, cb = tid >> 6, fr = lane & 15, fq = lane >> 4;
    const int r = u & 127, head = (u >> 7) & 7, b = u >> 10;
    const bf16_t* q = (const bf16_t*)(P.ws + OFF_Q); const bf16_t* k = (const bf16_t*)(P.ws + OFF_K); const bf16_t* vt = (const bf16_t*)(P.ws + OFF_VT); const bf16_t* zn = (const bf16_t*)(P.ws + OFF_ZN);
    bf16_t* mixin = (bf16_t*)(P.ws + OFF_MIXIN);
    for (int i = tid; i < 15 * 31; i += 256) ldsf[i] = P.rpb[head * 15 * 31 + i];
    const int rs = min(max(r - 4, 0), 120);
    const int cw0 = cb == 0 ? 0 : (cb == 1 ? 8 : (cb == 2 ? 24 : 32));
    const int c = cb * 16 + fr, cs = min(max(c - 8, 0), 48);
    const size_t tq = (size_t)b * SEQ + r * 64 + c;
    const bf16x8 qf0 = *(const bf16x8*)(q + tq * 512 + head * 64 + fq * 8), qf1 = *(const bf16x8*)(q + tq * 512 + head * 64 + 32 + fq * 8);
    f32x4 s[16];
    const int kcol = cw0 + (fr >> 2) * 8 + (fr & 3);
    const bf16_t* kbase = k + ((size_t)b * SEQ + rs * 64 + kcol) * 512 + head * 64 + fq * 8;
#pragma unroll
    for (int hf = 0; hf < 2; ++hf) {
        bf16x8 k0[8], k1[8];
#pragma unroll
        for (int t = 0; t < 8; ++t) { const int tt = hf * 8 + t; const bf16_t* kp = kbase + ((size_t)(tt >> 1) * 64 + (tt & 1) * 4) * 512; k0[t] = *(const bf16x8*)kp; k1[t] = *(const bf16x8*)(kp + 32); }
#pragma unroll
        for (int t = 0; t < 8; ++t) {
            f32x4 z = (f32x4){0.f, 0.f, 0.f, 0.f};
            z = __builtin_amdgcn_mfma_f32_16x16x32_bf16(k0[t], qf0, z, 0, 0, 0);
            z = __builtin_amdgcn_mfma_f32_16x16x32_bf16(k1[t], qf1, z, 0, 0, 0);
            s[hf * 8 + t] = z;
        }
    }
    __syncthreads();
    float mx = -3.0e38f;
#pragma unroll
    for (int t = 0; t < 16; ++t) {
        const int i = t >> 1, odd = t & 1, dr = rs + i - r + 7;
#pragma unroll
        for (int e = 0; e < 4; ++e) {
            const int ck = cw0 + fq * 8 + odd * 4 + e; const bool valid = (ck >= cs) && (ck < cs + 16);
            const int dc = min(max(ck - c + 15, 0), 30);
            const float bv = ldsf[dr * 31 + dc];
            const float sv = valid ? s[t][e] + bv : -3.0e38f;
            s[t][e] = sv; mx = fmaxf(mx, sv);
        }
    }
    mx = fmaxf(mx, __shfl_xor(mx, 16)); mx = fmaxf(mx, __shfl_xor(mx, 32));
    float l = 0.f;
#pragma unroll
    for (int t = 0; t < 16; ++t)
#pragma unroll
        for (int e = 0; e < 4; ++e) { const float pv = __expf(s[t][e] - mx); s[t][e] = pv; l += pv; }
    l += __shfl_xor(l, 16); l += __shfl_xor(l, 32);
    f32x4 o[4];
#pragma unroll
    for (int dt = 0; dt < 4; ++dt) o[dt] = (f32x4){0.f, 0.f, 0.f, 0.f};
    const bf16_t* vbase = vt + ((size_t)(b * 512 + head * 64 + fr)) * SEQ + rs * 64 + cw0 + fq * 8;
#pragma unroll
    for (int k2 = 0; k2 < 4; ++k2) {
        bf16x8 vf[2][4];
#pragma unroll
        for (int kk = 0; kk < 2; ++kk)
#pragma unroll
            for (int dt = 0; dt < 4; ++dt) vf[kk][dt] = *(const bf16x8*)(vbase + (size_t)dt * 16 * SEQ + (k2 * 2 + kk) * 64);
#pragma unroll
        for (int kk = 0; kk < 2; ++kk) {
            const int kq = k2 * 2 + kk;
            u32x4 pw; pw.x = pk2(s[2 * kq][0], s[2 * kq][1]); pw.y = pk2(s[2 * kq][2], s[2 * kq][3]); pw.z = pk2(s[2 * kq + 1][0], s[2 * kq + 1][1]); pw.w = pk2(s[2 * kq + 1][2], s[2 * kq + 1][3]);
            const bf16x8 pf = __builtin_bit_cast(bf16x8, pw);
#pragma unroll
            for (int dt = 0; dt < 4; ++dt) o[dt] = __builtin_amdgcn_mfma_f32_16x16x32_bf16(vf[kk][dt], pf, o[dt], 0, 0, 0);
        }
    }
    const float inv = 1.f / l;
#pragma unroll
    for (int dt = 0; dt < 4; ++dt) {
        const int d0 = head * 64 + dt * 16 + fq * 4; const f32x4 z = load_bf4(zn + tq * 512 + d0); f32x4 ov;
#pragma unroll
        for (int e = 0; e < 4; ++e) ov[e] = o[dt][e] * inv * z[e] * sigmoidf_(z[e]);
        store_bf4(mixin + tq * 1024 + 512 + d0, ov);
    }
    __syncthreads();
}
constexpr int NA_KOFF = 0, NA_VOFF = 9 * 8192, NA_BOFF = 18 * 8192, NA_LDS = NA_BOFF + 2048;
__device__ __forceinline__ void na_block(const Params& P, int unit, unsigned char* lds) {
    const int tid = threadIdx.x, lane = tid & 63, w = tid >> 6, qrow = w >> 2, cb = w & 3, fr = lane & 15, fq = lane >> 4;
    const int seg = unit & 7, head = (unit >> 3) & 7, b = unit >> 6;
    const bf16_t* q = (const bf16_t*)(P.ws + OFF_Q); const bf16_t* k = (const bf16_t*)(P.ws + OFF_K); const bf16_t* vt = (const bf16_t*)(P.ws + OFF_VT); const bf16_t* zn = (const bf16_t*)(P.ws + OFF_ZN);
    bf16_t* mixin = (bf16_t*)(P.ws + OFF_MIXIN);
    float* bias = (float*)(lds + NA_BOFF);
    do { asm volatile("s_waitcnt vmcnt(0) lgkmcnt(0)" ::: "memory"); __syncthreads(); } while (0);
    for (int i = tid; i < 15 * 31; i += 512) bias[i] = P.rpb[head * 15 * 31 + i];
    const int st_r = tid >> 3, st_c = tid & 7;
    const int ksw = st_r * 128 + ((st_c ^ (((st_r >> 1) & 1) | (((st_r >> 3) & 3) << 1))) * 16);
    const int vsw = st_r * 128 + ((st_c ^ (st_r & 7)) * 16);
    const bf16_t* kst = k + ((size_t)b * SEQ + st_r) * 512 + head * 64 + st_c * 8;
    const bf16_t* vst = vt + ((size_t)(b * 512 + head * 64 + st_r)) * SEQ + st_c * 8;
    const int cw0 = cb == 0 ? 0 : (cb == 1 ? 8 : (cb == 2 ? 24 : 32));
    const int c = cb * 16 + fr, cs = min(max(c - 8, 0), 48);
    const int kcol = cw0 + (fr >> 2) * 8 + (fr & 3);
    const int sK = ((kcol >> 1) & 1) | (((kcol >> 3) & 3) << 1);
    const int kfo0 = kcol * 128 + ((fq ^ sK) * 16), kfo1 = kcol * 128 + (((4 + fq) ^ sK) * 16);
    const int vfo = fr * 128 + ((((cw0 >> 3) + fq) ^ (fr & 7)) * 16);
    int res_hi = -1;
    for (int p = 0; p < 8; ++p) {
        const int r0 = seg * 16 + 2 * p;
        const int lo = min(max(r0 - 4, 0), 120), hi = min(max(r0 - 3, 0), 120) + 7;
        const int first_new = max(lo, res_hi + 1);
        do { asm volatile("s_waitcnt vmcnt(0) lgkmcnt(0)" ::: "memory"); __syncthreads(); } while (0);
        for (int kr0 = first_new; kr0 <= hi; kr0 += 3) {
            u32x4 kv[3], vv[3];
#pragma unroll
            for (int j = 0; j < 3; ++j) { const int kr = min(kr0 + j, hi); kv[j] = *(const u32x4*)(kst + (size_t)kr * 64 * 512); vv[j] = *(const u32x4*)(vst + kr * 64); }
#pragma unroll
            for (int j = 0; j < 3; ++j) { const int slot = min(kr0 + j, hi) % 9; *(u32x4*)(lds + NA_KOFF + slot * 8192 + ksw) = kv[j]; *(u32x4*)(lds + NA_VOFF + slot * 8192 + vsw) = vv[j]; }
        }
        res_hi = hi;
        const int r = r0 + qrow, rs = min(max(r - 4, 0), 120);
        const size_t tq = (size_t)b * SEQ + r * 64 + c;
        const bf16x8 qf0 = *(const bf16x8*)(q + tq * 512 + head * 64 + fq * 8), qf1 = *(const bf16x8*)(q + tq * 512 + head * 64 + 32 + fq * 8);
        f32x4 zg[4];
#pragma unroll
        for (int dt = 0; dt < 4; ++dt) zg[dt] = load_bf4(zn + tq * 512 + head * 64 + dt * 16 + fq * 4);
        do { asm volatile("s_waitcnt vmcnt(0) lgkmcnt(0)" ::: "memory"); __syncthreads(); } while (0);
        f32x4 s[16];
#pragma unroll
        for (int t = 0; t < 16; ++t) {
            const int slot = (rs + (t >> 1)) % 9; const unsigned char* kb = lds + NA_KOFF + slot * 8192 + (t & 1) * 4 * 128;
            const bf16x8 k0 = *(const bf16x8*)(kb + kfo0), k1 = *(const bf16x8*)(kb + kfo1);
            f32x4 z = (f32x4){0.f, 0.f, 0.f, 0.f};
            z = __builtin_amdgcn_mfma_f32_16x16x32_bf16(k0, qf0, z, 0, 0, 0);
            z = __builtin_amdgcn_mfma_f32_16x16x32_bf16(k1, qf1, z, 0, 0, 0);
            s[t] = z;
        }
        float mx = -3.0e38f;
#pragma unroll
        for (int t = 0; t < 16; ++t) {
            const int i = t >> 1, odd = t & 1, dr = rs + i - r + 7;
#pragma unroll
            for (int e = 0; e < 4; ++e) {
                const int ck = cw0 + fq * 8 + odd * 4 + e; const bool valid = (ck >= cs) && (ck < cs + 16);
                const int dc = min(max(ck - c + 15, 0), 30);
                const float bv = bias[dr * 31 + dc];
                const float sv = valid ? s[t][e] + bv : -3.0e38f;
                s[t][e] = sv; mx = fmaxf(mx, sv);
            }
        }
        mx = fmaxf(mx, __shfl_xor(mx, 16)); mx = fmaxf(mx, __shfl_xor(mx, 32));
        float l = 0.f;
#pragma unroll
        for (int t = 0; t < 16; ++t)
#pragma unroll
            for (int e = 0; e < 4; ++e) { const float pv = __expf(s[t][e] - mx); s[t][e] = pv; l += pv; }
        l += __shfl_xor(l, 16); l += __shfl_xor(l, 32);
        f32x4 o[4];
#pragma unroll
        for (int dt = 0; dt < 4; ++dt) o[dt] = (f32x4){0.f, 0.f, 0.f, 0.f};
#pragma unroll
        for (int kq = 0; kq < 8; ++kq) {
            u32x4 pw; pw.x = pk2(s[2 * kq][0], s[2 * kq][1]); pw.y = pk2(s[2 * kq][2], s[2 * kq][3]); pw.z = pk2(s[2 * kq + 1][0], s[2 * kq + 1][1]); pw.w = pk2(s[2 * kq + 1][2], s[2 * kq + 1][3]);
            const bf16x8 pf = __builtin_bit_cast(bf16x8, pw);
            const unsigned char* vb = lds + NA_VOFF + ((rs + kq) % 9) * 8192 + vfo;
#pragma unroll
            for (int dt = 0; dt < 4; ++dt) { const bf16x8 vf = *(const bf16x8*)(vb + dt * 16 * 128); o[dt] = __builtin_amdgcn_mfma_f32_16x16x32_bf16(vf, pf, o[dt], 0, 0, 0); }
        }
        const float inv = 1.f / l;
#pragma unroll
        for (int dt = 0; dt < 4; ++dt) {
            const int d0 = head * 64 + dt * 16 + fq * 4; const f32x4 z = zg[dt]; f32x4 ov;
#pragma unroll
            for (int e = 0; e < 4; ++e) ov[e] = o[dt][e] * inv * z[e] * sigmoidf_(z[e]);
            store_bf4(mixin + tq * 1024 + 512 + d0, ov);
        }
        do { asm volatile("s_waitcnt vmcnt(0) lgkmcnt(0)" ::: "memory"); __syncthreads(); } while (0);
    }
    do { asm volatile("s_waitcnt vmcnt(0) lgkmcnt(0)" ::: "memory"); __syncthreads(); } while (0);
}
__device__ __forceinline__ void phase2(const Params& P, int bid, int nb, unsigned char* lds) {
    const int xcd = bid & 7, rank = bid >> 3, R = nb >> 3;
    for (int l = rank; l < 8; l += R) {
        const int mt = l & 1, g = xcd + 8 * (l >> 1);
        const pg8::Gemm gm{(const bf16_t*)(P.ws + OFF_UA) + (size_t)g * NCH * KA, (const bf16_t*)(P.ws + OFF_PM) + (size_t)g * NS * KU, KA, KU};
        const pg8::Order S{0, 1, 1, 1, 0, mt}; const EpiS E{(float*)(P.ws + OFF_S) + (size_t)g * NCH * NS};
        pg8::gemm_phase<EpiS, pg8::Order, true, true>((PG8_LAS unsigned char*)lds, gm, S, E);
    }
    for (int l = rank; l < 32; l += R) na_block(P, xcd * 32 + l, lds);
    if (R == 32 && rank >= 8) {
        const int j = xcd * 48 + (rank - 8) * 2 + (threadIdx.x >> 8);
        for (int u = j; u < 1024; u += 384) tq_unit(P, u);
    }
}

__device__ __forceinline__ void phase3(const Params& P, int bid, int nb) {
    const float2* lampow = (const float2*)(P.ws + OFF_LAM); const float2* S = (const float2*)(P.ws + OFF_S); bf16_t* ua = (bf16_t*)(P.ws + OFF_UA);
    const int vb = bid * 2 + (threadIdx.x >> 8), nvb = nb * 2;
    if (nvb == 512 && vb >= 64) {
        for (int u = 1024 + (vb - 64); u < 32 * LC; u += 448) tq_unit(P, u);
        return;
    }
    if (nvb != 512) { for (int u = vb; u < 32 * LC; u += nvb) tq_unit(P, u); }
    for (int sidx = vb * 256 + TID; sidx < 4 * 2 * 32 * 64; sidx += nvb * 256) {
        const int p = sidx & 63, g = (sidx >> 6) & 31, dir = (sidx >> 11) & 1, b = sidx >> 12;
        const float2 L = lampow[((size_t)((dir * 32 + g) * 64 + p)) * 65 + LC];
        float hr = 0.f, hi = 0.f;
        const float2* Sp = S + ((size_t)(g * NCH + b * CPB)) * (NS / 2) + dir * 64 + p;
        bf16_t* up = ua + ((size_t)(g * NCH + b * CPB)) * KA + KU + dir * 128 + p * 2;
        for (int cb0 = 0; cb0 < CPB; cb0 += 16) {
            float2 sv[16];
#pragma unroll
            for (int uu = 0; uu < 16; ++uu) { const int c = dir == 0 ? cb0 + uu : CPB - 1 - (cb0 + uu); sv[uu] = Sp[(size_t)c * (NS / 2)]; }
#pragma unroll
            for (int uu = 0; uu < 16; ++uu) {
                const int c = dir == 0 ? cb0 + uu : CPB - 1 - (cb0 + uu);
                *(unsigned*)(up + (size_t)c * KA) = pk2(hr, hi);
                const float tr = L.x * hr - L.y * hi + sv[uu].x; hi = L.x * hi + L.y * hr + sv[uu].y; hr = tr;
            }
        }
    }
}

__device__ __forceinline__ void phase4(const Params& P, int bid, int nb, unsigned char* lds) {
    const int xcd = bid & 7, rank = bid >> 3, R = nb >> 3;
    for (int l = rank; l < 32; l += R) {
        const int mt = l & 1, nt = (l >> 1) & 3, g = xcd + 8 * (l >> 3);
        const pg8::Gemm gm{(const bf16_t*)(P.ws + OFF_UA) + (size_t)g * NCH * KA, (const bf16_t*)(P.ws + OFF_TQ) + (size_t)g * KU * KA, KA, KA};
        const pg8::Order S{0, 1, 1, 1, nt, mt}; const EpiY E{(bf16_t*)(P.ws + OFF_YS), g};
        pg8::gemm_phase<EpiY, pg8::Order, true, true>((PG8_LAS unsigned char*)lds, gm, S, E);
    }
}
__device__ __forceinline__ void phase5(const Params& P, int bid, int nb, unsigned char* lds) {
    const int xcd = bid & 7, rank = bid >> 3, R = nb >> 3;
    const pg8::Gemm g{(const bf16_t*)(P.ws + OFF_YS), (const bf16_t*)(P.ws + OFF_WGLU), 512, 512};
    const pg8::Order S{rank, R, 32, 2, 0, xcd * 16};
    const EpiGlu E{(const bf16_t*)(P.ws + OFF_YS), (const bf16_t*)(P.ws + OFF_ZS), P.b_glu, (bf16_t*)(P.ws + OFF_MIXIN)};
    pg8::gemm_phase<EpiGlu, pg8::Order, true, true>((PG8_LAS unsigned char*)lds, g, S, E);
}
__device__ __forceinline__ void phase6(const Params& P, int bid, int nb, unsigned char* lds) {
    const int xcd = bid & 7, rank = bid >> 3, R = nb >> 3;
    const pg8::Order S{rank, R, 64, 4, 0, xcd * 16};
    {
        const pg8::Gemm g{(const bf16_t*)(P.ws + OFF_MIXIN), (const bf16_t*)(P.ws + OFF_WOUT), 1024, 1024};
        const EpiStoreSS E{(bf16_t*)(P.ws + OFF_MIX), (float*)(P.ws + OFF_SS)};
        pg8::gemm_phase<EpiStoreSS, pg8::Order, true, true>((PG8_LAS unsigned char*)lds, g, S, E);
    }
    {
        const pg8::Gemm g{(const bf16_t*)(P.ws + OFF_PB), (const bf16_t*)(P.ws + OFF_WPLE), 256, 256};
        const EpiStoreSS E{(bf16_t*)(P.ws + OFF_ERAW), (float*)(P.ws + OFF_ESS)};
        pg8::gemm_phase<EpiStoreSS, pg8::Order, true, true>((PG8_LAS unsigned char*)lds, g, S, E);
    }
}
__device__ __forceinline__ void phase7(const Params& P, int bid, int nb) {
    const int tid = TID, lane = tid & 63, wid = tid >> 6;
    const float* ss = (const float*)(P.ws + OFF_SS); const float* ess = (const float*)(P.ws + OFF_ESS); float* rstd = (float*)(P.ws + OFF_RSTD);
    const bf16_t* mix = (const bf16_t*)(P.ws + OFF_MIX); bf16_t* hb = (bf16_t*)(P.ws + OFF_HB);
    const int vb = bid * 2 + (threadIdx.x >> 8), nvb = nb * 2;
    for (int u = vb; u < T / 8; u += nvb) {
        const int t = u * 8 + wid * 2;
        const int tl = t + (lane >> 5), l5 = lane & 31;
        f32x4 xv[8], mv[8];
#pragma unroll
        for (int j = 0; j < 8; ++j) { const size_t off = (size_t)(t + (j >> 2)) * 1024 + lane * 4 + 256 * (j & 3); xv[j] = *(const f32x4*)(P.x + off); mv[j] = load_bf4(mix + off); }
        float v = l5 < 16 ? ss[(size_t)tl * 16 + l5] : ess[(size_t)tl * 16 + l5 - 16];
        v += __shfl_xor(v, 1); v += __shfl_xor(v, 2); v += __shfl_xor(v, 4); v += __shfl_xor(v, 8);
        const float rp0 = rsqrtf(__shfl(v, 0) * (1.f / 1024.f) + EPS), re0 = rsqrtf(__shfl(v, 16) * (1.f / 1024.f) + EPS);
        const float rp1 = rsqrtf(__shfl(v, 32) * (1.f / 1024.f) + EPS), re1 = rsqrtf(__shfl(v, 48) * (1.f / 1024.f) + EPS);
        if (lane == 0) { rstd[t] = rp0; rstd[T + t] = re0; rstd[t + 1] = rp1; rstd[T + t + 1] = re1; }
#pragma unroll
        for (int j = 0; j < 8; ++j) {
            const int n = lane * 4 + 256 * (j & 3); const size_t off = (size_t)(t + (j >> 2)) * 1024 + n; const float rp = (j >> 2) ? rp1 : rp0;
            const f32x4 gp = *(const f32x4*)(P.norm_post + n); f32x4 h;
#pragma unroll
            for (int e = 0; e < 4; ++e) h[e] = xv[j][e] + mv[j][e] * rp * gp[e];
            store_bf4(hb + off, h);
        }
    }
}
__device__ __forceinline__ void phase8(const Params& P, int bid, int nb, unsigned char* lds) {
    const int xcd = bid & 7, rank = bid >> 3, R = nb >> 3;
    const pg8::Gemm g{(const bf16_t*)(P.ws + OFF_HB), (const bf16_t*)(P.ws + OFF_WPG), 1024, 1024};
    const pg8::Order S{rank, R, 64, 4, 0, xcd * 16};
    const EpiFinal E{(const bf16_t*)(P.ws + OFF_HB), (const bf16_t*)(P.ws + OFF_ERAW), (const float*)(P.ws + OFF_RSTD), P.ple_norm, P.out};
    pg8::gemm_phase<EpiFinal, pg8::Order, true, true>((PG8_LAS unsigned char*)lds, g, S, E);
}

#define XB_TMO      128
#define XB_XCNT(j)  (256  + 64 * (j))
#define XB_XSUB(j)  (1280 + 64 * (j))
#define XB_XGEN(j)  (2304 + 64 * (j))
#define XB_TOP      3328
#define XB_TOPGEN   3392
#define XCD_BAR_WORDS 3456
#define XB_SPIN_CAP (1u << 20)
#define LAS __attribute__((address_space(3)))
__device__ __forceinline__ unsigned xb_ld(unsigned* p)              { return __hip_atomic_load(p, __ATOMIC_RELAXED, __HIP_MEMORY_SCOPE_AGENT); }
__device__ __forceinline__ unsigned xb_add(unsigned* p, unsigned v) { return __hip_atomic_fetch_add(p, v, __ATOMIC_RELAXED, __HIP_MEMORY_SCOPE_AGENT); }
__device__ __forceinline__ unsigned xb_xcc_id() { return (unsigned)__builtin_amdgcn_s_getreg((3 << 11) | 20) & 0xFu; }
#define XB_SPIN(cond, bar) do { unsigned _sp = 0; while (cond) { __builtin_amdgcn_s_sleep(1); \
    if ((++_sp & 255u) == 0u) { if (xb_ld(&(bar)[XB_TMO])) break; if (_sp > XB_SPIN_CAP) { atomicAdd(&(bar)[XB_TMO], 1u); break; } } } } while (0)
struct XcdBarrier { unsigned* bar; unsigned x; volatile LAS unsigned* st; };
__device__ __forceinline__ XcdBarrier xcd_barrier_post(unsigned* bar, volatile LAS unsigned* st) {
    XcdBarrier b; b.bar = bar; b.x = xb_xcc_id(); b.st = st;
    if (threadIdx.x == 0) (void)xb_add(&bar[XB_XCNT(b.x)], 1u);
    return b;
}
__device__ __forceinline__ void xcd_barrier_complete(unsigned* bar, unsigned x, unsigned& nloc, unsigned& nx) {
    const unsigned G = gridDim.x * gridDim.y * gridDim.z;
    unsigned sum, cnt, mine, sp = 0u;
    for (;;) {
        sum = 0u; cnt = 0u; mine = 0u;
#pragma unroll
        for (unsigned j = 0; j < 16; ++j) { const unsigned c = xb_ld(&bar[XB_XCNT(j)]); sum += c; cnt += (c > 0u) ? 1u : 0u; mine = (j == x) ? c : mine; }
        if (sum == G) break;
        __builtin_amdgcn_s_sleep(1);
        if ((++sp & 255u) == 0u) { if (xb_ld(&bar[XB_TMO])) break; if (sp > XB_SPIN_CAP) { atomicAdd(&bar[XB_TMO], 1u); break; } }
    }
    nloc = mine > 0u ? mine : 1u; nx = cnt > 0u ? cnt : 1u;
}
__device__ __forceinline__ void xcd_barrier(const XcdBarrier& b) {
    asm volatile("s_waitcnt vmcnt(0)" ::: "memory");
    __syncthreads();
    if (threadIdx.x == 0) {
        unsigned* bar = b.bar;
        __builtin_amdgcn_s_waitcnt(0);
        unsigned nloc = b.st[0], nx = b.st[1];
        if (nloc == 0u) { xcd_barrier_complete(bar, b.x, nloc, nx); b.st[0] = nloc; b.st[1] = nx; }
        const unsigned old = xb_add(&bar[XB_XSUB(b.x)], 1u);
        const unsigned gen = old / nloc;
        if (old + 1u == (gen + 1u) * nloc) {
            __builtin_amdgcn_fence(__ATOMIC_RELEASE, "agent");
            asm volatile("s_waitcnt vmcnt(0)" ::: "memory");
            const unsigned og = xb_add(&bar[XB_TOP], 1u);
            const unsigned tg = og / nx;
            if (og + 1u == (tg + 1u) * nx) xb_add(&bar[XB_TOPGEN], 1u);
            else XB_SPIN(xb_ld(&bar[XB_TOPGEN]) == tg, bar);
            __builtin_amdgcn_fence(__ATOMIC_ACQUIRE, "agent");
            xb_add(&bar[XB_XGEN(b.x)], 1u);
            asm volatile("s_waitcnt vmcnt(0)" ::: "memory");
        } else {
            XB_SPIN(xb_ld(&bar[XB_XGEN(b.x)]) == gen, bar);
            __builtin_amdgcn_fence(__ATOMIC_ACQUIRE, "agent");
            asm volatile("s_waitcnt vmcnt(0)" ::: "memory");
        }
    }
    __syncthreads();
}

extern __shared__ __attribute__((aligned(16))) unsigned char dyn_lds[];

#if MK_MULTI
__global__ void __launch_bounds__(512, 2) k_phase(Params P, int ph) {
    const int bid = blockIdx.x, nb = gridDim.x;
    switch (ph) {
        case 0: phase0(P, bid, nb, dyn_lds); break;
        case 1: phase1(P, bid, nb, dyn_lds); break;
        case 2: phase2(P, bid, nb, dyn_lds); break;
        case 3: phase3(P, bid, nb); break;
        case 4: phase4(P, bid, nb, dyn_lds); break;
        case 5: phase5(P, bid, nb, dyn_lds); break;
        case 6: phase6(P, bid, nb, dyn_lds); break;
        case 7: phase7(P, bid, nb); break;
        default: phase8(P, bid, nb, dyn_lds); break;
    }
}
#else
__global__ void __launch_bounds__(512, 2) k_mega(Params P) {
    __shared__ uint4 xb_words;
    if (threadIdx.x == 0) xb_words = make_uint4(0u, 0u, 0u, 0u);
    __syncthreads();
    const XcdBarrier xb = xcd_barrier_post((unsigned*)(P.ws + OFF_BAR), (volatile LAS unsigned*)&xb_words);
    const int bid = blockIdx.x, nb = gridDim.x;
#ifndef REP
#define REP -1
#endif
#define PH(n, call) do { call; xcd_barrier(xb); if (REP == n) { call; xcd_barrier(xb); } } while (0)
    PH(0, phase0(P, bid, nb, dyn_lds));
    PH(1, phase1(P, bid, nb, dyn_lds));
    PH(2, phase2(P, bid, nb, dyn_lds));
    PH(3, phase3(P, bid, nb));
    PH(4, phase4(P, bid, nb, dyn_lds));
    PH(5, phase5(P, bid, nb, dyn_lds));
    PH(6, phase6(P, bid, nb, dyn_lds));
    PH(7, phase7(P, bid, nb));
    phase8(P, bid, nb, dyn_lds);
    if (REP == 8) { xcd_barrier(xb); phase8(P, bid, nb, dyn_lds); }
}
#endif

extern "C" void kernel_launch(void* const* d_in, const int* in_sizes, int n_in, void* d_out, int out_size, void* d_ws, size_t ws_size, hipStream_t stream) {
    static int grid = 0;
    if (grid == 0) {
        if (n_in != 20 || ws_size < WS_END) { fprintf(stderr, "kernel_launch: unexpected n_in %d or ws_size %zu (< %zu)\n", n_in, ws_size, (size_t)WS_END); grid = -1; return; }
        int dev = 0, cus = 0, per_cu = 0;
        hipGetDevice(&dev); hipDeviceGetAttribute(&cus, hipDeviceAttributeMultiprocessorCount, dev);
#if MK_MULTI
        hipFuncSetAttribute((const void*)k_phase, hipFuncAttributeMaxDynamicSharedMemorySize, LDS_BYTES);
        hipOccupancyMaxActiveBlocksPerMultiprocessor(&per_cu, (const void*)k_phase, 512, LDS_BYTES);
#else
        hipFuncSetAttribute((const void*)k_mega, hipFuncAttributeMaxDynamicSharedMemorySize, LDS_BYTES);
        hipOccupancyMaxActiveBlocksPerMultiprocessor(&per_cu, (const void*)k_mega, 512, LDS_BYTES);
#endif
        if (per_cu < 1) per_cu = 1;
        if (per_cu > 1) per_cu = 1;
        grid = (cus * per_cu) & ~7;
        (void)hipGetLastError();
    }
    if (grid < 0) return;
    Params P{};
    const float** pp = (const float**)&P;
    for (int i = 0; i < 20; ++i) pp[i] = (const float*)d_in[i];
    P.out = (float*)d_out; P.ws = (unsigned char*)d_ws;
#if MK_MULTI
    for (int ph = 0; ph < 9; ++ph) hipLaunchKernelGGL(k_phase, dim3(grid), dim3(512), LDS_BYTES, stream, P, ph);
#else
    (void)hipMemsetAsync((unsigned char*)d_ws + OFF_BAR, 0, XCD_BAR_WORDS * 4, stream);
    void* args[] = {&P};
    hipError_t e = hipLaunchCooperativeKernel((const void*)k_mega, dim3(grid), dim3(512), args, LDS_BYTES, stream);
    if (e != hipSuccess) fprintf(stderr, "cooperative launch failed: %s (grid %d)\n", hipGetErrorString(e), grid);
#endif
}
```

```cpp
#include <hip/hip_runtime.h>
#include <hip/hip_cooperative_groups.h>
#include <stdint.h>
#include <stdio.h>
namespace cg = cooperative_groups;

#ifndef MK_MULTI
#define MK_MULTI 0
#endif

typedef unsigned short bf16_t;
typedef short bf16x8 __attribute__((ext_vector_type(8)));
typedef float f32x4 __attribute__((ext_vector_type(4)));
typedef unsigned u32x4 __attribute__((ext_vector_type(4)));
typedef unsigned u32x2 __attribute__((ext_vector_type(2)));

constexpr int T = 32768, DM = 1024, SEQ = 8192, DPLE = 256, DIN = 3072;
constexpr int LC = 64;
constexpr int NCH = T / LC;
constexpr int CPB = SEQ / LC;
constexpr int KU = LC * 16;
constexpr int NS = 256;
constexpr int KA = KU + NS;
constexpr float EPS = 1e-6f;

constexpr size_t MB = 1ull << 20;
constexpr size_t OFF_XN = 0;
constexpr size_t OFF_MIXIN = OFF_XN;
constexpr size_t OFF_PB = OFF_XN + 64 * MB;
constexpr size_t OFF_WIN = OFF_PB + 16 * MB;
constexpr size_t OFF_WGLU = OFF_WIN + 6 * MB;
constexpr size_t OFF_WOUT = OFF_WGLU + 1 * MB;
constexpr size_t OFF_WPLE = OFF_WOUT + 2 * MB;
constexpr size_t OFF_WPG = OFF_WPLE + 1 * MB;
constexpr size_t OFF_UA = OFF_WPG + 2 * MB;
constexpr size_t OFF_ZS = OFF_UA + 40 * MB;
constexpr size_t OFF_Q = OFF_ZS + 32 * MB;
constexpr size_t OFF_K = OFF_Q + 32 * MB;
constexpr size_t OFF_VT = OFF_K + 32 * MB;
constexpr size_t OFF_ZN = OFF_VT + 32 * MB;
constexpr size_t OFF_MIX = OFF_Q;
constexpr size_t OFF_HB = OFF_VT;
constexpr size_t OFF_LAM = OFF_ZN + 32 * MB;
constexpr size_t OFF_BBAR = OFF_LAM + 3 * MB;
constexpr size_t OFF_KTAB = OFF_BBAR + 1 * MB;
constexpr size_t OFF_TQ = OFF_KTAB + 4 * MB;
constexpr size_t OFF_ERAW = OFF_TQ;
constexpr size_t OFF_PM = OFF_TQ + 80 * MB;
constexpr size_t OFF_S = OFF_PM + 16 * MB;
constexpr size_t OFF_YS = OFF_S + 16 * MB;
constexpr size_t OFF_SS = OFF_YS + 32 * MB;
constexpr size_t OFF_ESS = OFF_SS + 2 * MB;
constexpr size_t OFF_RSTD = OFF_ESS + 2 * MB;
constexpr size_t OFF_BAR = OFF_RSTD + 1 * MB;
constexpr size_t WS_END = OFF_BAR + 1 * MB;

#define TID ((int)(threadIdx.x & 255))
struct Params {
    const float *x, *p, *norm_pre, *norm_post, *w_in, *a_re, *a_im, *log_dt, *b_re, *b_im, *c_re, *c_im, *ssm_d, *w_glu, *b_glu, *rpb, *w_out, *w_ple, *ple_norm, *w_pg;
    float* out;
    unsigned char* ws;
};

__device__ __forceinline__ unsigned pk2(float lo, float hi) { unsigned r; asm("v_cvt_pk_bf16_f32 %0, %1, %2" : "=v"(r) : "v"(lo), "v"(hi)); return r; }
__device__ __forceinline__ float bflo(unsigned w) { return __uint_as_float(w << 16); }
__device__ __forceinline__ float bfhi(unsigned w) { return __uint_as_float(w & 0xffff0000u); }
__device__ __forceinline__ void store_bf4(bf16_t* p, f32x4 v) { u32x2 w; w.x = pk2(v[0], v[1]); w.y = pk2(v[2], v[3]); *(u32x2*)p = w; }
__device__ __forceinline__ f32x4 load_bf4(const bf16_t* p) { u32x2 w = *(const u32x2*)p; f32x4 v; v[0] = bflo(w.x); v[1] = bfhi(w.x); v[2] = bflo(w.y); v[3] = bfhi(w.y); return v; }
__device__ __forceinline__ float sigmoidf_(float v) { return 1.f / (1.f + __expf(-v)); }
__device__ __forceinline__ float gelu_tanh(float v) { const float u = 0.7978845608028654f * (v + 0.044715f * v * v * v); const float th = 1.f - 2.f / (__expf(2.f * u) + 1.f); return 0.5f * v * (1.f + th); }

constexpr int LDS_BYTES = 18 * 8192 + 2048;
namespace pg8 {
#define PG8_LAS __attribute__((address_space(3)))
constexpr int BM = 256, BK = 64, HALF = 128, HTB = HALF * BK * 2  , STAGE_BYTES = 8 * HTB;
__host__ __device__ __forceinline__ int lds_byte(int r, int c) { const int st = (r >> 4) * 2 + (c >> 5), rr = r & 15, cc = c & 31, ob = rr * 64 + cc * 2; return st * 1024 + (ob ^ (((ob >> 9) & 1) << 5)); }
__host__ __device__ __forceinline__ void stage_rc(int b, int& R, int& C) { const int st = b / 1024, sb = b % 1024, swz = sb ^ (((sb >> 9) & 1) << 5); R = (st >> 1) * 16 + swz / 64; C = (st & 1) * 32 + (swz % 64) / 2; }
__host__ __device__ __forceinline__ int perm32(int rho) { const int n = rho >> 4, i = rho & 15; return 8 * (i >> 2) + 4 * n + (i & 3); }
struct Unit { int pm, pn; };
struct Gemm { const bf16_t* A; const bf16_t* Bt; int lda, K; };
struct Order {
    int rank, R, n_x, nn, n0, m0, ns;
    __device__ __forceinline__ bool next(int i, Unit& u) const { const int l = rank + R * i; if (l >= n_x) return false; u.pn = n0 + (l % nn) * ns; u.pm = m0 + l / nn; return true; }
    __device__ __forceinline__ void a_ready(const Unit&) const {}
    __device__ __forceinline__ void done(const Unit&) const {}
};
template <class Epi, class Sched, bool ALIGN_EPI = false, bool SP2 = false>
__device__ __forceinline__ void gemm_phase(PG8_LAS unsigned char* lds, const Gemm g, const Sched& S, const Epi& E) {
    const int tid = threadIdx.x, wid = __builtin_amdgcn_readfirstlane(tid >> 6), lane = tid & 63, wr = wid >> 2, wc = wid & 3, fr = lane & 15, fq = lane >> 4;
    const int K = g.K, nt = K / BK;
    unsigned voffA[2], voffB[2];
#pragma unroll
    for (int i = 0; i < 2; ++i) { int R, C; stage_rc(tid * 16 + i * 8192, R, C); const int Rb = Epi::PERM ? ((R & ~31) + perm32(R & 31)) : R;
        voffA[i] = (unsigned)(R * g.lda + C) * 2u; voffB[i] = (unsigned)(Rb * K + C) * 2u; }
    const size_t kstep = (size_t)(BK * 2);
    const size_t hstep = (size_t)HALF * K * 2, hstepA = (size_t)HALF * g.lda * 2;
    const size_t tstep = 2 * hstep, tstepA = 2 * hstepA;
    const unsigned ldsw = (unsigned)wid * 1024u;
    const int aoff = lds_byte(wr * 64 + fr, fq * 8), boff = lds_byte(wc * 32 + fr, fq * 8);
#define PG8_SA(b, h) (((b) * 2 + (h)) * HTB)
#define PG8_SB(b, h) ((4 + (b) * 2 + (h)) * HTB)
#define PG8_STAGE(bufoff, gbase, voff) do { _Pragma("unroll") for (int _i = 0; _i < 2; ++_i) \
        __builtin_amdgcn_global_load_lds((const unsigned*)((const char*)(gbase) + (voff)[_i]), (PG8_LAS unsigned*)(lds + (bufoff) + ldsw + _i * 8192), 16, 0, 0); } while (0)
#define PG8_LDA(dst, b, h) do { _Pragma("unroll") for (int m = 0; m < 4; ++m) _Pragma("unroll") for (int k = 0; k < 2; ++k) dst[m][k] = *(const PG8_LAS bf16x8*)(lds + PG8_SA(b, h) + aoff + m * 2048 + k * 1024); } while (0)
#define PG8_LDB(dst, b, h) do { _Pragma("unroll") for (int n = 0; n < 2; ++n) _Pragma("unroll") for (int k = 0; k < 2; ++k) dst[n][k] = *(const PG8_LAS bf16x8*)(lds + PG8_SB(b, h) + boff + n * 2048 + k * 1024); } while (0)
#define PG8_MMA(ai, bj, At, Bt) do { __builtin_amdgcn_s_setprio(1); _Pragma("unroll") for (int m = 0; m < 4; ++m) _Pragma("unroll") for (int n = 0; n < 2; ++n) _Pragma("unroll") for (int k = 0; k < 2; ++k) \
        acc[ai][bj][m][n] = __builtin_amdgcn_mfma_f32_16x16x32_bf16(Bt[n][k], At[m][k], acc[ai][bj][m][n], 0, 0, 0); __builtin_amdgcn_s_setprio(0); } while (0)
#define PG8_WAIT_V(n) asm volatile("s_waitcnt vmcnt(" #n ")" ::: "memory")
#define PG8_WAIT_L(n) asm volatile("s_waitcnt lgkmcnt(" #n ")" ::: "memory")
#define PG8_BAR __builtin_amdgcn_s_barrier()
#define PG8_SCHED __builtin_amdgcn_sched_barrier(0)
    Unit cur, nxt; int ui = 0;
    if (!S.next(0, cur)) return;
    f32x4 acc[2][2][4][2];
#pragma unroll
    for (int a = 0; a < 2; ++a)
#pragma unroll
        for (int b = 0; b < 2; ++b)
#pragma unroll
            for (int m = 0; m < 4; ++m)
#pragma unroll
                for (int n = 0; n < 2; ++n) acc[a][b][m][n] = (f32x4){0.f, 0.f, 0.f, 0.f};
    bf16x8 At[4][2], B0[2][2], B1[2][2];
    const char* cA = (const char*)g.A + (size_t)cur.pm * tstepA; const char* cB = (const char*)g.Bt + (size_t)cur.pn * tstep;
    S.a_ready(cur);
    if constexpr (SP2) {
        PG8_STAGE(PG8_SB(0, 0), cB, voffB); PG8_STAGE(PG8_SB(0, 1), cB + hstep, voffB); PG8_STAGE(PG8_SA(0, 0), cA, voffA); PG8_STAGE(PG8_SA(0, 1), cA + hstepA, voffA);
        if (wr == 1) PG8_BAR;
        PG8_WAIT_V(2); PG8_BAR;
        PG8_STAGE(PG8_SB(1, 0), cB + kstep, voffB); PG8_STAGE(PG8_SA(1, 0), cA + kstep, voffA); PG8_STAGE(PG8_SB(1, 1), cB + hstep + kstep, voffB);
        PG8_WAIT_V(6); PG8_BAR;
    } else {
        PG8_STAGE(PG8_SB(0, 0), cB, voffB); PG8_STAGE(PG8_SA(0, 0), cA, voffA); PG8_STAGE(PG8_SB(0, 1), cB + hstep, voffB); PG8_STAGE(PG8_SA(0, 1), cA + hstepA, voffA);
        if (wr == 1) PG8_BAR;
        PG8_WAIT_V(4); PG8_BAR;
        PG8_STAGE(PG8_SB(1, 0), cB + kstep, voffB); PG8_STAGE(PG8_SA(1, 0), cA + kstep, voffA); PG8_STAGE(PG8_SB(1, 1), cB + hstep + kstep, voffB);
        PG8_WAIT_V(6); PG8_BAR;
    }
    for (;;) {
        const bool has_next = S.next(ui + 1, nxt);
        const char* nA = has_next ? (const char*)g.A + (size_t)nxt.pm * tstepA : cA; const char* nB = has_next ? (const char*)g.Bt + (size_t)nxt.pn * tstep : cB;
        for (int t = 0; t < nt; t += 2) {
            const bool last = (t == nt - 2);
            const char* a1 = cA + (size_t)(t + 1) * kstep;
            const char* a2 = last ? nA : cA + (size_t)(t + 2) * kstep; const char* b2 = last ? nB : cB + (size_t)(t + 2) * kstep;
            const char* a3 = a2 + kstep; const char* b3 = b2 + kstep;
            if (last && has_next) S.a_ready(nxt);
            if constexpr (SP2) {
            PG8_LDB(B0, 0, 0); PG8_LDB(B1, 0, 1); PG8_SCHED; PG8_LDA(At, 0, 0); PG8_STAGE(PG8_SA(1, 1), a1 + hstepA, voffA);
            PG8_WAIT_V(8); PG8_WAIT_L(0); PG8_BAR; PG8_MMA(0, 0, At, B0); PG8_MMA(0, 1, At, B1); PG8_BAR; PG8_SCHED;
            PG8_LDA(At, 0, 1); PG8_STAGE(PG8_SB(0, 0), b2, voffB); PG8_STAGE(PG8_SB(0, 1), b2 + hstep, voffB); PG8_STAGE(PG8_SA(0, 0), a2, voffA);
            PG8_WAIT_V(8); PG8_WAIT_L(0); PG8_BAR; PG8_MMA(1, 0, At, B0); PG8_MMA(1, 1, At, B1); PG8_BAR; PG8_SCHED;
            PG8_LDB(B0, 1, 0); PG8_LDB(B1, 1, 1); PG8_SCHED; PG8_LDA(At, 1, 0); PG8_STAGE(PG8_SA(0, 1), a2 + hstepA, voffA);
            PG8_WAIT_V(8); PG8_WAIT_L(0); PG8_BAR; PG8_MMA(0, 0, At, B0); PG8_MMA(0, 1, At, B1); PG8_BAR; PG8_SCHED;
            PG8_LDA(At, 1, 1); PG8_STAGE(PG8_SB(1, 0), b3, voffB); PG8_STAGE(PG8_SB(1, 1), b3 + hstep, voffB); PG8_STAGE(PG8_SA(1, 0), a3, voffA);
            PG8_WAIT_V(8); PG8_WAIT_L(0); PG8_BAR; PG8_MMA(1, 0, At, B0); PG8_MMA(1, 1, At, B1); PG8_BAR; PG8_SCHED;
            } else {
            PG8_LDB(B0, 0, 0); PG8_SCHED; PG8_LDA(At, 0, 0); PG8_STAGE(PG8_SA(1, 1), a1 + hstepA, voffA);
            PG8_WAIT_L(8); PG8_BAR; PG8_WAIT_L(0); PG8_MMA(0, 0, At, B0); PG8_BAR; PG8_SCHED;
            PG8_LDB(B1, 0, 1); PG8_STAGE(PG8_SB(0, 0), b2, voffB);
            PG8_BAR; PG8_WAIT_L(0); PG8_MMA(0, 1, At, B1); PG8_BAR;
            PG8_LDA(At, 0, 1); PG8_STAGE(PG8_SA(0, 0), a2, voffA);
            PG8_BAR; PG8_WAIT_L(0); PG8_MMA(1, 0, At, B0); PG8_BAR; PG8_SCHED;
            PG8_STAGE(PG8_SB(0, 1), b2 + hstep, voffB);
            PG8_WAIT_V(6); PG8_BAR; PG8_MMA(1, 1, At, B1); PG8_BAR;
            PG8_LDB(B0, 1, 0); PG8_SCHED; PG8_LDA(At, 1, 0); PG8_STAGE(PG8_SA(0, 1), a2 + hstepA, voffA);
            PG8_WAIT_L(8); PG8_BAR; PG8_WAIT_L(0); PG8_MMA(0, 0, At, B0); PG8_BAR; PG8_SCHED;
            PG8_LDB(B1, 1, 1); PG8_STAGE(PG8_SB(1, 0), b3, voffB);
            PG8_BAR; PG8_WAIT_L(0); PG8_MMA(0, 1, At, B1); PG8_BAR;
            PG8_LDA(At, 1, 1); PG8_STAGE(PG8_SA(1, 0), a3, voffA);
            PG8_BAR; PG8_WAIT_L(0); PG8_MMA(1, 0, At, B0); PG8_BAR; PG8_SCHED;
            PG8_STAGE(PG8_SB(1, 1), b3 + hstep, voffB);
            PG8_WAIT_V(6); PG8_BAR; PG8_MMA(1, 1, At, B1); PG8_BAR;
            }
        }
        if constexpr (ALIGN_EPI) { if (wr == 0) PG8_BAR; }
        if constexpr (!Epi::AFTER_DRAIN) { E(acc, cur, wr, wc, fr, fq); S.done(cur); }
        if (!has_next) break;
#pragma unroll
        for (int a = 0; a < 2; ++a)
#pragma unroll
            for (int b = 0; b < 2; ++b)
#pragma unroll
                for (int m = 0; m < 4; ++m)
#pragma unroll
                    for (int n = 0; n < 2; ++n) acc[a][b][m][n] = (f32x4){0.f, 0.f, 0.f, 0.f};
        cur = nxt; cA = nA; cB = nB; ++ui;
        if constexpr (ALIGN_EPI) { if (wr == 1) PG8_BAR; }
    }
    PG8_WAIT_V(0);
    if constexpr (!ALIGN_EPI) { if (wr == 0) PG8_BAR; }
    PG8_BAR;
    if constexpr (Epi::AFTER_DRAIN) { E.fused(acc, cur, wr, wc, fr, fq, lds, wid, lane); S.done(cur); }
#undef PG8_SA
#undef PG8_SB
#undef PG8_STAGE
#undef PG8_LDA
#undef PG8_LDB
#undef PG8_MMA
#undef PG8_WAIT_V
#undef PG8_WAIT_L
#undef PG8_BAR
#undef PG8_SCHED
}
}

#define EPI_ROWS(...) _Pragma("unroll") for (int ai = 0; ai < 2; ++ai) _Pragma("unroll") for (int m = 0; m < 4; ++m) { const int row = u.pm * 256 + ai * 128 + wr * 64 + m * 16 + fr; __VA_ARGS__ asm volatile("" ::: "memory"); }
#define EPI_COLS(...) _Pragma("unroll") for (int bj = 0; bj < 2; ++bj) _Pragma("unroll") for (int n = 0; n < 2; ++n) { const int col = u.pn * 256 + bj * 128 + wc * 32 + n * 16 + fq * 4; const f32x4 v = acc[ai][bj][m][n]; __VA_ARGS__ }
typedef f32x4 acc_t[2][2][4][2];
struct EpiInProj {
    static constexpr bool PERM = false, AFTER_DRAIN = false;
    unsigned char* ws;
    __device__ __forceinline__ void operator()(const acc_t& acc, const pg8::Unit& u, int wr, int wc, int fr, int fq) const {
        const int sec = (u.pn * 256) >> 9;
        EPI_ROWS( const int t = row; EPI_COLS( const int nn = col & 511;
            if (sec == 0) { const int g = nn >> 4, hh = nn & 15, ch = t / LC, j = t % LC; store_bf4((bf16_t*)(ws + OFF_UA) + ((size_t)(g * NCH + ch)) * KA + j * 16 + hh, v); }
            else if (sec == 1) store_bf4((bf16_t*)(ws + OFF_ZS) + (size_t)t * 512 + nn, v);
            else if (sec == 2) store_bf4((bf16_t*)(ws + OFF_Q) + (size_t)t * 512 + nn, v * 0.125f);
            else if (sec == 3) store_bf4((bf16_t*)(ws + OFF_K) + (size_t)t * 512 + nn, v);
            else if (sec == 4) { const int b = t >> 13, l = t & 8191; bf16_t* vt = (bf16_t*)(ws + OFF_VT) + ((size_t)(b * 512 + nn)) * SEQ + l; const unsigned w0 = pk2(v[0], v[1]), w1 = pk2(v[2], v[3]);
                vt[0] = (bf16_t)(w0 & 0xffff); vt[SEQ] = (bf16_t)(w0 >> 16); vt[2 * SEQ] = (bf16_t)(w1 & 0xffff); vt[3 * SEQ] = (bf16_t)(w1 >> 16); }
            else store_bf4((bf16_t*)(ws + OFF_ZN) + (size_t)t * 512 + nn, v); ) )
    }
};
struct EpiS {
    static constexpr bool PERM = false, AFTER_DRAIN = false;
    float* S;
    __device__ __forceinline__ void operator()(const acc_t& acc, const pg8::Unit& u, int wr, int wc, int fr, int fq) const {
        EPI_ROWS( EPI_COLS( *(f32x4*)(S + (size_t)row * NS + col) = v; ) )
    }
};
struct EpiY {
    static constexpr bool PERM = false, AFTER_DRAIN = false;
    bf16_t* ys; int g;
    __device__ __forceinline__ void operator()(const acc_t& acc, const pg8::Unit& u, int wr, int wc, int fr, int fq) const {
        EPI_ROWS( EPI_COLS( const int i = col >> 4, h = col & 15; f32x4 o;
            _Pragma("unroll") for (int e = 0; e < 4; ++e) o[e] = gelu_tanh(v[e]);
            store_bf4(ys + ((size_t)row * LC + i) * 512 + g * 16 + h, o); ) )
    }
};
struct EpiGlu {
    static constexpr bool PERM = false, AFTER_DRAIN = false;
    const bf16_t* ys; const bf16_t* zs; const float* bglu; bf16_t* mixin;
    __device__ __forceinline__ void operator()(const acc_t& acc, const pg8::Unit& u, int wr, int wc, int fr, int fq) const {
        EPI_ROWS( EPI_COLS( const f32x4 bv = *(const f32x4*)(bglu + col);
            const f32x4 y = load_bf4(ys + (size_t)row * 512 + col), z = load_bf4(zs + (size_t)row * 512 + col); f32x4 o;
            _Pragma("unroll") for (int e = 0; e < 4; ++e) o[e] = y[e] * sigmoidf_(v[e] + bv[e]) * z[e] * sigmoidf_(z[e]);
            store_bf4(mixin + (size_t)row * 1024 + col, o); ) )
    }
};
struct EpiStoreSS {
    static constexpr bool PERM = false, AFTER_DRAIN = false;
    bf16_t* dst; float* ss;
    __device__ __forceinline__ void operator()(const acc_t& acc, const pg8::Unit& u, int wr, int wc, int fr, int fq) const {
        EPI_ROWS( float s = 0.f;
            EPI_COLS( s += (v[0] * v[0] + v[1] * v[1]) + (v[2] * v[2] + v[3] * v[3]); store_bf4(dst + (size_t)row * 1024 + col, v); )
            s += __shfl_xor(s, 16); s += __shfl_xor(s, 32);
            if (fq == 0) ss[(size_t)row * 16 + u.pn * 4 + wc] = s; )
    }
};
struct EpiFinal {
    static constexpr bool PERM = false, AFTER_DRAIN = false;
    const bf16_t* hb; const bf16_t* eraw; const float* rstd; const float* gple; float* out;
    __device__ __forceinline__ void operator()(const acc_t& acc, const pg8::Unit& u, int wr, int wc, int fr, int fq) const {
        EPI_ROWS( const float re = rstd[T + row];
            EPI_COLS( const size_t off = (size_t)row * 1024 + col;
                const f32x4 ge = *(const f32x4*)(gple + col), hv = load_bf4(hb + off), ev = load_bf4(eraw + off); f32x4 o;
                _Pragma("unroll") for (int e = 0; e < 4; ++e) o[e] = hv[e] + sigmoidf_(v[e]) * (ev[e] * re * ge[e]);
                *(f32x4*)(out + off) = o; ) )
    }
};

__device__ __forceinline__ void ktab_unit(const Params& P, int u, float* ldsf) {
    const int dir = u >> 8, g = (u >> 3) & 31, mr = u & 7, tid = TID;
    float2* lp = (float2*)ldsf;
    float2* bb = lp + 64 * 65;
    float2* cc = bb + 64 * 16;
    float2* lampow = (float2*)(P.ws + OFF_LAM); float2* bbar = (float2*)(P.ws + OFF_BBAR); float* ktab = (float*)(P.ws + OFF_KTAB);
    if (tid < 64) {
        const int p = tid, idx = (dir * 32 + g) * 64 + p;
        const float ar = P.a_re[idx], ai = P.a_im[idx], dt = expf(P.log_dt[dir * 32 + g]);
        const float mag = expf(dt * ar), ang = dt * ai; const float lr = mag * cosf(ang), li = mag * sinf(ang);
        const float nr = lr - 1.f, ni = li, den = ar * ar + ai * ai;
        const float cr = (nr * ar + ni * ai) / den, ci = (ni * ar - nr * ai) / den;
        float brv[16], biv[16];
#pragma unroll
        for (int h = 0; h < 16; ++h) { brv[h] = P.b_re[idx * 16 + h]; biv[h] = P.b_im[idx * 16 + h]; }
        float pr = 1.f, pi = 0.f;
        for (int m = 0; m <= 64; ++m) { lp[p * 65 + m] = make_float2(pr, pi); if (mr == 0) lampow[(size_t)idx * 65 + m] = make_float2(pr, pi); const float tt = pr * lr - pi * li; pi = pr * li + pi * lr; pr = tt; }
#pragma unroll
        for (int h = 0; h < 16; ++h) { const float2 v = make_float2(cr * brv[h] - ci * biv[h], cr * biv[h] + ci * brv[h]); bb[p * 16 + h] = v; if (mr == 0) bbar[(size_t)idx * 16 + h] = v; }
    }
#pragma unroll
    for (int i = 0; i < 4; ++i) { const int e = tid + 256 * i; cc[(e >> 6) * 65 + (e & 63)] = make_float2(P.c_re[(dir * 32 + g) * 1024 + e], P.c_im[(dir * 32 + g) * 1024 + e]); }
    __syncthreads();
    const int h = tid >> 4, h2 = tid & 15;
    float s[8];
#pragma unroll
    for (int mm = 0; mm < 8; ++mm) s[mm] = 0.f;
    for (int p = 0; p < 64; ++p) {
        const float2 c = cc[h * 65 + p], b = bb[p * 16 + h2];
        const float cbx = c.x * b.x - c.y * b.y, cby = c.x * b.y + c.y * b.x;
#pragma unroll
        for (int mm = 0; mm < 8; ++mm) { const float2 l = lp[p * 65 + mr * 8 + mm]; s[mm] += cbx * l.x - cby * l.y; }
    }
#pragma unroll
    for (int mm = 0; mm < 8; ++mm) ktab[((size_t)((dir * 32 + g) * 64 + mr * 8 + mm)) * 256 + h * 16 + h2] = s[mm];
    __syncthreads();
}
__device__ __forceinline__ void transpose_unit(const float* W, int K, int N, const float* gain, bf16_t* Wt, int item, float* ldsf) {
    const int nblk = N / 64, kb = item / nblk, nbk = item % nblk, k0 = kb * 64, n0 = nbk * 64, tid = TID;
#pragma unroll 4
    for (int i = 0; i < 16; ++i) { const int kk = i * 4 + (tid >> 6), nn = tid & 63; float v = W[(size_t)(k0 + kk) * N + n0 + nn]; if (gain) v *= gain[k0 + kk]; ldsf[kk * 65 + nn] = v; }
    __syncthreads();
#pragma unroll 4
    for (int i = 0; i < 8; ++i) { const int nn = i * 8 + (tid >> 5), kk = (tid & 31) * 2; *(unsigned*)(Wt + (size_t)(n0 + nn) * K + k0 + kk) = pk2(ldsf[kk * 65 + nn], ldsf[(kk + 1) * 65 + nn]); }
    __syncthreads();
}
__device__ __forceinline__ float wave_sum(float v) {
#pragma unroll
    for (int o = 1; o < 64; o <<= 1) v += __shfl_xor(v, o);
    return v;
}
__device__ __forceinline__ void phase0(const Params& P, int bid, int nb, unsigned char* lds) {
    float* ldsf = (float*)(lds + (threadIdx.x >> 8) * 65536);
    const int vb = bid * 2 + (threadIdx.x >> 8), nvb = nb * 2;
    constexpr int U_K = 512, I_IN = 16 * 48, I_GLU = 64, I_OUT = 256, I_PLE = 4 * 16, I_PG = 256, U_T = I_IN + I_GLU + I_OUT + I_PLE + I_PG, U_X = T / 16, U_P = (T * DPLE) / 4096;
    constexpr int NU = U_K + U_T + U_X + U_P;
    const int tid = TID, lane = tid & 63, wid = tid >> 6;
    for (int u = vb; u < NU; u += nvb) {
        int r = u;
        if (r < U_K) { ktab_unit(P, r, ldsf); continue; } r -= U_K;
        if (r < U_T) {
            if (r < I_IN) { transpose_unit(P.w_in, 1024, 3072, P.norm_pre, (bf16_t*)(P.ws + OFF_WIN), r, ldsf); continue; } r -= I_IN;
            if (r < I_GLU) { transpose_unit(P.w_glu, 512, 512, nullptr, (bf16_t*)(P.ws + OFF_WGLU), r, ldsf); continue; } r -= I_GLU;
            if (r < I_OUT) { transpose_unit(P.w_out, 1024, 1024, nullptr, (bf16_t*)(P.ws + OFF_WOUT), r, ldsf); continue; } r -= I_OUT;
            if (r < I_PLE) { transpose_unit(P.w_ple, 256, 1024, nullptr, (bf16_t*)(P.ws + OFF_WPLE), r, ldsf); continue; } r -= I_PLE;
            transpose_unit(P.w_pg, 1024, 1024, nullptr, (bf16_t*)(P.ws + OFF_WPG), r, ldsf); continue;
        }
        r -= U_T;
        if (r < U_X) {
            const int t = r * 16 + wid * 4; const f32x4* xr = (const f32x4*)(P.x + (size_t)t * 1024) + lane; f32x4 v[16]; float s[4];
#pragma unroll
            for (int j = 0; j < 16; ++j) v[j] = xr[64 * j];
#pragma unroll
            for (int q = 0; q < 4; ++q) { float a = 0.f;
#pragma unroll
                for (int j = 0; j < 4; ++j) { const f32x4 w = v[4 * q + j]; a += (w[0] * w[0] + w[1] * w[1]) + (w[2] * w[2] + w[3] * w[3]); }
                s[q] = rsqrtf(wave_sum(a) * (1.f / 1024.f) + EPS); }
            bf16_t* o = (bf16_t*)(P.ws + OFF_XN) + (size_t)t * 1024 + lane * 4;
#pragma unroll
            for (int q = 0; q < 4; ++q)
#pragma unroll
                for (int j = 0; j < 4; ++j) store_bf4(o + q * 1024 + 256 * j, v[4 * q + j] * s[q]);
            continue;
        }
        r -= U_X;
        {
            const size_t e0 = (size_t)r * 4096 + tid * 8; f32x4 a[2], c[2];
#pragma unroll
            for (int h = 0; h < 2; ++h) { a[h] = *(const f32x4*)(P.p + e0 + h * 2048); c[h] = *(const f32x4*)(P.p + e0 + h * 2048 + 4); }
#pragma unroll
            for (int h = 0; h < 2; ++h) { u32x4 w; w.x = pk2(a[h][0], a[h][1]); w.y = pk2(a[h][2], a[h][3]); w.z = pk2(c[h][0], c[h][1]); w.w = pk2(c[h][2], c[h][3]);
                *(u32x4*)((bf16_t*)(P.ws + OFF_PB) + e0 + h * 2048) = w; }
        }
    }
}

__device__ __forceinline__ void tq_unit(const Params& P, int u) {
    static_assert(LC == 64, "tq_unit / pm_unit thread maps assume 64-token chunks");
    const int g = u / LC, i = u % LC, tid = TID;
    const float* ktab = (const float*)(P.ws + OFF_KTAB); const float2* lampow = (const float2*)(P.ws + OFF_LAM); bf16_t* tq = (bf16_t*)(P.ws + OFF_TQ);
    const int h2 = (tid & 7) * 2;
#pragma unroll
    for (int half = 0; half < 2; ++half) {
        const int j = (tid >> 3) + 32 * half;
        const int ma = i > j ? i - j : 0, mb = j > i ? j - i : 0;
        const float wa = i >= j ? 1.f : 0.f, wb = j >= i ? 1.f : 0.f;
        const float* kf = ktab + ((size_t)((0 * 32 + g) * 64 + ma)) * 256 + h2; const float* kb = ktab + ((size_t)((1 * 32 + g) * 64 + mb)) * 256 + h2;
        float2 a[16], b[16];
#pragma unroll
        for (int h = 0; h < 16; ++h) { a[h] = *(const float2*)(kf + h * 16); b[h] = *(const float2*)(kb + h * 16); }
#pragma unroll
        for (int h = 0; h < 16; ++h) {
            float v0 = wa * a[h].x + wb * b[h].x, v1 = wa * a[h].y + wb * b[h].y;
            if (i == j) { const float dd = P.ssm_d[g * 16 + h]; v0 += (h == h2 ? dd : 0.f); v1 += (h == h2 + 1 ? dd : 0.f); }
            *(unsigned*)(tq + ((size_t)(g * KU + i * 16 + h)) * KA + j * 16 + h2) = pk2(v0, v1);
        }
    }
    {
        const int pn = tid & 127, dir = pn >> 6, p = pn & 63, m = dir == 0 ? i + 1 : LC - i;
        const float2 l = lampow[((size_t)((dir * 32 + g) * 64 + p)) * 65 + m];
        float cr[8], ci[8];
#pragma unroll
        for (int it = 0; it < 8; ++it) { const int h = it * 2 + (tid >> 7); cr[it] = P.c_re[((dir * 32 + g) * 16 + h) * 64 + p]; ci[it] = P.c_im[((dir * 32 + g) * 16 + h) * 64 + p]; }
#pragma unroll
        for (int it = 0; it < 8; ++it) { const int h = it * 2 + (tid >> 7);
            *(unsigned*)(tq + ((size_t)(g * KU + i * 16 + h)) * KA + KU + dir * 128 + p * 2) = pk2(cr[it] * l.x - ci[it] * l.y, -(cr[it] * l.y + ci[it] * l.x)); }
    }
}
__device__ __forceinline__ void pm_unit(const Params& P, int u) {
    const int g = u >> 4, rg = u & 15, tid = TID;
    const float2* lampow = (const float2*)(P.ws + OFF_LAM); const float2* bbar = (const float2*)(P.ws + OFF_BBAR); bf16_t* pm = (bf16_t*)(P.ws + OFF_PM);
    const int h2 = (tid & 7) * 2;
#pragma unroll 4
    for (int q = 0; q < 8; ++q) {
        const int pidx = rg * 8 + q, dir = pidx >> 6, p = pidx & 63;
        const f32x4 bq = *(const f32x4*)(bbar + ((size_t)((dir * 32 + g) * 64 + p)) * 16 + h2);
#pragma unroll
        for (int half = 0; half < 2; ++half) {
            const int j = (tid >> 3) + 32 * half, m = dir == 0 ? LC - 1 - j : j;
            const float2 l = lampow[((size_t)((dir * 32 + g) * 64 + p)) * 65 + m];
            bf16_t* dst = pm + ((size_t)(g * NS + 2 * pidx)) * KU + j * 16 + h2;
            *(unsigned*)dst = pk2(l.x * bq[0] - l.y * bq[1], l.x * bq[2] - l.y * bq[3]);
            *(unsigned*)(dst + KU) = pk2(l.x * bq[1] + l.y * bq[0], l.x * bq[3] + l.y * bq[2]);
        }
    }
}
__device__ __forceinline__ void phase1(const Params& P, int bid, int nb, unsigned char* lds) {
    constexpr int U_TQ = 32 * LC, U_PM = 32 * 16;
    const int xcd = bid & 7, rank = bid >> 3, R = nb >> 3;
    {
        const pg8::Gemm g{(const bf16_t*)(P.ws + OFF_XN), (const bf16_t*)(P.ws + OFF_WIN), 1024, 1024};
        const pg8::Order S{rank, R, 192, 6, xcd & 1, (xcd >> 1) * 32, 2}; const EpiInProj E{P.ws};
        pg8::gemm_phase<EpiInProj, pg8::Order, true, true>((PG8_LAS unsigned char*)lds, g, S, E);
    }
    const int vb = bid * 2 + (threadIdx.x >> 8), nvb = nb * 2;
    for (int u = vb; u < U_PM; u += nvb) pm_unit(P, u);
}

__device__ __forceinline__ void na_unit(const Params& P, int u, float* ldsf) {
    const int tid = TID, lane = tid & 63, cb = tid >> 6, fr = lane & 15, fq = lane >> 4;
    const int r = u & 127, head = (u >> 7) & 7, b = u >> 10;
    const bf16_t* q = (const bf16_t*)(P.ws + OFF_Q); const bf16_t* k = (const bf16_t*)(P.ws + OFF_K); const bf16_t* vt = (const bf16_t*)(P.ws + OFF_VT); const bf16_t* zn = (const bf16_t*)(P.ws + OFF_ZN);
    bf16_t* mixin = (bf16_t*)(P.ws + OFF_MIXIN);
    for (int i = tid; i < 15 * 31; i += 256) ldsf[i] = P.rpb[head * 15 * 31 + i];
    const int rs = min(max(r - 4, 0), 120);
    const int cw0 = cb == 0 ? 0 : (cb == 1 ? 8 : (cb == 2 ? 24 : 32));
    const int c = cb * 16 + fr, cs = min(max(c - 8, 0), 48);
    const size_t tq = (size_t)b * SEQ + r * 64 + c;
    const bf16x8 qf0 = *(const bf16x8*)(q + tq * 512 + head * 64 + fq * 8), qf1 = *(const bf16x8*)(q + tq * 512 + head * 64 + 32 + fq * 8);
    f32x4 s[16];
    const int kcol = cw0 + (fr >> 2) * 8 + (fr & 3);
    const bf16_t* kbase = k + ((size_t)b * SEQ + rs * 64 + kcol) * 512 + head * 64 + fq * 8;
#pragma unroll
    for (int hf = 0; hf < 2; ++hf) {
        bf16x8 k0[8], k1[8];
#pragma unroll
        for (int t = 0; t < 8; ++t) { const int tt = hf * 8 + t; const bf16_t* kp = kbase + ((size_t)(tt >> 1) * 64 + (tt & 1) * 4) * 512; k0[t] = *(const bf16x8*)kp; k1[t] = *(const bf16x8*)(kp + 32); }
#pragma unroll
        for (int t = 0; t < 8; ++t) {
            f32x4 z = (f32x4){0.f, 0.f, 0.f, 0.f};
            z = __builtin_amdgcn_mfma_f32_16x16x32_bf16(k0[t], qf0, z, 0, 0, 0);
            z = __builtin_amdgcn_mfma_f32_16x16x32_bf16(k1[t], qf1, z, 0, 0, 0);
            s[hf * 8 + t] = z;
        }
    }
    __syncthreads();
    float mx = -3.0e38f;
#pragma unroll
    for (int t = 0; t < 16; ++t) {
        const int i = t >> 1, odd = t & 1, dr = rs + i - r + 7;
#pragma unroll
        for (int e = 0; e < 4; ++e) {
            const int ck = cw0 + fq * 8 + odd * 4 + e; const bool valid = (ck >= cs) && (ck < cs + 16);
            const int dc = min(max(ck - c + 15, 0), 30);
            const float bv = ldsf[dr * 31 + dc];
            const float sv = valid ? s[t][e] + bv : -3.0e38f;
            s[t][e] = sv; mx = fmaxf(mx, sv);
        }
    }
    mx = fmaxf(mx, __shfl_xor(mx, 16)); mx = fmaxf(mx, __shfl_xor(mx, 32));
    float l = 0.f;
#pragma unroll
    for (int t = 0; t < 16; ++t)
#pragma unroll
        for (int e = 0; e < 4; ++e) { const float pv = __expf(s[t][e] - mx); s[t][e] = pv; l += pv; }
    l += __shfl_xor(l, 16); l += __shfl_xor(l, 32);
    f32x4 o[4];
#pragma unroll
    for (int dt = 0; dt < 4; ++dt) o[dt] = (f32x4){0.f, 0.f, 0.f, 0.f};
    const bf16_t* vbase = vt + ((size_t)(b * 512 + head * 64 + fr)) * SEQ + rs * 64 + cw0 + fq * 8;
#pragma unroll
    for (int k2 = 0; k2 < 4; ++k2) {
        bf16x8 vf[2][4];
#pragma unroll
        for (int kk = 0; kk < 2; ++kk)
#pragma unroll
            for (int dt = 0; dt < 4; ++dt) vf[kk][dt] = *(const bf16x8*)(vbase + (size_t)dt * 16 * SEQ + (k2 * 2 + kk) * 64);
#pragma unroll
        for (int kk = 0; kk < 2; ++kk) {
            const int kq = k2 * 2 + kk;
            u32x4 pw; pw.x = pk2(s[2 * kq][0], s[2 * kq][1]); pw.y = pk2(s[2 * kq][2], s[2 * kq][3]); pw.z = pk2(s[2 * kq + 1][0], s[2 * kq + 1][1]); pw.w = pk2(s[2 * kq + 1][2], s[2 * kq + 1][3]);
            const bf16x8 pf = __builtin_bit_cast(bf16x8, pw);
#pragma unroll
            for (int dt = 0; dt < 4; ++dt) o[dt] = __builtin_amdgcn_mfma_f32_16x16x32_bf16(vf[kk][dt], pf, o[dt], 0, 0, 0);
        }
    }
    const float inv = 1.f / l;
#pragma unroll
    for (int dt = 0; dt < 4; ++dt) {
        const int d0 = head * 64 + dt * 16 + fq * 4; const f32x4 z = load_bf4(zn + tq * 512 + d0); f32x4 ov;
#pragma unroll
        for (int e = 0; e < 4; ++e) ov[e] = o[dt][e] * inv * z[e] * sigmoidf_(z[e]);
        store_bf4(mixin + tq * 1024 + 512 + d0, ov);
    }
    __syncthreads();
}
constexpr int NA_KOFF = 0, NA_VOFF = 9 * 8192, NA_BOFF = 18 * 8192, NA_LDS = NA_BOFF + 2048;
__device__ __forceinline__ void na_block(const Params& P, int unit, unsigned char* lds) {
    const int tid = threadIdx.x, lane = tid & 63, w = tid >> 6, qrow = w >> 2, cb = w & 3, fr = lane & 15, fq = lane >> 4;
    const int seg = unit & 7, head = (unit >> 3) & 7, b = unit >> 6;
    const bf16_t* q = (const bf16_t*)(P.ws + OFF_Q); const bf16_t* k = (const bf16_t*)(P.ws + OFF_K); const bf16_t* vt = (const bf16_t*)(P.ws + OFF_VT); const bf16_t* zn = (const bf16_t*)(P.ws + OFF_ZN);
    bf16_t* mixin = (bf16_t*)(P.ws + OFF_MIXIN);
    float* bias = (float*)(lds + NA_BOFF);
    do { asm volatile("s_waitcnt vmcnt(0) lgkmcnt(0)" ::: "memory"); __syncthreads(); } while (0);
    for (int i = tid; i < 15 * 31; i += 512) bias[i] = P.rpb[head * 15 * 31 + i];
    const int st_r = tid >> 3, st_c = tid & 7;
    const int ksw = st_r * 128 + ((st_c ^ (((st_r >> 1) & 1) | (((st_r >> 3) & 3) << 1))) * 16);
    const int vsw = st_r * 128 + ((st_c ^ (st_r & 7)) * 16);
    const bf16_t* kst = k + ((size_t)b * SEQ + st_r) * 512 + head * 64 + st_c * 8;
    const bf16_t* vst = vt + ((size_t)(b * 512 + head * 64 + st_r)) * SEQ + st_c * 8;
    const int cw0 = cb == 0 ? 0 : (cb == 1 ? 8 : (cb == 2 ? 24 : 32));
    const int c = cb * 16 + fr, cs = min(max(c - 8, 0), 48);
    const int kcol = cw0 + (fr >> 2) * 8 + (fr & 3);
    const int sK = ((kcol >> 1) & 1) | (((kcol >> 3) & 3) << 1);
    const int kfo0 = kcol * 128 + ((fq ^ sK) * 16), kfo1 = kcol * 128 + (((4 + fq) ^ sK) * 16);
    const int vfo = fr * 128 + ((((cw0 >> 3) + fq) ^ (fr & 7)) * 16);
    int res_hi = -1;
    for (int p = 0; p < 8; ++p) {
        const int r0 = seg * 16 + 2 * p;
        const int lo = min(max(r0 - 4, 0), 120), hi = min(max(r0 - 3, 0), 120) + 7;
        const int first_new = max(lo, res_hi + 1);
        do { asm volatile("s_waitcnt vmcnt(0) lgkmcnt(0)" ::: "memory"); __syncthreads(); } while (0);
        for (int kr0 = first_new; kr0 <= hi; kr0 += 3) {
            u32x4 kv[3], vv[3];
#pragma unroll
            for (int j = 0; j < 3; ++j) { const int kr = min(kr0 + j, hi); kv[j] = *(const u32x4*)(kst + (size_t)kr * 64 * 512); vv[j] = *(const u32x4*)(vst + kr * 64); }
#pragma unroll
            for (int j = 0; j < 3; ++j) { const int slot = min(kr0 + j, hi) % 9; *(u32x4*)(lds + NA_KOFF + slot * 8192 + ksw) = kv[j]; *(u32x4*)(lds + NA_VOFF + slot * 8192 + vsw) = vv[j]; }
        }
        res_hi = hi;
        const int r = r0 + qrow, rs = min(max(r - 4, 0), 120);
        const size_t tq = (size_t)b * SEQ + r * 64 + c;
        const bf16x8 qf0 = *(const bf16x8*)(q + tq * 512 + head * 64 + fq * 8), qf1 = *(const bf16x8*)(q + tq * 512 + head * 64 + 32 + fq * 8);
        f32x4 zg[4];
#pragma unroll
        for (int dt = 0; dt < 4; ++dt) zg[dt] = load_bf4(zn + tq * 512 + head * 64 + dt * 16 + fq * 4);
        do { asm volatile("s_waitcnt vmcnt(0) lgkmcnt(0)" ::: "memory"); __syncthreads(); } while (0);
        f32x4 s[16];
#pragma unroll
        for (int t = 0; t < 16; ++t) {
            const int slot = (rs + (t >> 1)) % 9; const unsigned char* kb = lds + NA_KOFF + slot * 8192 + (t & 1) * 4 * 128;
            const bf16x8 k0 = *(const bf16x8*)(kb + kfo0), k1 = *(const bf16x8*)(kb + kfo1);
            f32x4 z = (f32x4){0.f, 0.f, 0.f, 0.f};
            z = __builtin_amdgcn_mfma_f32_16x16x32_bf16(k0, qf0, z, 0, 0, 0);
            z = __builtin_amdgcn_mfma_f32_16x16x32_bf16(k1, qf1, z, 0, 0, 0);
            s[t] = z;
        }
        float mx = -3.0e38f;
#pragma unroll
        for (int t = 0; t < 16; ++t) {
            const int i = t >> 1, odd = t & 1, dr = rs + i - r + 7;
#pragma unroll
            for (int e = 0; e < 4; ++e) {
                const int ck = cw0 + fq * 8 + odd * 4 + e; const bool valid = (ck >= cs) && (ck < cs + 16);
                const int dc = min(max(ck - c + 15, 0), 30);
                const float bv = bias[dr * 31 + dc];
                const float sv = valid ? s[t][e] + bv : -3.0e38f;
                s[t][e] = sv; mx = fmaxf(mx, sv);
            }
        }
        mx = fmaxf(mx, __shfl_xor(mx, 16)); mx = fmaxf(mx, __shfl_xor(mx, 32));
        float l = 0.f;
#pragma unroll
        for (int t = 0; t < 16; ++t)
#pragma unroll
            for (int e = 0; e < 4; ++e) { const float pv = __expf(s[t][e] - mx); s[t][e] = pv; l += pv; }
        l += __shfl_xor(l, 16); l += __shfl_xor(l, 32);
        f32x4 o[4];
#pragma unroll
        for (int dt = 0; dt < 4; ++dt) o[dt] = (f32x4){0.f, 0.f, 0.f, 0.f};
#pragma unroll
        for (int kq = 0; kq < 8; ++kq) {
            u32x4 pw; pw.x = pk2(s[2 * kq][0], s[2 * kq][1]); pw.y = pk2(s[2 * kq][2], s[2 * kq][3]); pw.z = pk2(s[2 * kq + 1][0], s[2 * kq + 1][1]); pw.w = pk2(s[2 * kq + 1][2], s[2 * kq + 1][3]);
            const bf16x8 pf = __builtin_bit_cast(bf16x8, pw);
            const unsigned char* vb = lds + NA_VOFF + ((rs + kq) % 9) * 8192 + vfo;
#pragma unroll
            for (int dt = 0; dt < 4; ++dt) { const bf16x8 vf = *(const bf16x8*)(vb + dt * 16 * 128); o[dt] = __builtin_amdgcn_mfma_f32_16x16x32_bf16(vf, pf, o[dt], 0, 0, 0); }
        }
        const float inv = 1.f / l;
#pragma unroll
        for (int dt = 0; dt < 4; ++dt) {
            const int d0 = head * 64 + dt * 16 + fq * 4; const f32x4 z = zg[dt]; f32x4 ov;
#pragma unroll
            for (int e = 0; e < 4; ++e) ov[e] = o[dt][e] * inv * z[e] * sigmoidf_(z[e]);
            store_bf4(mixin + tq * 1024 + 512 + d0, ov);
        }
        do { asm volatile("s_waitcnt vmcnt(0) lgkmcnt(0)" ::: "memory"); __syncthreads(); } while (0);
    }
    do { asm volatile("s_waitcnt vmcnt(0) lgkmcnt(0)" ::: "memory"); __syncthreads(); } while (0);
}
__device__ __forceinline__ void phase2(const Params& P, int bid, int nb, unsigned char* lds) {
    const int xcd = bid & 7, rank = bid >> 3, R = nb >> 3;
    for (int l = rank; l < 8; l += R) {
        const int mt = l & 1, g = xcd + 8 * (l >> 1);
        const pg8::Gemm gm{(const bf16_t*)(P.ws + OFF_UA) + (size_t)g * NCH * KA, (const bf16_t*)(P.ws + OFF_PM) + (size_t)g * NS * KU, KA, KU};
        const pg8::Order S{0, 1, 1, 1, 0, mt, 1}; const EpiS E{(float*)(P.ws + OFF_S) + (size_t)g * NCH * NS};
        pg8::gemm_phase<EpiS, pg8::Order, true, true>((PG8_LAS unsigned char*)lds, gm, S, E);
    }
    for (int l = rank; l < 32; l += R) na_block(P, xcd * 32 + l, lds);
    if (R == 32 && rank >= 8) {
        const int j = xcd * 48 + (rank - 8) * 2 + (threadIdx.x >> 8);
        for (int u = j; u < 1024; u += 384) tq_unit(P, u);
    }
}

__device__ __forceinline__ void phase3(const Params& P, int bid, int nb) {
    const float2* lampow = (const float2*)(P.ws + OFF_LAM); const float2* S = (const float2*)(P.ws + OFF_S); bf16_t* ua = (bf16_t*)(P.ws + OFF_UA);
    const int vb = bid * 2 + (threadIdx.x >> 8), nvb = nb * 2;
    if (nvb == 512 && vb >= 64) {
        for (int u = 1024 + (vb - 64); u < 32 * LC; u += 448) tq_unit(P, u);
        return;
    }
    if (nvb != 512) { for (int u = vb; u < 32 * LC; u += nvb) tq_unit(P, u); }
    for (int sidx = vb * 256 + TID; sidx < 4 * 2 * 32 * 64; sidx += nvb * 256) {
        const int p = sidx & 63, g = (sidx >> 6) & 31, dir = (sidx >> 11) & 1, b = sidx >> 12;
        const float2 L = lampow[((size_t)((dir * 32 + g) * 64 + p)) * 65 + LC];
        float hr = 0.f, hi = 0.f;
        const float2* Sp = S + ((size_t)(g * NCH + b * CPB)) * (NS / 2) + dir * 64 + p;
        bf16_t* up = ua + ((size_t)(g * NCH + b * CPB)) * KA + KU + dir * 128 + p * 2;
        for (int cb0 = 0; cb0 < CPB; cb0 += 16) {
            float2 sv[16];
#pragma unroll
            for (int uu = 0; uu < 16; ++uu) { const int c = dir == 0 ? cb0 + uu : CPB - 1 - (cb0 + uu); sv[uu] = Sp[(size_t)c * (NS / 2)]; }
#pragma unroll
            for (int uu = 0; uu < 16; ++uu) {
                const int c = dir == 0 ? cb0 + uu : CPB - 1 - (cb0 + uu);
                *(unsigned*)(up + (size_t)c * KA) = pk2(hr, hi);
                const float tr = L.x * hr - L.y * hi + sv[uu].x; hi = L.x * hi + L.y * hr + sv[uu].y; hr = tr;
            }
        }
    }
}

__device__ __forceinline__ void phase4(const Params& P, int bid, int nb, unsigned char* lds) {
    const int xcd = bid & 7, rank = bid >> 3, R = nb >> 3;
    for (int l = rank; l < 32; l += R) {
        const int mt = l & 1, nt = (l >> 1) & 3, g = xcd + 8 * (l >> 3);
        const pg8::Gemm gm{(const bf16_t*)(P.ws + OFF_UA) + (size_t)g * NCH * KA, (const bf16_t*)(P.ws + OFF_TQ) + (size_t)g * KU * KA, KA, KA};
        const pg8::Order S{0, 1, 1, 1, nt, mt, 1}; const EpiY E{(bf16_t*)(P.ws + OFF_YS), g};
        pg8::gemm_phase<EpiY, pg8::Order, true, true>((PG8_LAS unsigned char*)lds, gm, S, E);
    }
}
__device__ __forceinline__ void phase5(const Params& P, int bid, int nb, unsigned char* lds) {
    const int xcd = bid & 7, rank = bid >> 3, R = nb >> 3;
    const pg8::Gemm g{(const bf16_t*)(P.ws + OFF_YS), (const bf16_t*)(P.ws + OFF_WGLU), 512, 512};
    const pg8::Order S{rank, R, 32, 2, 0, xcd * 16, 1};
    const EpiGlu E{(const bf16_t*)(P.ws + OFF_YS), (const bf16_t*)(P.ws + OFF_ZS), P.b_glu, (bf16_t*)(P.ws + OFF_MIXIN)};
    pg8::gemm_phase<EpiGlu, pg8::Order, true, true>((PG8_LAS unsigned char*)lds, g, S, E);
}
__device__ __forceinline__ void phase6(const Params& P, int bid, int nb, unsigned char* lds) {
    const int xcd = bid & 7, rank = bid >> 3, R = nb >> 3;
    const pg8::Order S{rank, R, 64, 4, 0, xcd * 16, 1};
    {
        const pg8::Gemm g{(const bf16_t*)(P.ws + OFF_MIXIN), (const bf16_t*)(P.ws + OFF_WOUT), 1024, 1024};
        const EpiStoreSS E{(bf16_t*)(P.ws + OFF_MIX), (float*)(P.ws + OFF_SS)};
        pg8::gemm_phase<EpiStoreSS, pg8::Order, true, true>((PG8_LAS unsigned char*)lds, g, S, E);
    }
    {
        const pg8::Gemm g{(const bf16_t*)(P.ws + OFF_PB), (const bf16_t*)(P.ws + OFF_WPLE), 256, 256};
        const EpiStoreSS E{(bf16_t*)(P.ws + OFF_ERAW), (float*)(P.ws + OFF_ESS)};
        pg8::gemm_phase<EpiStoreSS, pg8::Order, true, true>((PG8_LAS unsigned char*)lds, g, S, E);
    }
}
__device__ __forceinline__ void phase7(const Params& P, int bid, int nb) {
    const int tid = TID, lane = tid & 63, wid = tid >> 6;
    const float* ss = (const float*)(P.ws + OFF_SS); const float* ess = (const float*)(P.ws + OFF_ESS); float* rstd = (float*)(P.ws + OFF_RSTD);
    const bf16_t* mix = (const bf16_t*)(P.ws + OFF_MIX); bf16_t* hb = (bf16_t*)(P.ws + OFF_HB);
    const int vb = bid * 2 + (threadIdx.x >> 8), nvb = nb * 2;
    for (int u = vb; u < T / 8; u += nvb) {
        const int t = u * 8 + wid * 2;
        const int tl = t + (lane >> 5), l5 = lane & 31;
        f32x4 xv[8], mv[8];
#pragma unroll
        for (int j = 0; j < 8; ++j) { const size_t off = (size_t)(t + (j >> 2)) * 1024 + lane * 4 + 256 * (j & 3); xv[j] = *(const f32x4*)(P.x + off); mv[j] = load_bf4(mix + off); }
        float v = l5 < 16 ? ss[(size_t)tl * 16 + l5] : ess[(size_t)tl * 16 + l5 - 16];
        v += __shfl_xor(v, 1); v += __shfl_xor(v, 2); v += __shfl_xor(v, 4); v += __shfl_xor(v, 8);
        const float rp0 = rsqrtf(__shfl(v, 0) * (1.f / 1024.f) + EPS), re0 = rsqrtf(__shfl(v, 16) * (1.f / 1024.f) + EPS);
        const float rp1 = rsqrtf(__shfl(v, 32) * (1.f / 1024.f) + EPS), re1 = rsqrtf(__shfl(v, 48) * (1.f / 1024.f) + EPS);
        if (lane == 0) { rstd[t] = rp0; rstd[T + t] = re0; rstd[t + 1] = rp1; rstd[T + t + 1] = re1; }
#pragma unroll
        for (int j = 0; j < 8; ++j) {
            const int n = lane * 4 + 256 * (j & 3); const size_t off = (size_t)(t + (j >> 2)) * 1024 + n; const float rp = (j >> 2) ? rp1 : rp0;
            const f32x4 gp = *(const f32x4*)(P.norm_post + n); f32x4 h;
#pragma unroll
            for (int e = 0; e < 4; ++e) h[e] = xv[j][e] + mv[j][e] * rp * gp[e];
            store_bf4(hb + off, h);
        }
    }
}
__device__ __forceinline__ void phase8(const Params& P, int bid, int nb, unsigned char* lds) {
    const int xcd = bid & 7, rank = bid >> 3, R = nb >> 3;
    const pg8::Gemm g{(const bf16_t*)(P.ws + OFF_HB), (const bf16_t*)(P.ws + OFF_WPG), 1024, 1024};
    const pg8::Order S{rank, R, 64, 4, 0, xcd * 16, 1};
    const EpiFinal E{(const bf16_t*)(P.ws + OFF_HB), (const bf16_t*)(P.ws + OFF_ERAW), (const float*)(P.ws + OFF_RSTD), P.ple_norm, P.out};
    pg8::gemm_phase<EpiFinal, pg8::Order, true, true>((PG8_LAS unsigned char*)lds, g, S, E);
}

#define XB_TMO      128
#define XB_XCNT(j)  (256  + 64 * (j))
#define XB_XSUB(j)  (1280 + 64 * (j))
#define XB_XGEN(j)  (2304 + 64 * (j))
#define XB_TOP      3328
#define XB_TOPGEN   3392
#define XCD_BAR_WORDS 3456
#define XB_SPIN_CAP (1u << 20)
#define LAS __attribute__((address_space(3)))
__device__ __forceinline__ unsigned xb_ld(unsigned* p)              { return __hip_atomic_load(p, __ATOMIC_RELAXED, __HIP_MEMORY_SCOPE_AGENT); }
__device__ __forceinline__ unsigned xb_add(unsigned* p, unsigned v) { return __hip_atomic_fetch_add(p, v, __ATOMIC_RELAXED, __HIP_MEMORY_SCOPE_AGENT); }
__device__ __forceinline__ unsigned xb_xcc_id() { return (unsigned)__builtin_amdgcn_s_getreg((3 << 11) | 20) & 0xFu; }
#define XB_SPIN(cond, bar) do { unsigned _sp = 0; while (cond) { __builtin_amdgcn_s_sleep(1); \
    if ((++_sp & 255u) == 0u) { if (xb_ld(&(bar)[XB_TMO])) break; if (_sp > XB_SPIN_CAP) { atomicAdd(&(bar)[XB_TMO], 1u); break; } } } } while (0)
struct XcdBarrier { unsigned* bar; unsigned x; volatile LAS unsigned* st; };
__device__ __forceinline__ XcdBarrier xcd_barrier_post(unsigned* bar, volatile LAS unsigned* st) {
    XcdBarrier b; b.bar = bar; b.x = xb_xcc_id(); b.st = st;
    if (threadIdx.x == 0) (void)xb_add(&bar[XB_XCNT(b.x)], 1u);
    return b;
}
__device__ __forceinline__ void xcd_barrier_complete(unsigned* bar, unsigned x, unsigned& nloc, unsigned& nx) {
    const unsigned G = gridDim.x * gridDim.y * gridDim.z;
    unsigned sum, cnt, mine, sp = 0u;
    for (;;) {
        sum = 0u; cnt = 0u; mine = 0u;
#pragma unroll
        for (unsigned j = 0; j < 16; ++j) { const unsigned c = xb_ld(&bar[XB_XCNT(j)]); sum += c; cnt += (c > 0u) ? 1u : 0u; mine = (j == x) ? c : mine; }
        if (sum == G) break;
        __builtin_amdgcn_s_sleep(1);
        if ((++sp & 255u) == 0u) { if (xb_ld(&bar[XB_TMO])) break; if (sp > XB_SPIN_CAP) { atomicAdd(&bar[XB_TMO], 1u); break; } }
    }
    nloc = mine > 0u ? mine : 1u; nx = cnt > 0u ? cnt : 1u;
}
__device__ __forceinline__ void xcd_barrier(const XcdBarrier& b) {
    asm volatile("s_waitcnt vmcnt(0)" ::: "memory");
    __syncthreads();
    if (threadIdx.x == 0) {
        unsigned* bar = b.bar;
        __builtin_amdgcn_s_waitcnt(0);
        unsigned nloc = b.st[0], nx = b.st[1];
        if (nloc == 0u) { xcd_barrier_complete(bar, b.x, nloc, nx); b.st[0] = nloc; b.st[1] = nx; }
        const unsigned old = xb_add(&bar[XB_XSUB(b.x)], 1u);
        const unsigned gen = old / nloc;
        if (old + 1u == (gen + 1u) * nloc) {
            __builtin_amdgcn_fence(__ATOMIC_RELEASE, "agent");
            asm volatile("s_waitcnt vmcnt(0)" ::: "memory");
            const unsigned og = xb_add(&bar[XB_TOP], 1u);
            const unsigned tg = og / nx;
            if (og + 1u == (tg + 1u) * nx) xb_add(&bar[XB_TOPGEN], 1u);
            else XB_SPIN(xb_ld(&bar[XB_TOPGEN]) == tg, bar);
            __builtin_amdgcn_fence(__ATOMIC_ACQUIRE, "agent");
            xb_add(&bar[XB_XGEN(b.x)], 1u);
            asm volatile("s_waitcnt vmcnt(0)" ::: "memory");
        } else {
            XB_SPIN(xb_ld(&bar[XB_XGEN(b.x)]) == gen, bar);
            __builtin_amdgcn_fence(__ATOMIC_ACQUIRE, "agent");
            asm volatile("s_waitcnt vmcnt(0)" ::: "memory");
        }
    }
    __syncthreads();
}

extern __shared__ __attribute__((aligned(16))) unsigned char dyn_lds[];

#if MK_MULTI
__global__ void __launch_bounds__(512, 2) k_phase(Params P, int ph) {
    const int bid = blockIdx.x, nb = gridDim.x;
    switch (ph) {
        case 0: phase0(P, bid, nb, dyn_lds); break;
        case 1: phase1(P, bid, nb, dyn_lds); break;
        case 2: phase2(P, bid, nb, dyn_lds); break;
        case 3: phase3(P, bid, nb); break;
        case 4: phase4(P, bid, nb, dyn_lds); break;
        case 5: phase5(P, bid, nb, dyn_lds); break;
        case 6: phase6(P, bid, nb, dyn_lds); break;
        case 7: phase7(P, bid, nb); break;
        default: phase8(P, bid, nb, dyn_lds); break;
    }
}
#else
__global__ void __launch_bounds__(512, 2) k_mega(Params P) {
    __shared__ uint4 xb_words;
    if (threadIdx.x == 0) xb_words = make_uint4(0u, 0u, 0u, 0u);
    __syncthreads();
    const XcdBarrier xb = xcd_barrier_post((unsigned*)(P.ws + OFF_BAR), (volatile LAS unsigned*)&xb_words);
    const int bid = blockIdx.x, nb = gridDim.x;
#ifndef REP
#define REP -1
#endif
#define PH(n, call) do { call; xcd_barrier(xb); if (REP == n) { call; xcd_barrier(xb); } } while (0)
    PH(0, phase0(P, bid, nb, dyn_lds));
    PH(1, phase1(P, bid, nb, dyn_lds));
    PH(2, phase2(P, bid, nb, dyn_lds));
    PH(3, phase3(P, bid, nb));
    PH(4, phase4(P, bid, nb, dyn_lds));
    PH(5, phase5(P, bid, nb, dyn_lds));
    PH(6, phase6(P, bid, nb, dyn_lds));
    PH(7, phase7(P, bid, nb));
    phase8(P, bid, nb, dyn_lds);
    if (REP == 8) { xcd_barrier(xb); phase8(P, bid, nb, dyn_lds); }
}
#endif

extern "C" void kernel_launch(void* const* d_in, const int* in_sizes, int n_in, void* d_out, int out_size, void* d_ws, size_t ws_size, hipStream_t stream) {
    static int grid = 0;
    if (grid == 0) {
        if (n_in != 20 || ws_size < WS_END) { fprintf(stderr, "kernel_launch: unexpected n_in %d or ws_size %zu (< %zu)\n", n_in, ws_size, (size_t)WS_END); grid = -1; return; }
        int dev = 0, cus = 0, per_cu = 0;
        hipGetDevice(&dev); hipDeviceGetAttribute(&cus, hipDeviceAttributeMultiprocessorCount, dev);
#if MK_MULTI
        hipFuncSetAttribute((const void*)k_phase, hipFuncAttributeMaxDynamicSharedMemorySize, LDS_BYTES);
        hipOccupancyMaxActiveBlocksPerMultiprocessor(&per_cu, (const void*)k_phase, 512, LDS_BYTES);
#else
        hipFuncSetAttribute((const void*)k_mega, hipFuncAttributeMaxDynamicSharedMemorySize, LDS_BYTES);
        hipOccupancyMaxActiveBlocksPerMultiprocessor(&per_cu, (const void*)k_mega, 512, LDS_BYTES);
#endif
        if (per_cu < 1) per_cu = 1;
        if (per_cu > 1) per_cu = 1;
        grid = (cus * per_cu) & ~7;
        (void)hipGetLastError();
    }
    if (grid < 0) return;
    Params P{};
    const float** pp = (const float**)&P;
    for (int i = 0; i < 20; ++i) pp[i] = (const float*)d_in[i];
    P.out = (float*)d_out; P.ws = (unsigned char*)d_ws;
#if MK_MULTI
    for (int ph = 0; ph < 9; ++ph) hipLaunchKernelGGL(k_phase, dim3(grid), dim3(512), LDS_BYTES, stream, P, ph);
#else
    (void)hipMemsetAsync((unsigned char*)d_ws + OFF_BAR, 0, XCD_BAR_WORDS * 4, stream);
    void* args[] = {&P};
    hipError_t e = hipLaunchCooperativeKernel((const void*)k_mega, dim3(grid), dim3(512), args, LDS_BYTES, stream);
    if (e != hipSuccess) fprintf(stderr, "cooperative launch failed: %s (grid %d)\n", hipGetErrorString(e), grid);
#endif
}
```

```cpp
#include <hip/hip_runtime.h>
#include <hip/hip_cooperative_groups.h>
#include <stdint.h>
#include <stdio.h>
namespace cg = cooperative_groups;

#ifndef MK_MULTI
#define MK_MULTI 0
#endif

typedef unsigned short bf16_t;
typedef short bf16x8 __attribute__((ext_vector_type(8)));
typedef float f32x4 __attribute__((ext_vector_type(4)));
typedef unsigned u32x4 __attribute__((ext_vector_type(4)));
typedef unsigned u32x2 __attribute__((ext_vector_type(2)));

constexpr int T = 32768, DM = 1024, SEQ = 8192, DPLE = 256, DIN = 3072;
constexpr int LC = 64;
constexpr int NCH = T / LC;
constexpr int CPB = SEQ / LC;
constexpr int KU = LC * 16;
constexpr int NS = 256;
constexpr int KA = KU + NS;
constexpr float EPS = 1e-6f;

constexpr size_t MB = 1ull << 20;
constexpr size_t OFF_XN = 0;
constexpr size_t OFF_MIXIN = OFF_XN;
constexpr size_t OFF_PB = OFF_XN + 64 * MB;
constexpr size_t OFF_WIN = OFF_PB + 16 * MB;
constexpr size_t OFF_WGLU = OFF_WIN + 6 * MB;
constexpr size_t OFF_WOUT = OFF_WGLU + 1 * MB;
constexpr size_t OFF_WPLE = OFF_WOUT + 2 * MB;
constexpr size_t OFF_WPG = OFF_WPLE + 1 * MB;
constexpr size_t OFF_UA = OFF_WPG + 2 * MB;
constexpr size_t OFF_ZS = OFF_UA + 40 * MB;
constexpr size_t OFF_Q = OFF_ZS + 32 * MB;
constexpr size_t OFF_K = OFF_Q + 32 * MB;
constexpr size_t OFF_VT = OFF_K + 32 * MB;
constexpr size_t OFF_ZN = OFF_VT + 32 * MB;
constexpr size_t OFF_MIX = OFF_Q;
constexpr size_t OFF_HB = OFF_VT;
constexpr size_t OFF_LAM = OFF_ZN + 32 * MB;
constexpr size_t OFF_BBAR = OFF_LAM + 3 * MB;
constexpr size_t OFF_KTAB = OFF_BBAR + 1 * MB;
constexpr size_t OFF_TQ = OFF_KTAB + 4 * MB;
constexpr size_t OFF_ERAW = OFF_TQ;
constexpr size_t OFF_PM = OFF_TQ + 80 * MB;
constexpr size_t OFF_S = OFF_PM + 16 * MB;
constexpr size_t OFF_YS = OFF_S + 16 * MB;
constexpr size_t OFF_SS = OFF_YS + 32 * MB;
constexpr size_t OFF_ESS = OFF_SS + 2 * MB;
constexpr size_t OFF_RSTD = OFF_ESS + 2 * MB;
constexpr size_t OFF_BAR = OFF_RSTD + 1 * MB;
constexpr size_t WS_END = OFF_BAR + 1 * MB;

#define TID ((int)(threadIdx.x & 255))
struct Params {
    const float *x, *p, *norm_pre, *norm_post, *w_in, *a_re, *a_im, *log_dt, *b_re, *b_im, *c_re, *c_im, *ssm_d, *w_glu, *b_glu, *rpb, *w_out, *w_ple, *ple_norm, *w_pg;
    float* out;
    unsigned char* ws;
};

__device__ __forceinline__ unsigned pk2(float lo, float hi) { unsigned r; asm("v_cvt_pk_bf16_f32 %0, %1, %2" : "=v"(r) : "v"(lo), "v"(hi)); return r; }
__device__ __forceinline__ float bflo(unsigned w) { return __uint_as_float(w << 16); }
__device__ __forceinline__ float bfhi(unsigned w) { return __uint_as_float(w & 0xffff0000u); }
__device__ __forceinline__ void store_bf4(bf16_t* p, f32x4 v) { u32x2 w; w.x = pk2(v[0], v[1]); w.y = pk2(v[2], v[3]); *(u32x2*)p = w; }
__device__ __forceinline__ f32x4 load_bf4(const bf16_t* p) { u32x2 w = *(const u32x2*)p; f32x4 v; v[0] = bflo(w.x); v[1] = bfhi(w.x); v[2] = bflo(w.y); v[3] = bfhi(w.y); return v; }
__device__ __forceinline__ float sigmoidf_(float v) { return 1.f / (1.f + __expf(-v)); }
__device__ __forceinline__ float gelu_tanh(float v) { const float u = 0.7978845608028654f * (v + 0.044715f * v * v * v); const float th = 1.f - 2.f / (__expf(2.f * u) + 1.f); return 0.5f * v * (1.f + th); }

constexpr int LDS_BYTES = 18 * 8192 + 2048;
namespace pg8 {
#define PG8_LAS __attribute__((address_space(3)))
constexpr int BM = 256, BK = 64, HALF = 128, HTB = HALF * BK * 2  , STAGE_BYTES = 8 * HTB;
__host__ __device__ __forceinline__ int lds_byte(int r, int c) { const int st = (r >> 4) * 2 + (c >> 5), rr = r & 15, cc = c & 31, ob = rr * 64 + cc * 2; return st * 1024 + (ob ^ (((ob >> 9) & 1) << 5)); }
__host__ __device__ __forceinline__ void stage_rc(int b, int& R, int& C) { const int st = b / 1024, sb = b % 1024, swz = sb ^ (((sb >> 9) & 1) << 5); R = (st >> 1) * 16 + swz / 64; C = (st & 1) * 32 + (swz % 64) / 2; }
__host__ __device__ __forceinline__ int perm32(int rho) { const int n = rho >> 4, i = rho & 15; return 8 * (i >> 2) + 4 * n + (i & 3); }
struct Unit { int pm, pn; };
struct Gemm { const bf16_t* A; const bf16_t* Bt; int lda, K; };
struct Order {
    int rank, R, n_x, nn, n0, m0, ns;
    __device__ __forceinline__ bool next(int i, Unit& u) const { const int l = rank + R * i; if (l >= n_x) return false; u.pn = n0 + (l % nn) * ns; u.pm = m0 + l / nn; return true; }
    __device__ __forceinline__ void a_ready(const Unit&) const {}
    __device__ __forceinline__ void done(const Unit&) const {}
};
template <class Epi, class Sched, bool ALIGN_EPI = false, bool SP2 = false>
__device__ __forceinline__ void gemm_phase(PG8_LAS unsigned char* lds, const Gemm g, const Sched& S, const Epi& E) {
    const int tid = threadIdx.x, wid = __builtin_amdgcn_readfirstlane(tid >> 6), lane = tid & 63, wr = wid >> 2, wc = wid & 3, fr = lane & 15, fq = lane >> 4;
    const int K = g.K, nt = K / BK;
    unsigned voffA[2], voffB[2];
#pragma unroll
    for (int i = 0; i < 2; ++i) { int R, C; stage_rc(tid * 16 + i * 8192, R, C); const int Rb = Epi::PERM ? ((R & ~31) + perm32(R & 31)) : R;
        voffA[i] = (unsigned)(R * g.lda + C) * 2u; voffB[i] = (unsigned)(Rb * K + C) * 2u; }
    const size_t kstep = (size_t)(BK * 2);
    const size_t hstep = (size_t)HALF * K * 2, hstepA = (size_t)HALF * g.lda * 2;
    const size_t tstep = 2 * hstep, tstepA = 2 * hstepA;
    const unsigned ldsw = (unsigned)wid * 1024u;
    const int aoff = lds_byte(wr * 64 + fr, fq * 8), boff = lds_byte(wc * 32 + fr, fq * 8);
#define PG8_SA(b, h) (((b) * 2 + (h)) * HTB)
#define PG8_SB(b, h) ((4 + (b) * 2 + (h)) * HTB)
#define PG8_STAGE(bufoff, gbase, voff) do { _Pragma("unroll") for (int _i = 0; _i < 2; ++_i) \
        __builtin_amdgcn_global_load_lds((const unsigned*)((const char*)(gbase) + (voff)[_i]), (PG8_LAS unsigned*)(lds + (bufoff) + ldsw + _i * 8192), 16, 0, 0); } while (0)
#define PG8_LDA(dst, b, h) do { _Pragma("unroll") for (int m = 0; m < 4; ++m) _Pragma("unroll") for (int k = 0; k < 2; ++k) dst[m][k] = *(const PG8_LAS bf16x8*)(lds + PG8_SA(b, h) + aoff + m * 2048 + k * 1024); } while (0)
#define PG8_LDB(dst, b, h) do { _Pragma("unroll") for (int n = 0; n < 2; ++n) _Pragma("unroll") for (int k = 0; k < 2; ++k) dst[n][k] = *(const PG8_LAS bf16x8*)(lds + PG8_SB(b, h) + boff + n * 2048 + k * 1024); } while (0)
#define PG8_MMA(ai, bj, At, Bt) do { __builtin_amdgcn_s_setprio(1); _Pragma("unroll") for (int m = 0; m < 4; ++m) _Pragma("unroll") for (int n = 0; n < 2; ++n) _Pragma("unroll") for (int k = 0; k < 2; ++k) \
        acc[ai][bj][m][n] = __builtin_amdgcn_mfma_f32_16x16x32_bf16(Bt[n][k], At[m][k], acc[ai][bj][m][n], 0, 0, 0); __builtin_amdgcn_s_setprio(0); } while (0)
#define PG8_WAIT_V(n) asm volatile("s_waitcnt vmcnt(" #n ")" ::: "memory")
#define PG8_WAIT_L(n) asm volatile("s_waitcnt lgkmcnt(" #n ")" ::: "memory")
#define PG8_BAR __builtin_amdgcn_s_barrier()
#define PG8_SCHED __builtin_amdgcn_sched_barrier(0)
    Unit cur, nxt; int ui = 0;
    if (!S.next(0, cur)) return;
    f32x4 acc[2][2][4][2];
#pragma unroll
    for (int a = 0; a < 2; ++a)
#pragma unroll
        for (int b = 0; b < 2; ++b)
#pragma unroll
            for (int m = 0; m < 4; ++m)
#pragma unroll
                for (int n = 0; n < 2; ++n) acc[a][b][m][n] = (f32x4){0.f, 0.f, 0.f, 0.f};
    bf16x8 At[4][2], B0[2][2], B1[2][2];
    const char* cA = (const char*)g.A + (size_t)cur.pm * tstepA; const char* cB = (const char*)g.Bt + (size_t)cur.pn * tstep;
    S.a_ready(cur);
    if constexpr (SP2) {
        PG8_STAGE(PG8_SB(0, 0), cB, voffB); PG8_STAGE(PG8_SB(0, 1), cB + hstep, voffB); PG8_STAGE(PG8_SA(0, 0), cA, voffA); PG8_STAGE(PG8_SA(0, 1), cA + hstepA, voffA);
        if (wr == 1) PG8_BAR;
        PG8_WAIT_V(2); PG8_BAR;
        PG8_STAGE(PG8_SB(1, 0), cB + kstep, voffB); PG8_STAGE(PG8_SA(1, 0), cA + kstep, voffA); PG8_STAGE(PG8_SB(1, 1), cB + hstep + kstep, voffB);
        PG8_WAIT_V(6); PG8_BAR;
    } else {
        PG8_STAGE(PG8_SB(0, 0), cB, voffB); PG8_STAGE(PG8_SA(0, 0), cA, voffA); PG8_STAGE(PG8_SB(0, 1), cB + hstep, voffB); PG8_STAGE(PG8_SA(0, 1), cA + hstepA, voffA);
        if (wr == 1) PG8_BAR;
        PG8_WAIT_V(4); PG8_BAR;
        PG8_STAGE(PG8_SB(1, 0), cB + kstep, voffB); PG8_STAGE(PG8_SA(1, 0), cA + kstep, voffA); PG8_STAGE(PG8_SB(1, 1), cB + hstep + kstep, voffB);
        PG8_WAIT_V(6); PG8_BAR;
    }
    for (;;) {
        const bool has_next = S.next(ui + 1, nxt);
        const char* nA = has_next ? (const char*)g.A + (size_t)nxt.pm * tstepA : cA; const char* nB = has_next ? (const char*)g.Bt + (size_t)nxt.pn * tstep : cB;
        for (int t = 0; t < nt; t += 2) {
            const bool last = (t == nt - 2);
            const char* a1 = cA + (size_t)(t + 1) * kstep;
            const char* a2 = last ? nA : cA + (size_t)(t + 2) * kstep; const char* b2 = last ? nB : cB + (size_t)(t + 2) * kstep;
            const char* a3 = a2 + kstep; const char* b3 = b2 + kstep;
            if (last && has_next) S.a_ready(nxt);
            if constexpr (SP2) {
            PG8_LDB(B0, 0, 0); PG8_LDB(B1, 0, 1); PG8_SCHED; PG8_LDA(At, 0, 0); PG8_STAGE(PG8_SA(1, 1), a1 + hstepA, voffA);
            PG8_WAIT_V(8); PG8_WAIT_L(0); PG8_BAR; PG8_MMA(0, 0, At, B0); PG8_MMA(0, 1, At, B1); PG8_BAR; PG8_SCHED;
            PG8_LDA(At, 0, 1); PG8_STAGE(PG8_SB(0, 0), b2, voffB); PG8_STAGE(PG8_SB(0, 1), b2 + hstep, voffB); PG8_STAGE(PG8_SA(0, 0), a2, voffA);
            PG8_WAIT_V(8); PG8_WAIT_L(0); PG8_BAR; PG8_MMA(1, 0, At, B0); PG8_MMA(1, 1, At, B1); PG8_BAR; PG8_SCHED;
            PG8_LDB(B0, 1, 0); PG8_LDB(B1, 1, 1); PG8_SCHED; PG8_LDA(At, 1, 0); PG8_STAGE(PG8_SA(0, 1), a2 + hstepA, voffA);
            PG8_WAIT_V(8); PG8_WAIT_L(0); PG8_BAR; PG8_MMA(0, 0, At, B0); PG8_MMA(0, 1, At, B1); PG8_BAR; PG8_SCHED;
            PG8_LDA(At, 1, 1); PG8_STAGE(PG8_SB(1, 0), b3, voffB); PG8_STAGE(PG8_SB(1, 1), b3 + hstep, voffB); PG8_STAGE(PG8_SA(1, 0), a3, voffA);
            PG8_WAIT_V(8); PG8_WAIT_L(0); PG8_BAR; PG8_MMA(1, 0, At, B0); PG8_MMA(1, 1, At, B1); PG8_BAR; PG8_SCHED;
            } else {
            PG8_LDB(B0, 0, 0); PG8_SCHED; PG8_LDA(At, 0, 0); PG8_STAGE(PG8_SA(1, 1), a1 + hstepA, voffA);
            PG8_WAIT_L(8); PG8_BAR; PG8_WAIT_L(0); PG8_MMA(0, 0, At, B0); PG8_BAR; PG8_SCHED;
            PG8_LDB(B1, 0, 1); PG8_STAGE(PG8_SB(0, 0), b2, voffB);
            PG8_BAR; PG8_WAIT_L(0); PG8_MMA(0, 1, At, B1); PG8_BAR;
            PG8_LDA(At, 0, 1); PG8_STAGE(PG8_SA(0, 0), a2, voffA);
            PG8_BAR; PG8_WAIT_L(0); PG8_MMA(1, 0, At, B0); PG8_BAR; PG8_SCHED;
            PG8_STAGE(PG8_SB(0, 1), b2 + hstep, voffB);
            PG8_WAIT_V(6); PG8_BAR; PG8_MMA(1, 1, At, B1); PG8_BAR;
            PG8_LDB(B0, 1, 0); PG8_SCHED; PG8_LDA(At, 1, 0); PG8_STAGE(PG8_SA(0, 1), a2 + hstepA, voffA);
            PG8_WAIT_L(8); PG8_BAR; PG8_WAIT_L(0); PG8_MMA(0, 0, At, B0); PG8_BAR; PG8_SCHED;
            PG8_LDB(B1, 1, 1); PG8_STAGE(PG8_SB(1, 0), b3, voffB);
            PG8_BAR; PG8_WAIT_L(0); PG8_MMA(0, 1, At, B1); PG8_BAR;
            PG8_LDA(At, 1, 1); PG8_STAGE(PG8_SA(1, 0), a3, voffA);
            PG8_BAR; PG8_WAIT_L(0); PG8_MMA(1, 0, At, B0); PG8_BAR; PG8_SCHED;
            PG8_STAGE(PG8_SB(1, 1), b3 + hstep, voffB);
            PG8_WAIT_V(6); PG8_BAR; PG8_MMA(1, 1, At, B1); PG8_BAR;
            }
        }
        if constexpr (ALIGN_EPI) { if (wr == 0) PG8_BAR; }
        if constexpr (!Epi::AFTER_DRAIN) { E(acc, cur, wr, wc, fr, fq); S.done(cur); }
        if (!has_next) break;
#pragma unroll
        for (int a = 0; a < 2; ++a)
#pragma unroll
            for (int b = 0; b < 2; ++b)
#pragma unroll
                for (int m = 0; m < 4; ++m)
#pragma unroll
                    for (int n = 0; n < 2; ++n) acc[a][b][m][n] = (f32x4){0.f, 0.f, 0.f, 0.f};
        cur = nxt; cA = nA; cB = nB; ++ui;
        if constexpr (ALIGN_EPI) { if (wr == 1) PG8_BAR; }
    }
    PG8_WAIT_V(0);
    if constexpr (!ALIGN_EPI) { if (wr == 0) PG8_BAR; }
    PG8_BAR;
    if constexpr (Epi::AFTER_DRAIN) { E.fused(acc, cur, wr, wc, fr, fq, lds, wid, lane); S.done(cur); }
#undef PG8_SA
#undef PG8_SB
#undef PG8_STAGE
#undef PG8_LDA
#undef PG8_LDB
#undef PG8_MMA
#undef PG8_WAIT_V
#undef PG8_WAIT_L
#undef PG8_BAR
#undef PG8_SCHED
}
}

#define EPI_ROWS(...) _Pragma("unroll") for (int ai = 0; ai < 2; ++ai) _Pragma("unroll") for (int m = 0; m < 4; ++m) { const int row = u.pm * 256 + ai * 128 + wr * 64 + m * 16 + fr; __VA_ARGS__ asm volatile("" ::: "memory"); }
#define EPI_COLS(...) _Pragma("unroll") for (int bj = 0; bj < 2; ++bj) _Pragma("unroll") for (int n = 0; n < 2; ++n) { const int col = u.pn * 256 + bj * 128 + wc * 32 + n * 16 + fq * 4; const f32x4 v = acc[ai][bj][m][n]; __VA_ARGS__ }
typedef f32x4 acc_t[2][2][4][2];
struct EpiInProj {
    static constexpr bool PERM = false, AFTER_DRAIN = false;
    unsigned char* ws;
    __device__ __forceinline__ void operator()(const acc_t& acc, const pg8::Unit& u, int wr, int wc, int fr, int fq) const {
        const int sec = (u.pn * 256) >> 9;
        EPI_ROWS( const int t = row; EPI_COLS( const int nn = col & 511;
            if (sec == 0) { const int g = nn >> 4, hh = nn & 15, ch = t / LC, j = t % LC; store_bf4((bf16_t*)(ws + OFF_UA) + ((size_t)(g * NCH + ch)) * KA + j * 16 + hh, v); }
            else if (sec == 1) store_bf4((bf16_t*)(ws + OFF_ZS) + (size_t)t * 512 + nn, v);
            else if (sec == 2) store_bf4((bf16_t*)(ws + OFF_Q) + (size_t)t * 512 + nn, v * 0.125f);
            else if (sec == 3) store_bf4((bf16_t*)(ws + OFF_K) + (size_t)t * 512 + nn, v);
            else if (sec == 4) { const int b = t >> 13, l = t & 8191; bf16_t* vt = (bf16_t*)(ws + OFF_VT) + ((size_t)(b * 512 + nn)) * SEQ + l; const unsigned w0 = pk2(v[0], v[1]), w1 = pk2(v[2], v[3]);
                vt[0] = (bf16_t)(w0 & 0xffff); vt[SEQ] = (bf16_t)(w0 >> 16); vt[2 * SEQ] = (bf16_t)(w1 & 0xffff); vt[3 * SEQ] = (bf16_t)(w1 >> 16); }
            else store_bf4((bf16_t*)(ws + OFF_ZN) + (size_t)t * 512 + nn, v); ) )
    }
};
struct EpiS {
    static constexpr bool PERM = false, AFTER_DRAIN = false;
    float* S;
    __device__ __forceinline__ void operator()(const acc_t& acc, const pg8::Unit& u, int wr, int wc, int fr, int fq) const {
        EPI_ROWS( EPI_COLS( *(f32x4*)(S + (size_t)row * NS + col) = v; ) )
    }
};
struct EpiY {
    static constexpr bool PERM = false, AFTER_DRAIN = false;
    bf16_t* ys; int g;
    __device__ __forceinline__ void operator()(const acc_t& acc, const pg8::Unit& u, int wr, int wc, int fr, int fq) const {
        EPI_ROWS( EPI_COLS( const int i = col >> 4, h = col & 15; f32x4 o;
            _Pragma("unroll") for (int e = 0; e < 4; ++e) o[e] = gelu_tanh(v[e]);
            store_bf4(ys + ((size_t)row * LC + i) * 512 + g * 16 + h, o); ) )
    }
};
struct EpiGlu {
    static constexpr bool PERM = false, AFTER_DRAIN = false;
    const bf16_t* ys; const bf16_t* zs; const float* bglu; bf16_t* mixin;
    __device__ __forceinline__ void operator()(const acc_t& acc, const pg8::Unit& u, int wr, int wc, int fr, int fq) const {
        const int colb = u.pn * 256 + wc * 32 + fq * 4, rowb = u.pm * 256 + wr * 64 + fr;
        f32x4 bv[4]; u32x2 yv[2][4], zv[2][4];
#pragma unroll
        for (int c = 0; c < 4; ++c) bv[c] = *(const f32x4*)(bglu + colb + (c >> 1) * 128 + (c & 1) * 16);
#define GLU_LOAD(G, B) do { const size_t ro_ = (size_t)(rowb + ((G) >> 2) * 128 + ((G) & 3) * 16) * 512 + colb; _Pragma("unroll") for (int c = 0; c < 4; ++c) { \
        yv[B][c] = *(const u32x2*)(ys + ro_ + (c >> 1) * 128 + (c & 1) * 16); zv[B][c] = *(const u32x2*)(zs + ro_ + (c >> 1) * 128 + (c & 1) * 16); } } while (0)
        GLU_LOAD(0, 0);
#pragma unroll
        for (int g = 0; g < 8; ++g) {
            if (g < 7) GLU_LOAD(g + 1, (g + 1) & 1);
            __builtin_amdgcn_sched_barrier(0);
            const size_t ro = (size_t)(rowb + (g >> 2) * 128 + (g & 3) * 16) * 1024 + colb;
#pragma unroll
            for (int c = 0; c < 4; ++c) {
                const f32x4 v = acc[g >> 2][c >> 1][g & 3][c & 1]; const u32x2 yw = yv[g & 1][c], zw = zv[g & 1][c];
                const float y[4] = {bflo(yw.x), bfhi(yw.x), bflo(yw.y), bfhi(yw.y)}, z[4] = {bflo(zw.x), bfhi(zw.x), bflo(zw.y), bfhi(zw.y)}; f32x4 o;
#pragma unroll
                for (int e = 0; e < 4; ++e) o[e] = y[e] * sigmoidf_(v[e] + bv[c][e]) * z[e] * sigmoidf_(z[e]);
                store_bf4(mixin + ro + (c >> 1) * 128 + (c & 1) * 16, o);
            }
            __builtin_amdgcn_sched_barrier(0);
        }
#undef GLU_LOAD
    }
};
struct EpiStoreSS {
    static constexpr bool PERM = false, AFTER_DRAIN = false;
    bf16_t* dst; float* ss;
    __device__ __forceinline__ void operator()(const acc_t& acc, const pg8::Unit& u, int wr, int wc, int fr, int fq) const {
        EPI_ROWS( float s = 0.f;
            EPI_COLS( s += (v[0] * v[0] + v[1] * v[1]) + (v[2] * v[2] + v[3] * v[3]); store_bf4(dst + (size_t)row * 1024 + col, v); )
            s += __shfl_xor(s, 16); s += __shfl_xor(s, 32);
            if (fq == 0) ss[(size_t)row * 16 + u.pn * 4 + wc] = s; )
    }
};
struct EpiFinal {
    static constexpr bool PERM = false, AFTER_DRAIN = false;
    const bf16_t* hb; const bf16_t* eraw; const float* rstd; const float* gple; float* out;
    __device__ __forceinline__ void operator()(const acc_t& acc, const pg8::Unit& u, int wr, int wc, int fr, int fq) const {
        const int colb = u.pn * 256 + wc * 32 + fq * 4, rowb = u.pm * 256 + wr * 64 + fr;
        f32x4 ge[4]; u32x2 hv[2][4], ev[2][4]; float re[2];
#pragma unroll
        for (int c = 0; c < 4; ++c) ge[c] = *(const f32x4*)(gple + colb + (c >> 1) * 128 + (c & 1) * 16);
#define FIN_LOAD(G, B) do { const int row_ = rowb + ((G) >> 2) * 128 + ((G) & 3) * 16; const size_t ro_ = (size_t)row_ * 1024 + colb; re[B] = rstd[T + row_]; _Pragma("unroll") for (int c = 0; c < 4; ++c) { \
        hv[B][c] = *(const u32x2*)(hb + ro_ + (c >> 1) * 128 + (c & 1) * 16); ev[B][c] = *(const u32x2*)(eraw + ro_ + (c >> 1) * 128 + (c & 1) * 16); } } while (0)
        FIN_LOAD(0, 0);
#pragma unroll
        for (int g = 0; g < 8; ++g) {
            if (g < 7) FIN_LOAD(g + 1, (g + 1) & 1);
            __builtin_amdgcn_sched_barrier(0);
            const size_t ro = (size_t)(rowb + (g >> 2) * 128 + (g & 3) * 16) * 1024 + colb; const float rr = re[g & 1];
#pragma unroll
            for (int c = 0; c < 4; ++c) {
                const f32x4 v = acc[g >> 2][c >> 1][g & 3][c & 1]; const u32x2 hw = hv[g & 1][c], ew = ev[g & 1][c];
                const float h[4] = {bflo(hw.x), bfhi(hw.x), bflo(hw.y), bfhi(hw.y)}, e4[4] = {bflo(ew.x), bfhi(ew.x), bflo(ew.y), bfhi(ew.y)}; f32x4 o;
#pragma unroll
                for (int e = 0; e < 4; ++e) o[e] = h[e] + sigmoidf_(v[e]) * (e4[e] * rr * ge[c][e]);
                *(f32x4*)(out + ro + (c >> 1) * 128 + (c & 1) * 16) = o;
            }
            __builtin_amdgcn_sched_barrier(0);
        }
#undef FIN_LOAD
    }
};

__device__ __forceinline__ void ktab_unit(const Params& P, int u, float* ldsf) {
    const int dir = u >> 8, g = (u >> 3) & 31, mr = u & 7, tid = TID;
    float2* lp = (float2*)ldsf;
    float2* bb = lp + 64 * 65;
    float2* cc = bb + 64 * 16;
    float2* lampow = (float2*)(P.ws + OFF_LAM); float2* bbar = (float2*)(P.ws + OFF_BBAR); float* ktab = (float*)(P.ws + OFF_KTAB);
    if (tid < 64) {
        const int p = tid, idx = (dir * 32 + g) * 64 + p;
        const float ar = P.a_re[idx], ai = P.a_im[idx], dt = expf(P.log_dt[dir * 32 + g]);
        const float mag = expf(dt * ar), ang = dt * ai; const float lr = mag * cosf(ang), li = mag * sinf(ang);
        const float nr = lr - 1.f, ni = li, den = ar * ar + ai * ai;
        const float cr = (nr * ar + ni * ai) / den, ci = (ni * ar - nr * ai) / den;
        float brv[16], biv[16];
#pragma unroll
        for (int h = 0; h < 16; ++h) { brv[h] = P.b_re[idx * 16 + h]; biv[h] = P.b_im[idx * 16 + h]; }
        float pr = 1.f, pi = 0.f;
        for (int m = 0; m <= 64; ++m) { lp[p * 65 + m] = make_float2(pr, pi); if (mr == 0) lampow[(size_t)idx * 65 + m] = make_float2(pr, pi); const float tt = pr * lr - pi * li; pi = pr * li + pi * lr; pr = tt; }
#pragma unroll
        for (int h = 0; h < 16; ++h) { const float2 v = make_float2(cr * brv[h] - ci * biv[h], cr * biv[h] + ci * brv[h]); bb[p * 16 + h] = v; if (mr == 0) bbar[(size_t)idx * 16 + h] = v; }
    }
#pragma unroll
    for (int i = 0; i < 4; ++i) { const int e = tid + 256 * i; cc[(e >> 6) * 65 + (e & 63)] = make_float2(P.c_re[(dir * 32 + g) * 1024 + e], P.c_im[(dir * 32 + g) * 1024 + e]); }
    __syncthreads();
    const int h = tid >> 4, h2 = tid & 15;
    float s[8];
#pragma unroll
    for (int mm = 0; mm < 8; ++mm) s[mm] = 0.f;
    for (int p = 0; p < 64; ++p) {
        const float2 c = cc[h * 65 + p], b = bb[p * 16 + h2];
        const float cbx = c.x * b.x - c.y * b.y, cby = c.x * b.y + c.y * b.x;
#pragma unroll
        for (int mm = 0; mm < 8; ++mm) { const float2 l = lp[p * 65 + mr * 8 + mm]; s[mm] += cbx * l.x - cby * l.y; }
    }
#pragma unroll
    for (int mm = 0; mm < 8; ++mm) ktab[((size_t)((dir * 32 + g) * 64 + mr * 8 + mm)) * 256 + h * 16 + h2] = s[mm];
    __syncthreads();
}
__device__ __forceinline__ void transpose_unit(const float* W, int K, int N, const float* gain, bf16_t* Wt, int item, float* ldsf) {
    const int nblk = N / 64, kb = item / nblk, nbk = item % nblk, k0 = kb * 64, n0 = nbk * 64, tid = TID;
#pragma unroll 4
    for (int i = 0; i < 16; ++i) { const int kk = i * 4 + (tid >> 6), nn = tid & 63; float v = W[(size_t)(k0 + kk) * N + n0 + nn]; if (gain) v *= gain[k0 + kk]; ldsf[kk * 65 + nn] = v; }
    __syncthreads();
#pragma unroll 4
    for (int i = 0; i < 8; ++i) { const int nn = i * 8 + (tid >> 5), kk = (tid & 31) * 2; *(unsigned*)(Wt + (size_t)(n0 + nn) * K + k0 + kk) = pk2(ldsf[kk * 65 + nn], ldsf[(kk + 1) * 65 + nn]); }
    __syncthreads();
}
__device__ __forceinline__ float wave_sum(float v) {
#pragma unroll
    for (int o = 1; o < 64; o <<= 1) v += __shfl_xor(v, o);
    return v;
}
__device__ __forceinline__ void phase0(const Params& P, int bid, int nb, unsigned char* lds) {
    float* ldsf = (float*)(lds + (threadIdx.x >> 8) * 65536);
    const int vb = bid * 2 + (threadIdx.x >> 8), nvb = nb * 2;
    constexpr int U_K = 512, I_IN = 16 * 48, I_GLU = 64, I_OUT = 256, I_PLE = 4 * 16, I_PG = 256, U_T = I_IN + I_GLU + I_OUT + I_PLE + I_PG, U_X = T / 16, U_P = (T * DPLE) / 4096;
    constexpr int NU = U_K + U_T + U_X + U_P;
    const int tid = TID, lane = tid & 63, wid = tid >> 6;
    for (int u = vb; u < NU; u += nvb) {
        int r = u;
        if (r < U_K) { ktab_unit(P, r, ldsf); continue; } r -= U_K;
        if (r < U_T) {
            if (r < I_IN) { transpose_unit(P.w_in, 1024, 3072, P.norm_pre, (bf16_t*)(P.ws + OFF_WIN), r, ldsf); continue; } r -= I_IN;
            if (r < I_GLU) { transpose_unit(P.w_glu, 512, 512, nullptr, (bf16_t*)(P.ws + OFF_WGLU), r, ldsf); continue; } r -= I_GLU;
            if (r < I_OUT) { transpose_unit(P.w_out, 1024, 1024, nullptr, (bf16_t*)(P.ws + OFF_WOUT), r, ldsf); continue; } r -= I_OUT;
            if (r < I_PLE) { transpose_unit(P.w_ple, 256, 1024, nullptr, (bf16_t*)(P.ws + OFF_WPLE), r, ldsf); continue; } r -= I_PLE;
            transpose_unit(P.w_pg, 1024, 1024, nullptr, (bf16_t*)(P.ws + OFF_WPG), r, ldsf); continue;
        }
        r -= U_T;
        if (r < U_X) {
            const int t = r * 16 + wid * 4; const f32x4* xr = (const f32x4*)(P.x + (size_t)t * 1024) + lane; f32x4 v[16]; float s[4];
#pragma unroll
            for (int j = 0; j < 16; ++j) v[j] = xr[64 * j];
#pragma unroll
            for (int q = 0; q < 4; ++q) { float a = 0.f;
#pragma unroll
                for (int j = 0; j < 4; ++j) { const f32x4 w = v[4 * q + j]; a += (w[0] * w[0] + w[1] * w[1]) + (w[2] * w[2] + w[3] * w[3]); }
                s[q] = rsqrtf(wave_sum(a) * (1.f / 1024.f) + EPS); }
            bf16_t* o = (bf16_t*)(P.ws + OFF_XN) + (size_t)t * 1024 + lane * 4;
#pragma unroll
            for (int q = 0; q < 4; ++q)
#pragma unroll
                for (int j = 0; j < 4; ++j) store_bf4(o + q * 1024 + 256 * j, v[4 * q + j] * s[q]);
            continue;
        }
        r -= U_X;
        {
            const size_t e0 = (size_t)r * 4096 + tid * 8; f32x4 a[2], c[2];
#pragma unroll
            for (int h = 0; h < 2; ++h) { a[h] = *(const f32x4*)(P.p + e0 + h * 2048); c[h] = *(const f32x4*)(P.p + e0 + h * 2048 + 4); }
#pragma unroll
            for (int h = 0; h < 2; ++h) { u32x4 w; w.x = pk2(a[h][0], a[h][1]); w.y = pk2(a[h][2], a[h][3]); w.z = pk2(c[h][0], c[h][1]); w.w = pk2(c[h][2], c[h][3]);
                *(u32x4*)((bf16_t*)(P.ws + OFF_PB) + e0 + h * 2048) = w; }
        }
    }
}

__device__ __forceinline__ void tq_unit(const Params& P, int u) {
    static_assert(LC == 64, "tq_unit / pm_unit thread maps assume 64-token chunks");
    const int g = u / LC, i = u % LC, tid = TID;
    const float* ktab = (const float*)(P.ws + OFF_KTAB); const float2* lampow = (const float2*)(P.ws + OFF_LAM); bf16_t* tq = (bf16_t*)(P.ws + OFF_TQ);
    const int h2 = (tid & 7) * 2;
#pragma unroll
    for (int half = 0; half < 2; ++half) {
        const int j = (tid >> 3) + 32 * half;
        const int ma = i > j ? i - j : 0, mb = j > i ? j - i : 0;
        const float wa = i >= j ? 1.f : 0.f, wb = j >= i ? 1.f : 0.f;
        const float* kf = ktab + ((size_t)((0 * 32 + g) * 64 + ma)) * 256 + h2; const float* kb = ktab + ((size_t)((1 * 32 + g) * 64 + mb)) * 256 + h2;
        float2 a[16], b[16];
#pragma unroll
        for (int h = 0; h < 16; ++h) { a[h] = *(const float2*)(kf + h * 16); b[h] = *(const float2*)(kb + h * 16); }
#pragma unroll
        for (int h = 0; h < 16; ++h) {
            float v0 = wa * a[h].x + wb * b[h].x, v1 = wa * a[h].y + wb * b[h].y;
            if (i == j) { const float dd = P.ssm_d[g * 16 + h]; v0 += (h == h2 ? dd : 0.f); v1 += (h == h2 + 1 ? dd : 0.f); }
            *(unsigned*)(tq + ((size_t)(g * KU + i * 16 + h)) * KA + j * 16 + h2) = pk2(v0, v1);
        }
    }
    {
        const int pn = tid & 127, dir = pn >> 6, p = pn & 63, m = dir == 0 ? i + 1 : LC - i;
        const float2 l = lampow[((size_t)((dir * 32 + g) * 64 + p)) * 65 + m];
        float cr[8], ci[8];
#pragma unroll
        for (int it = 0; it < 8; ++it) { const int h = it * 2 + (tid >> 7); cr[it] = P.c_re[((dir * 32 + g) * 16 + h) * 64 + p]; ci[it] = P.c_im[((dir * 32 + g) * 16 + h) * 64 + p]; }
#pragma unroll
        for (int it = 0; it < 8; ++it) { const int h = it * 2 + (tid >> 7);
            *(unsigned*)(tq + ((size_t)(g * KU + i * 16 + h)) * KA + KU + dir * 128 + p * 2) = pk2(cr[it] * l.x - ci[it] * l.y, -(cr[it] * l.y + ci[it] * l.x)); }
    }
}
__device__ __forceinline__ void pm_unit(const Params& P, int u) {
    const int g = u >> 4, rg = u & 15, tid = TID;
    const float2* lampow = (const float2*)(P.ws + OFF_LAM); const float2* bbar = (const float2*)(P.ws + OFF_BBAR); bf16_t* pm = (bf16_t*)(P.ws + OFF_PM);
    const int h2 = (tid & 7) * 2;
#pragma unroll 4
    for (int q = 0; q < 8; ++q) {
        const int pidx = rg * 8 + q, dir = pidx >> 6, p = pidx & 63;
        const f32x4 bq = *(const f32x4*)(bbar + ((size_t)((dir * 32 + g) * 64 + p)) * 16 + h2);
#pragma unroll
        for (int half = 0; half < 2; ++half) {
            const int j = (tid >> 3) + 32 * half, m = dir == 0 ? LC - 1 - j : j;
            const float2 l = lampow[((size_t)((dir * 32 + g) * 64 + p)) * 65 + m];
            bf16_t* dst = pm + ((size_t)(g * NS + 2 * pidx)) * KU + j * 16 + h2;
            *(unsigned*)dst = pk2(l.x * bq[0] - l.y * bq[1], l.x * bq[2] - l.y * bq[3]);
            *(unsigned*)(dst + KU) = pk2(l.x * bq[1] + l.y * bq[0], l.x * bq[3] + l.y * bq[2]);
        }
    }
}
__device__ __forceinline__ void phase1(const Params& P, int bid, int nb, unsigned char* lds) {
    constexpr int U_TQ = 32 * LC, U_PM = 32 * 16;
    const int xcd = bid & 7, rank = bid >> 3, R = nb >> 3;
    {
        const pg8::Gemm g{(const bf16_t*)(P.ws + OFF_XN), (const bf16_t*)(P.ws + OFF_WIN), 1024, 1024};
        const pg8::Order S{rank, R, 192, 6, xcd & 1, (xcd >> 1) * 32, 2}; const EpiInProj E{P.ws};
        pg8::gemm_phase<EpiInProj, pg8::Order, true, true>((PG8_LAS unsigned char*)lds, g, S, E);
    }
    const int vb = bid * 2 + (threadIdx.x >> 8), nvb = nb * 2;
    for (int u = vb; u < U_PM; u += nvb) pm_unit(P, u);
}

__device__ __forceinline__ void na_unit(const Params& P, int u, float* ldsf) {
    const int tid = TID, lane = tid & 63, cb = tid >> 6, fr = lane & 15, fq = lane >> 4;
    const int r = u & 127, head = (u >> 7) & 7, b = u >> 10;
    const bf16_t* q = (const bf16_t*)(P.ws + OFF_Q); const bf16_t* k = (const bf16_t*)(P.ws + OFF_K); const bf16_t* vt = (const bf16_t*)(P.ws + OFF_VT); const bf16_t* zn = (const bf16_t*)(P.ws + OFF_ZN);
    bf16_t* mixin = (bf16_t*)(P.ws + OFF_MIXIN);
    for (int i = tid; i < 15 * 31; i += 256) ldsf[i] = P.rpb[head * 15 * 31 + i];
    const int rs = min(max(r - 4, 0), 120);
    const int cw0 = cb == 0 ? 0 : (cb == 1 ? 8 : (cb == 2 ? 24 : 32));
    const int c = cb * 16 + fr, cs = min(max(c - 8, 0), 48);
    const size_t tq = (size_t)b * SEQ + r * 64 + c;
    const bf16x8 qf0 = *(const bf16x8*)(q + tq * 512 + head * 64 + fq * 8), qf1 = *(const bf16x8*)(q + tq * 512 + head * 64 + 32 + fq * 8);
    f32x4 s[16];
    const int kcol = cw0 + (fr >> 2) * 8 + (fr & 3);
    const bf16_t* kbase = k + ((size_t)b * SEQ + rs * 64 + kcol) * 512 + head * 64 + fq * 8;
#pragma unroll
    for (int hf = 0; hf < 2; ++hf) {
        bf16x8 k0[8], k1[8];
#pragma unroll
        for (int t = 0; t < 8; ++t) { const int tt = hf * 8 + t; const bf16_t* kp = kbase + ((size_t)(tt >> 1) * 64 + (tt & 1) * 4) * 512; k0[t] = *(const bf16x8*)kp; k1[t] = *(const bf16x8*)(kp + 32); }
#pragma unroll
        for (int t = 0; t < 8; ++t) {
            f32x4 z = (f32x4){0.f, 0.f, 0.f, 0.f};
            z = __builtin_amdgcn_mfma_f32_16x16x32_bf16(k0[t], qf0, z, 0, 0, 0);
            z = __builtin_amdgcn_mfma_f32_16x16x32_bf16(k1[t], qf1, z, 0, 0, 0);
            s[hf * 8 + t] = z;
        }
    }
    __syncthreads();
    float mx = -3.0e38f;
#pragma unroll
    for (int t = 0; t < 16; ++t) {
        const int i = t >> 1, odd = t & 1, dr = rs + i - r + 7;
#pragma unroll
        for (int e = 0; e < 4; ++e) {
            const int ck = cw0 + fq * 8 + odd * 4 + e; const bool valid = (ck >= cs) && (ck < cs + 16);
            const int dc = min(max(ck - c + 15, 0), 30);
            const float bv = ldsf[dr * 31 + dc];
            const float sv = valid ? s[t][e] + bv : -3.0e38f;
            s[t][e] = sv; mx = fmaxf(mx, sv);
        }
    }
    mx = fmaxf(mx, __shfl_xor(mx, 16)); mx = fmaxf(mx, __shfl_xor(mx, 32));
    float l = 0.f;
#pragma unroll
    for (int t = 0; t < 16; ++t)
#pragma unroll
        for (int e = 0; e < 4; ++e) { const float pv = __expf(s[t][e] - mx); s[t][e] = pv; l += pv; }
    l += __shfl_xor(l, 16); l += __shfl_xor(l, 32);
    f32x4 o[4];
#pragma unroll
    for (int dt = 0; dt < 4; ++dt) o[dt] = (f32x4){0.f, 0.f, 0.f, 0.f};
    const bf16_t* vbase = vt + ((size_t)(b * 512 + head * 64 + fr)) * SEQ + rs * 64 + cw0 + fq * 8;
#pragma unroll
    for (int k2 = 0; k2 < 4; ++k2) {
        bf16x8 vf[2][4];
#pragma unroll
        for (int kk = 0; kk < 2; ++kk)
#pragma unroll
            for (int dt = 0; dt < 4; ++dt) vf[kk][dt] = *(const bf16x8*)(vbase + (size_t)dt * 16 * SEQ + (k2 * 2 + kk) * 64);
#pragma unroll
        for (int kk = 0; kk < 2; ++kk) {
            const int kq = k2 * 2 + kk;
            u32x4 pw; pw.x = pk2(s[2 * kq][0], s[2 * kq][1]); pw.y = pk2(s[2 * kq][2], s[2 * kq][3]); pw.z = pk2(s[2 * kq + 1][0], s[2 * kq + 1][1]); pw.w = pk2(s[2 * kq + 1][2], s[2 * kq + 1][3]);
            const bf16x8 pf = __builtin_bit_cast(bf16x8, pw);
#pragma unroll
            for (int dt = 0; dt < 4; ++dt) o[dt] = __builtin_amdgcn_mfma_f32_16x16x32_bf16(vf[kk][dt], pf, o[dt], 0, 0, 0);
        }
    }
    const float inv = 1.f / l;
#pragma unroll
    for (int dt = 0; dt < 4; ++dt) {
        const int d0 = head * 64 + dt * 16 + fq * 4; const f32x4 z = load_bf4(zn + tq * 512 + d0); f32x4 ov;
#pragma unroll
        for (int e = 0; e < 4; ++e) ov[e] = o[dt][e] * inv * z[e] * sigmoidf_(z[e]);
        store_bf4(mixin + tq * 1024 + 512 + d0, ov);
    }
    __syncthreads();
}
constexpr int NA_KOFF = 0, NA_VOFF = 9 * 8192, NA_BOFF = 18 * 8192, NA_LDS = NA_BOFF + 2048;
__device__ __forceinline__ void na_block(const Params& P, int unit, unsigned char* lds) {
    const int tid = threadIdx.x, lane = tid & 63, w = tid >> 6, qrow = w >> 2, cb = w & 3, fr = lane & 15, fq = lane >> 4;
    const int seg = unit & 7, head = (unit >> 3) & 7, b = unit >> 6;
    const bf16_t* q = (const bf16_t*)(P.ws + OFF_Q); const bf16_t* k = (const bf16_t*)(P.ws + OFF_K); const bf16_t* vt = (const bf16_t*)(P.ws + OFF_VT); const bf16_t* zn = (const bf16_t*)(P.ws + OFF_ZN);
    bf16_t* mixin = (bf16_t*)(P.ws + OFF_MIXIN);
    float* bias = (float*)(lds + NA_BOFF);
    do { asm volatile("s_waitcnt vmcnt(0) lgkmcnt(0)" ::: "memory"); __syncthreads(); } while (0);
    for (int i = tid; i < 15 * 31; i += 512) bias[i] = P.rpb[head * 15 * 31 + i];
    const int st_r = tid >> 3, st_c = tid & 7;
    const int ksw = st_r * 128 + ((st_c ^ (((st_r >> 1) & 1) | (((st_r >> 3) & 3) << 1))) * 16);
    const int vsw = st_r * 128 + ((st_c ^ (st_r & 7)) * 16);
    const bf16_t* kst = k + ((size_t)b * SEQ + st_r) * 512 + head * 64 + st_c * 8;
    const bf16_t* vst = vt + ((size_t)(b * 512 + head * 64 + st_r)) * SEQ + st_c * 8;
    const int cw0 = cb == 0 ? 0 : (cb == 1 ? 8 : (cb == 2 ? 24 : 32));
    const int c = cb * 16 + fr, cs = min(max(c - 8, 0), 48);
    const int kcol = cw0 + (fr >> 2) * 8 + (fr & 3);
    const int sK = ((kcol >> 1) & 1) | (((kcol >> 3) & 3) << 1);
    const int kfo0 = kcol * 128 + ((fq ^ sK) * 16), kfo1 = kcol * 128 + (((4 + fq) ^ sK) * 16);
    const int vfo = fr * 128 + ((((cw0 >> 3) + fq) ^ (fr & 7)) * 16);
    int res_hi = -1;
    for (int p = 0; p < 8; ++p) {
        const int r0 = seg * 16 + 2 * p;
        const int lo = min(max(r0 - 4, 0), 120), hi = min(max(r0 - 3, 0), 120) + 7;
        const int first_new = max(lo, res_hi + 1);
        do { asm volatile("s_waitcnt vmcnt(0) lgkmcnt(0)" ::: "memory"); __syncthreads(); } while (0);
        for (int kr0 = first_new; kr0 <= hi; kr0 += 3) {
            u32x4 kv[3], vv[3];
#pragma unroll
            for (int j = 0; j < 3; ++j) { const int kr = min(kr0 + j, hi); kv[j] = *(const u32x4*)(kst + (size_t)kr * 64 * 512); vv[j] = *(const u32x4*)(vst + kr * 64); }
#pragma unroll
            for (int j = 0; j < 3; ++j) { const int slot = min(kr0 + j, hi) % 9; *(u32x4*)(lds + NA_KOFF + slot * 8192 + ksw) = kv[j]; *(u32x4*)(lds + NA_VOFF + slot * 8192 + vsw) = vv[j]; }
        }
        res_hi = hi;
        const int r = r0 + qrow, rs = min(max(r - 4, 0), 120);
        const size_t tq = (size_t)b * SEQ + r * 64 + c;
        const bf16x8 qf0 = *(const bf16x8*)(q + tq * 512 + head * 64 + fq * 8), qf1 = *(const bf16x8*)(q + tq * 512 + head * 64 + 32 + fq * 8);
        f32x4 zg[4];
#pragma unroll
        for (int dt = 0; dt < 4; ++dt) zg[dt] = load_bf4(zn + tq * 512 + head * 64 + dt * 16 + fq * 4);
        do { asm volatile("s_waitcnt vmcnt(0) lgkmcnt(0)" ::: "memory"); __syncthreads(); } while (0);
        f32x4 s[16];
#pragma unroll
        for (int t = 0; t < 16; ++t) {
            const int slot = (rs + (t >> 1)) % 9; const unsigned char* kb = lds + NA_KOFF + slot * 8192 + (t & 1) * 4 * 128;
            const bf16x8 k0 = *(const bf16x8*)(kb + kfo0), k1 = *(const bf16x8*)(kb + kfo1);
            f32x4 z = (f32x4){0.f, 0.f, 0.f, 0.f};
            z = __builtin_amdgcn_mfma_f32_16x16x32_bf16(k0, qf0, z, 0, 0, 0);
            z = __builtin_amdgcn_mfma_f32_16x16x32_bf16(k1, qf1, z, 0, 0, 0);
            s[t] = z;
        }
        float mx = -3.0e38f;
#pragma unroll
        for (int t = 0; t < 16; ++t) {
            const int i = t >> 1, odd = t & 1, dr = rs + i - r + 7;
#pragma unroll
            for (int e = 0; e < 4; ++e) {
                const int ck = cw0 + fq * 8 + odd * 4 + e; const bool valid = (ck >= cs) && (ck < cs + 16);
                const int dc = min(max(ck - c + 15, 0), 30);
                const float bv = bias[dr * 31 + dc];
                const float sv = valid ? s[t][e] + bv : -3.0e38f;
                s[t][e] = sv; mx = fmaxf(mx, sv);
            }
        }
        mx = fmaxf(mx, __shfl_xor(mx, 16)); mx = fmaxf(mx, __shfl_xor(mx, 32));
        float l = 0.f;
#pragma unroll
        for (int t = 0; t < 16; ++t)
#pragma unroll
            for (int e = 0; e < 4; ++e) { const float pv = __expf(s[t][e] - mx); s[t][e] = pv; l += pv; }
        l += __shfl_xor(l, 16); l += __shfl_xor(l, 32);
        f32x4 o[4];
#pragma unroll
        for (int dt = 0; dt < 4; ++dt) o[dt] = (f32x4){0.f, 0.f, 0.f, 0.f};
#pragma unroll
        for (int kq = 0; kq < 8; ++kq) {
            u32x4 pw; pw.x = pk2(s[2 * kq][0], s[2 * kq][1]); pw.y = pk2(s[2 * kq][2], s[2 * kq][3]); pw.z = pk2(s[2 * kq + 1][0], s[2 * kq + 1][1]); pw.w = pk2(s[2 * kq + 1][2], s[2 * kq + 1][3]);
            const bf16x8 pf = __builtin_bit_cast(bf16x8, pw);
            const unsigned char* vb = lds + NA_VOFF + ((rs + kq) % 9) * 8192 + vfo;
#pragma unroll
            for (int dt = 0; dt < 4; ++dt) { const bf16x8 vf = *(const bf16x8*)(vb + dt * 16 * 128); o[dt] = __builtin_amdgcn_mfma_f32_16x16x32_bf16(vf, pf, o[dt], 0, 0, 0); }
        }
        const float inv = 1.f / l;
#pragma unroll
        for (int dt = 0; dt < 4; ++dt) {
            const int d0 = head * 64 + dt * 16 + fq * 4; const f32x4 z = zg[dt]; f32x4 ov;
#pragma unroll
            for (int e = 0; e < 4; ++e) ov[e] = o[dt][e] * inv * z[e] * sigmoidf_(z[e]);
            store_bf4(mixin + tq * 1024 + 512 + d0, ov);
        }
        do { asm volatile("s_waitcnt vmcnt(0) lgkmcnt(0)" ::: "memory"); __syncthreads(); } while (0);
    }
    do { asm volatile("s_waitcnt vmcnt(0) lgkmcnt(0)" ::: "memory"); __syncthreads(); } while (0);
}
__device__ __forceinline__ void phase2(const Params& P, int bid, int nb, unsigned char* lds) {
    const int xcd = bid & 7, rank = bid >> 3, R = nb >> 3;
    for (int l = rank; l < 8; l += R) {
        const int mt = l & 1, g = xcd + 8 * (l >> 1);
        const pg8::Gemm gm{(const bf16_t*)(P.ws + OFF_UA) + (size_t)g * NCH * KA, (const bf16_t*)(P.ws + OFF_PM) + (size_t)g * NS * KU, KA, KU};
        const pg8::Order S{0, 1, 1, 1, 0, mt, 1}; const EpiS E{(float*)(P.ws + OFF_S) + (size_t)g * NCH * NS};
        pg8::gemm_phase<EpiS, pg8::Order, true, true>((PG8_LAS unsigned char*)lds, gm, S, E);
    }
    for (int l = rank; l < 32; l += R) na_block(P, xcd * 32 + l, lds);
    if (R == 32 && rank >= 8) {
        const int j = xcd * 48 + (rank - 8) * 2 + (threadIdx.x >> 8);
        for (int u = j; u < 1024; u += 384) tq_unit(P, u);
    }
}

__device__ __forceinline__ void phase3(const Params& P, int bid, int nb) {
    const float2* lampow = (const float2*)(P.ws + OFF_LAM); const float2* S = (const float2*)(P.ws + OFF_S); bf16_t* ua = (bf16_t*)(P.ws + OFF_UA);
    const int vb = bid * 2 + (threadIdx.x >> 8), nvb = nb * 2;
    if (nvb == 512 && vb >= 64) {
        for (int u = 1024 + (vb - 64); u < 32 * LC; u += 448) tq_unit(P, u);
        return;
    }
    if (nvb != 512) { for (int u = vb; u < 32 * LC; u += nvb) tq_unit(P, u); }
    for (int sidx = vb * 256 + TID; sidx < 4 * 2 * 32 * 64; sidx += nvb * 256) {
        const int p = sidx & 63, g = (sidx >> 6) & 31, dir = (sidx >> 11) & 1, b = sidx >> 12;
        const float2 L = lampow[((size_t)((dir * 32 + g) * 64 + p)) * 65 + LC];
        float hr = 0.f, hi = 0.f;
        const float2* Sp = S + ((size_t)(g * NCH + b * CPB)) * (NS / 2) + dir * 64 + p;
        bf16_t* up = ua + ((size_t)(g * NCH + b * CPB)) * KA + KU + dir * 128 + p * 2;
        for (int cb0 = 0; cb0 < CPB; cb0 += 16) {
            float2 sv[16];
#pragma unroll
            for (int uu = 0; uu < 16; ++uu) { const int c = dir == 0 ? cb0 + uu : CPB - 1 - (cb0 + uu); sv[uu] = Sp[(size_t)c * (NS / 2)]; }
#pragma unroll
            for (int uu = 0; uu < 16; ++uu) {
                const int c = dir == 0 ? cb0 + uu : CPB - 1 - (cb0 + uu);
                *(unsigned*)(up + (size_t)c * KA) = pk2(hr, hi);
                const float tr = L.x * hr - L.y * hi + sv[uu].x; hi = L.x * hi + L.y * hr + sv[uu].y; hr = tr;
            }
        }
    }
}

__device__ __forceinline__ void phase4(const Params& P, int bid, int nb, unsigned char* lds) {
    const int xcd = bid & 7, rank = bid >> 3, R = nb >> 3;
    for (int l = rank; l < 32; l += R) {
        const int mt = l & 1, nt = (l >> 1) & 3, g = xcd + 8 * (l >> 3);
        const pg8::Gemm gm{(const bf16_t*)(P.ws + OFF_UA) + (size_t)g * NCH * KA, (const bf16_t*)(P.ws + OFF_TQ) + (size_t)g * KU * KA, KA, KA};
        const pg8::Order S{0, 1, 1, 1, nt, mt, 1}; const EpiY E{(bf16_t*)(P.ws + OFF_YS), g};
        pg8::gemm_phase<EpiY, pg8::Order, true, true>((PG8_LAS unsigned char*)lds, gm, S, E);
    }
}
__device__ __forceinline__ void phase5(const Params& P, int bid, int nb, unsigned char* lds) {
    const int xcd = bid & 7, rank = bid >> 3, R = nb >> 3;
    const pg8::Gemm g{(const bf16_t*)(P.ws + OFF_YS), (const bf16_t*)(P.ws + OFF_WGLU), 512, 512};
    const pg8::Order S{rank, R, 32, 2, 0, xcd * 16, 1};
    const EpiGlu E{(const bf16_t*)(P.ws + OFF_YS), (const bf16_t*)(P.ws + OFF_ZS), P.b_glu, (bf16_t*)(P.ws + OFF_MIXIN)};
    pg8::gemm_phase<EpiGlu, pg8::Order, true, true>((PG8_LAS unsigned char*)lds, g, S, E);
}
__device__ __forceinline__ void phase6(const Params& P, int bid, int nb, unsigned char* lds) {
    const int xcd = bid & 7, rank = bid >> 3, R = nb >> 3;
    const pg8::Order S{rank, R, 64, 4, 0, xcd * 16, 1};
    {
        const pg8::Gemm g{(const bf16_t*)(P.ws + OFF_MIXIN), (const bf16_t*)(P.ws + OFF_WOUT), 1024, 1024};
        const EpiStoreSS E{(bf16_t*)(P.ws + OFF_MIX), (float*)(P.ws + OFF_SS)};
        pg8::gemm_phase<EpiStoreSS, pg8::Order, true, true>((PG8_LAS unsigned char*)lds, g, S, E);
    }
    {
        const pg8::Gemm g{(const bf16_t*)(P.ws + OFF_PB), (const bf16_t*)(P.ws + OFF_WPLE), 256, 256};
        const EpiStoreSS E{(bf16_t*)(P.ws + OFF_ERAW), (float*)(P.ws + OFF_ESS)};
        pg8::gemm_phase<EpiStoreSS, pg8::Order, true, true>((PG8_LAS unsigned char*)lds, g, S, E);
    }
}
__device__ __forceinline__ void phase7(const Params& P, int bid, int nb) {
    const int tid = TID, lane = tid & 63, wid = tid >> 6;
    const float* ss = (const float*)(P.ws + OFF_SS); const float* ess = (const float*)(P.ws + OFF_ESS); float* rstd = (float*)(P.ws + OFF_RSTD);
    const bf16_t* mix = (const bf16_t*)(P.ws + OFF_MIX); bf16_t* hb = (bf16_t*)(P.ws + OFF_HB);
    const int vb = bid * 2 + (threadIdx.x >> 8), nvb = nb * 2;
    for (int u = vb; u < T / 8; u += nvb) {
        const int t = u * 8 + wid * 2;
        const int tl = t + (lane >> 5), l5 = lane & 31;
        f32x4 xv[8], mv[8];
#pragma unroll
        for (int j = 0; j < 8; ++j) { const size_t off = (size_t)(t + (j >> 2)) * 1024 + lane * 4 + 256 * (j & 3); xv[j] = *(const f32x4*)(P.x + off); mv[j] = load_bf4(mix + off); }
        float v = l5 < 16 ? ss[(size_t)tl * 16 + l5] : ess[(size_t)tl * 16 + l5 - 16];
        v += __shfl_xor(v, 1); v += __shfl_xor(v, 2); v += __shfl_xor(v, 4); v += __shfl_xor(v, 8);
        const float rp0 = rsqrtf(__shfl(v, 0) * (1.f / 1024.f) + EPS), re0 = rsqrtf(__shfl(v, 16) * (1.f / 1024.f) + EPS);
        const float rp1 = rsqrtf(__shfl(v, 32) * (1.f / 1024.f) + EPS), re1 = rsqrtf(__shfl(v, 48) * (1.f / 1024.f) + EPS);
        if (lane == 0) { rstd[t] = rp0; rstd[T + t] = re0; rstd[t + 1] = rp1; rstd[T + t + 1] = re1; }
#pragma unroll
        for (int j = 0; j < 8; ++j) {
            const int n = lane * 4 + 256 * (j & 3); const size_t off = (size_t)(t + (j >> 2)) * 1024 + n; const float rp = (j >> 2) ? rp1 : rp0;
            const f32x4 gp = *(const f32x4*)(P.norm_post + n); f32x4 h;
#pragma unroll
            for (int e = 0; e < 4; ++e) h[e] = xv[j][e] + mv[j][e] * rp * gp[e];
            store_bf4(hb + off, h);
        }
    }
}
__device__ __forceinline__ void phase8(const Params& P, int bid, int nb, unsigned char* lds) {
    const int xcd = bid & 7, rank = bid >> 3, R = nb >> 3;
    const pg8::Gemm g{(const bf16_t*)(P.ws + OFF_HB), (const bf16_t*)(P.ws + OFF_WPG), 1024, 1024};
    const pg8::Order S{rank, R, 64, 4, 0, xcd * 16, 1};
    const EpiFinal E{(const bf16_t*)(P.ws + OFF_HB), (const bf16_t*)(P.ws + OFF_ERAW), (const float*)(P.ws + OFF_RSTD), P.ple_norm, P.out};
    pg8::gemm_phase<EpiFinal, pg8::Order, true, true>((PG8_LAS unsigned char*)lds, g, S, E);
}

#define XB_TMO      128
#define XB_XCNT(j)  (256  + 64 * (j))
#define XB_XSUB(j)  (1280 + 64 * (j))
#define XB_XGEN(j)  (2304 + 64 * (j))
#define XB_TOP      3328
#define XB_TOPGEN   3392
#define XCD_BAR_WORDS 3456
#define XB_SPIN_CAP (1u << 20)
#define LAS __attribute__((address_space(3)))
__device__ __forceinline__ unsigned xb_ld(unsigned* p)              { return __hip_atomic_load(p, __ATOMIC_RELAXED, __HIP_MEMORY_SCOPE_AGENT); }
__device__ __forceinline__ unsigned xb_add(unsigned* p, unsigned v) { return __hip_atomic_fetch_add(p, v, __ATOMIC_RELAXED, __HIP_MEMORY_SCOPE_AGENT); }
__device__ __forceinline__ unsigned xb_xcc_id() { return (unsigned)__builtin_amdgcn_s_getreg((3 << 11) | 20) & 0xFu; }
#define XB_SPIN(cond, bar) do { unsigned _sp = 0; while (cond) { __builtin_amdgcn_s_sleep(1); \
    if ((++_sp & 255u) == 0u) { if (xb_ld(&(bar)[XB_TMO])) break; if (_sp > XB_SPIN_CAP) { atomicAdd(&(bar)[XB_TMO], 1u); break; } } } } while (0)
struct XcdBarrier { unsigned* bar; unsigned x; volatile LAS unsigned* st; };
__device__ __forceinline__ XcdBarrier xcd_barrier_post(unsigned* bar, volatile LAS unsigned* st) {
    XcdBarrier b; b.bar = bar; b.x = xb_xcc_id(); b.st = st;
    if (threadIdx.x == 0) (void)xb_add(&bar[XB_XCNT(b.x)], 1u);
    return b;
}
__device__ __forceinline__ void xcd_barrier_complete(unsigned* bar, unsigned x, unsigned& nloc, unsigned& nx) {
    const unsigned G = gridDim.x * gridDim.y * gridDim.z;
    unsigned sum, cnt, mine, sp = 0u;
    for (;;) {
        sum = 0u; cnt = 0u; mine = 0u;
#pragma unroll
        for (unsigned j = 0; j < 16; ++j) { const unsigned c = xb_ld(&bar[XB_XCNT(j)]); sum += c; cnt += (c > 0u) ? 1u : 0u; mine = (j == x) ? c : mine; }
        if (sum == G) break;
        __builtin_amdgcn_s_sleep(1);
        if ((++sp & 255u) == 0u) { if (xb_ld(&bar[XB_TMO])) break; if (sp > XB_SPIN_CAP) { atomicAdd(&bar[XB_TMO], 1u); break; } }
    }
    nloc = mine > 0u ? mine : 1u; nx = cnt > 0u ? cnt : 1u;
}
__device__ __forceinline__ void xcd_barrier(const XcdBarrier& b) {
    asm volatile("s_waitcnt vmcnt(0)" ::: "memory");
    __syncthreads();
    if (threadIdx.x == 0) {
        unsigned* bar = b.bar;
        __builtin_amdgcn_s_waitcnt(0);
        unsigned nloc = b.st[0], nx = b.st[1];
        if (nloc == 0u) { xcd_barrier_complete(bar, b.x, nloc, nx); b.st[0] = nloc; b.st[1] = nx; }
        const unsigned old = xb_add(&bar[XB_XSUB(b.x)], 1u);
        const unsigned gen = old / nloc;
        if (old + 1u == (gen + 1u) * nloc) {
            __builtin_amdgcn_fence(__ATOMIC_RELEASE, "agent");
            asm volatile("s_waitcnt vmcnt(0)" ::: "memory");
            const unsigned og = xb_add(&bar[XB_TOP], 1u);
            const unsigned tg = og / nx;
            if (og + 1u == (tg + 1u) * nx) xb_add(&bar[XB_TOPGEN], 1u);
            else XB_SPIN(xb_ld(&bar[XB_TOPGEN]) == tg, bar);
            __builtin_amdgcn_fence(__ATOMIC_ACQUIRE, "agent");
            xb_add(&bar[XB_XGEN(b.x)], 1u);
            asm volatile("s_waitcnt vmcnt(0)" ::: "memory");
        } else {
            XB_SPIN(xb_ld(&bar[XB_XGEN(b.x)]) == gen, bar);
            __builtin_amdgcn_fence(__ATOMIC_ACQUIRE, "agent");
            asm volatile("s_waitcnt vmcnt(0)" ::: "memory");
        }
    }
    __syncthreads();
}

extern __shared__ __attribute__((aligned(16))) unsigned char dyn_lds[];

#if MK_MULTI
__global__ void __launch_bounds__(512, 2) k_phase(Params P, int ph) {
    const int bid = blockIdx.x, nb = gridDim.x;
    switch (ph) {
        case 0: phase0(P, bid, nb, dyn_lds); break;
        case 1: phase1(P, bid, nb, dyn_lds); break;
        case 2: phase2(P, bid, nb, dyn_lds); break;
        case 3: phase3(P, bid, nb); break;
        case 4: phase4(P, bid, nb, dyn_lds); break;
        case 5: phase5(P, bid, nb, dyn_lds); break;
        case 6: phase6(P, bid, nb, dyn_lds); break;
        case 7: phase7(P, bid, nb); break;
        default: phase8(P, bid, nb, dyn_lds); break;
    }
}
#else
__global__ void __launch_bounds__(512, 2) k_mega(Params P) {
    __shared__ uint4 xb_words;
    if (threadIdx.x == 0) xb_words = make_uint4(0u, 0u, 0u, 0u);
    __syncthreads();
    const XcdBarrier xb = xcd_barrier_post((unsigned*)(P.ws + OFF_BAR), (volatile LAS unsigned*)&xb_words);
    const int bid = blockIdx.x, nb = gridDim.x;
#ifndef REP
#define REP -1
#endif
#define PH(n, call) do { call; xcd_barrier(xb); if (REP == n) { call; xcd_barrier(xb); } } while (0)
    PH(0, phase0(P, bid, nb, dyn_lds));
    PH(1, phase1(P, bid, nb, dyn_lds));
    PH(2, phase2(P, bid, nb, dyn_lds));
    PH(3, phase3(P, bid, nb));
    PH(4, phase4(P, bid, nb, dyn_lds));
    PH(5, phase5(P, bid, nb, dyn_lds));
    PH(6, phase6(P, bid, nb, dyn_lds));
    PH(7, phase7(P, bid, nb));
    phase8(P, bid, nb, dyn_lds);
    if (REP == 8) { xcd_barrier(xb); phase8(P, bid, nb, dyn_lds); }
}
#endif

extern "C" void kernel_launch(void* const* d_in, const int* in_sizes, int n_in, void* d_out, int out_size, void* d_ws, size_t ws_size, hipStream_t stream) {
    static int grid = 0;
    if (grid == 0) {
        if (n_in != 20 || ws_size < WS_END) { fprintf(stderr, "kernel_launch: unexpected n_in %d or ws_size %zu (< %zu)\n", n_in, ws_size, (size_t)WS_END); grid = -1; return; }
        int dev = 0, cus = 0, per_cu = 0;
        hipGetDevice(&dev); hipDeviceGetAttribute(&cus, hipDeviceAttributeMultiprocessorCount, dev);
#if MK_MULTI
        hipFuncSetAttribute((const void*)k_phase, hipFuncAttributeMaxDynamicSharedMemorySize, LDS_BYTES);
        hipOccupancyMaxActiveBlocksPerMultiprocessor(&per_cu, (const void*)k_phase, 512, LDS_BYTES);
#else
        hipFuncSetAttribute((const void*)k_mega, hipFuncAttributeMaxDynamicSharedMemorySize, LDS_BYTES);
        hipOccupancyMaxActiveBlocksPerMultiprocessor(&per_cu, (const void*)k_mega, 512, LDS_BYTES);
#endif
        if (per_cu < 1) per_cu = 1;
        if (per_cu > 1) per_cu = 1;
        grid = (cus * per_cu) & ~7;
        (void)hipGetLastError();
    }
    if (grid < 0) return;
    Params P{};
    const float** pp = (const float**)&P;
    for (int i = 0; i < 20; ++i) pp[i] = (const float*)d_in[i];
    P.out = (float*)d_out; P.ws = (unsigned char*)d_ws;
#if MK_MULTI
    for (int ph = 0; ph < 9; ++ph) hipLaunchKernelGGL(k_phase, dim3(grid), dim3(512), LDS_BYTES, stream, P, ph);
#else
    (void)hipMemsetAsync((unsigned char*)d_ws + OFF_BAR, 0, XCD_BAR_WORDS * 4, stream);
    void* args[] = {&P};
    hipError_t e = hipLaunchCooperativeKernel((const void*)k_mega, dim3(grid), dim3(512), args, LDS_BYTES, stream);
    if (e != hipSuccess) fprintf(stderr, "cooperative launch failed: %s (grid %d)\n", hipGetErrorString(e), grid);
#endif
}
```
